# Optimizing an MI355X kernel written in HIP

```python
import jax
import jax.numpy as jnp
from jax import lax
import numpy as np

D_MODEL = 1024
BATCH = 4
SEQ = 4096
DEPTH = 4

GRID_W = 64
CTX_LEN = 256
N_MOD = 6
NORM_EPS = 1e-6
CHUNK = 64
RET_HEADS = 8
RET_DK = 64
RET_DV = 64
RET_W = RET_HEADS * RET_DV
ROPE_BASE = 10000.0
HG_HEADS = 4
HG_DK = 128
HG_DV = 128
HG_W = HG_HEADS * HG_DK
LRU_W = 512
LRU_BLOCKS = 8
LRU_BD = LRU_W // LRU_BLOCKS
LRU_C = 8.0
CONV_W = 4
CONV_PAD = (2, 1)
N_EXPERTS = 32
TOP_K = 4
D_EXPERT = D_MODEL
SWIGLU_ALPHA = 1.702
SWIGLU_LIMIT = 7.0
MOE_BLOCK = 256
SPLIT_SIZES = (RET_W, RET_W, RET_W, RET_W, HG_W, HG_W, HG_W, HG_W, HG_W, LRU_W, LRU_W, D_MODEL, D_MODEL, D_MODEL)
IN_COLS = sum(SPLIT_SIZES)

kernel_name = 'hybrid_retention_hgrn2_rglru_moe_dit'


def rmsnorm(x, g):
    xf = x.astype(jnp.float32)
    y = xf * lax.rsqrt(jnp.mean(xf * xf, axis=-1, keepdims=True) + NORM_EPS)
    return (y * g.astype(jnp.float32)).astype(x.dtype)


def modulate(h, shift, scale):
    return h * (1 + scale) + shift


def heads(t, n):
    B, L, W = t.shape
    return t.reshape(B, L, n, W // n).transpose(0, 2, 1, 3)


def head_rmsnorm(o, g):
    B, H, L, d = o.shape
    of = o.astype(jnp.float32)
    of = of * lax.rsqrt(jnp.mean(of * of, axis=-1, keepdims=True) + NORM_EPS)
    return of.transpose(0, 2, 1, 3).reshape(B, L, H * d) * g.astype(jnp.float32)


def axial_rotary_tables(n_tokens):
    rows = n_tokens // GRID_W
    row = jnp.repeat(jnp.arange(rows, dtype=jnp.float32), GRID_W)
    col = jnp.tile(jnp.arange(GRID_W, dtype=jnp.float32), rows)
    n_freq = RET_DK // 4
    inv = ROPE_BASE ** (-jnp.arange(n_freq, dtype=jnp.float32) / n_freq)
    ang = jnp.concatenate([row[:, None] * inv, col[:, None] * inv], axis=-1)
    return jnp.cos(ang), jnp.sin(ang)


def apply_rotary(t, cos, sin):
    half = t.shape[-1] // 2
    t1, t2 = t[..., :half], t[..., half:]
    return jnp.concatenate([t1 * cos - t2 * sin, t1 * sin + t2 * cos], axis=-1).astype(t.dtype)


def chunk_scan(q, k, v, log_f, s0, include_diag):
    f32 = jnp.float32
    B, H, L, _ = q.shape
    n = L // CHUNK

    def blocks(t):
        return t.astype(f32).reshape(B, H, n, CHUNK, t.shape[-1]).transpose(2, 0, 1, 3, 4)

    mask = jnp.tril(jnp.ones((CHUNK, CHUNK), dtype=bool), 0 if include_diag else -1)
    scalar_decay = log_f.shape[-1] == 1

    def step(S, xs):
        qb, kb, vb, lfb = xs
        g = jnp.cumsum(lfb, axis=2)
        g_last = g[:, :, -1:]
        rel = jnp.exp(jnp.where(mask[:, :, None], g[:, :, :, None] - g[:, :, None], -jnp.inf))
        if scalar_decay:
            scores = jnp.einsum('bhid,bhjd->bhij', qb, kb) * rel[..., 0]
        else:
            scores = jnp.einsum('bhid,bhjd,bhijd->bhij', qb, kb, rel)
        o = jnp.einsum('bhij,bhjv->bhiv', scores, vb) + jnp.einsum('bhid,bhdv->bhiv', qb * jnp.exp(g), S)
        S_new = jnp.exp(g_last)[:, :, 0, :, None] * S + jnp.einsum('bhjd,bhjv->bhdv', kb * jnp.exp(g_last - g), vb)
        return S_new, o

    s_fin, o = lax.scan(step, s0.astype(f32), (blocks(q), blocks(k), blocks(v), blocks(log_f)))
    return o.transpose(1, 2, 0, 3, 4).reshape(B, H, L, v.shape[-1]), s_fin


def bidir_linear_recurrence(q, v, k_f, lf_f, k_b, lf_b, n_ctx, bwd_diag):
    c_ = lambda t: t[:, :, :n_ctx]
    l_ = lambda t: t[:, :, n_ctx:]
    r_ = lambda t: jnp.flip(t, axis=2)
    B, H, _, dk = q.shape
    s0 = jnp.zeros((B, H, dk, v.shape[-1]), jnp.float32)
    oc_f, sc_f = chunk_scan(c_(q), c_(k_f), c_(v), c_(lf_f), s0, True)
    ol_f, _ = chunk_scan(l_(q), l_(k_f), l_(v), l_(lf_f), sc_f, True)
    oc_b, sc_b = chunk_scan(r_(c_(q)), r_(c_(k_b)), r_(c_(v)), r_(c_(lf_b)), s0, bwd_diag)
    ol_b, _ = chunk_scan(r_(l_(q)), r_(l_(k_b)), r_(l_(v)), r_(l_(lf_b)), sc_b, bwd_diag)
    return oc_f + r_(oc_b), ol_f + r_(ol_b)


def hgrn_forget(z, lb):
    z = z.astype(jnp.float32)
    log_f = jnp.logaddexp(jnp.log(lb), jnp.log1p(-lb) + jax.nn.log_sigmoid(z))
    key_in = (1.0 - lb) * jax.nn.sigmoid(-z)
    return heads(key_in, HG_HEADS), heads(log_f, HG_HEADS)


def depthwise_conv(x, w, b):
    y = lax.conv_general_dilated(x, w[:, None, :].astype(x.dtype), window_strides=(1,), padding=[CONV_PAD],
                                 dimension_numbers=('NWC', 'WIO', 'NWC'), feature_group_count=x.shape[-1])
    return y + b.astype(x.dtype)


def rglru_coeffs(xs, w_a, b_a, w_x, b_x, lam):
    f32 = jnp.float32
    B, L, C = xs.shape
    xf = xs.astype(f32)
    xb = xf.reshape(B, L, LRU_BLOCKS, LRU_BD)
    r = jax.nn.sigmoid(jnp.einsum('blhi,hij->blhj', xb, w_a.astype(f32)).reshape(B, L, C) + b_a.astype(f32))
    i = jax.nn.sigmoid(jnp.einsum('blhi,hij->blhj', xb, w_x.astype(f32)).reshape(B, L, C) + b_x.astype(f32))
    log_a = -LRU_C * r * jax.nn.softplus(-lam.astype(f32))
    a = jnp.exp(log_a)
    b = jnp.sqrt(-jnp.expm1(2.0 * log_a)) * (i * xf)
    return a, b


def linear_scan(a, b, h0):
    b = b.at[:, 0].add(a[:, 0] * h0)
    _, h = lax.associative_scan(lambda l, r: (l[0] * r[0], r[0] * l[1] + r[1]), (a, b), axis=1)
    return h


def bidir_rglru(a_f, b_f, a_b, b_b, n_ctx):
    c_ = lambda t: t[:, :n_ctx]
    l_ = lambda t: t[:, n_ctx:]
    r_ = lambda t: jnp.flip(t, axis=1)
    h0 = jnp.zeros((a_f.shape[0], a_f.shape[2]), a_f.dtype)
    hc_f = linear_scan(c_(a_f), c_(b_f), h0)
    hl_f = linear_scan(l_(a_f), l_(b_f), hc_f[:, -1])
    hc_b = linear_scan(r_(c_(a_b)), r_(c_(b_b)), h0)
    hl_b = linear_scan(r_(l_(a_b)), r_(l_(b_b)), hc_b[:, -1])
    return hc_f + r_(hc_b), hl_f + r_(hl_b)


def merge_branches(o_ret, o_hg, y_lru, cols, p):
    rg, hgt, lgt, gr, gh, gl = cols
    ret = (head_rmsnorm(o_ret, p['ret_gn_g']) * jax.nn.silu(rg)) @ p['w_ret_o']
    hgr = (head_rmsnorm(o_hg, p['hgrn_gn_g']) * jax.nn.sigmoid(hgt)) @ p['w_hgrn_o']
    lru = (y_lru * jax.nn.gelu(lgt)) @ p['w_lru_o']
    merged = jax.nn.sigmoid(gr) * ret + jax.nn.sigmoid(gh) * hgr + jax.nn.sigmoid(gl) * lru
    return merged @ p['w_out']


def moe_ffn(h, router_w, router_b, w_gu, b_gu, w_down, b_down):
    T, D = h.shape
    logits = h.astype(jnp.float32) @ router_w.astype(jnp.float32) + router_b.astype(jnp.float32)
    top_val, top_idx = lax.top_k(logits, TOP_K)
    top_w = jax.nn.softmax(top_val, axis=-1).astype(h.dtype)
    n_assign = T * TOP_K
    flat_e = top_idx.reshape(-1)
    flat_tok = jnp.repeat(jnp.arange(T, dtype=jnp.int32), TOP_K)
    order = jnp.argsort(flat_e)
    se, stok, sw = flat_e[order], flat_tok[order], top_w.reshape(-1)[order]
    counts = jnp.bincount(flat_e, length=N_EXPERTS)
    padded = (counts + MOE_BLOCK - 1) // MOE_BLOCK * MOE_BLOCK
    pad_end = jnp.cumsum(padded)
    pad_start = pad_end - padded
    grp_start = jnp.cumsum(counts) - counts
    dest = pad_start[se] + jnp.arange(n_assign, dtype=jnp.int32) - grp_start[se]
    n_blocks = -(-n_assign // MOE_BLOCK) + N_EXPERTS
    slot_tok = jnp.zeros((n_blocks * MOE_BLOCK,), jnp.int32).at[dest].set(stok)
    block_exp = jnp.minimum(jnp.searchsorted(pad_end, jnp.arange(n_blocks, dtype=jnp.int32) * MOE_BLOCK, side='right'),
                            N_EXPERTS - 1)

    def run_block(args):
        tok, e = args
        xb = h[tok]
        gu = xb @ w_gu[e] + b_gu[e]
        gate = jnp.minimum(gu[:, :D_EXPERT], SWIGLU_LIMIT)
        up = jnp.clip(gu[:, D_EXPERT:], -SWIGLU_LIMIT, SWIGLU_LIMIT)
        glu = gate * jax.nn.sigmoid(SWIGLU_ALPHA * gate)
        return ((up + 1) * glu) @ w_down[e] + b_down[e]

    y_slots = lax.map(run_block, (slot_tok.reshape(n_blocks, MOE_BLOCK), block_exp)).reshape(-1, D)
    y = y_slots[dest] * sw[:, None]
    return jnp.zeros((T, D), y.dtype).at[stok].add(y)


def trunk_layer(xc, xl, mod_c, mod_l, p, cos, sin, last):
    f32 = jnp.float32
    B, Lc, D = xc.shape
    L = xl.shape[1]
    Lt = Lc + L
    sh1c, sc1c, g1c, sh2c, sc2c, g2c = [mod_c[i] for i in range(N_MOD)]
    sh1l, sc1l, g1l, sh2l, sc2l, g2l = [mod_l[:, None, i] for i in range(N_MOD)]

    hc = modulate(rmsnorm(xc, p['norm1_g']), sh1c, sc1c)
    hl = modulate(rmsnorm(xl, p['norm1_g']), sh1l, sc1l)
    u = jnp.concatenate([hc, hl], axis=1) @ p['w_in']
    points = np.cumsum(SPLIT_SIZES)[:-1].tolist()
    rq, rk, rv, rg, hq, hff, hfb, hi, hgt, lx, lgt, gr, gh, gl = jnp.split(u, points, axis=-1)

    q = heads(rq, RET_HEADS)
    k = heads(rk, RET_HEADS) * RET_DK ** -0.5
    v = heads(rv, RET_HEADS)
    q = jnp.concatenate([q[:, :, :Lc], apply_rotary(q[:, :, Lc:], cos, sin)], axis=2)
    k = jnp.concatenate([k[:, :, :Lc], apply_rotary(k[:, :, Lc:], cos, sin)], axis=2)
    log_gamma = jax.nn.log_sigmoid(p['ret_decay'].astype(f32))
    lg_f = jnp.broadcast_to(log_gamma[0][None, :, None, None], (B, RET_HEADS, Lt, 1))
    lg_b = jnp.broadcast_to(log_gamma[1][None, :, None, None], (B, RET_HEADS, Lt, 1))
    ret_c, ret_l = bidir_linear_recurrence(q, v, k, lg_f, k, lg_b, Lc, bwd_diag=False)

    hq_h = heads(jax.nn.silu(hq), HG_HEADS)
    hv_h = heads(hi, HG_HEADS)
    kf, lff = hgrn_forget(hff, p['hgrn_lb'][0])
    kb, lfb = hgrn_forget(hfb, p['hgrn_lb'][1])
    hg_c, hg_l = bidir_linear_recurrence(hq_h, hv_h, kf, lff, kb, lfb, Lc, bwd_diag=True)

    xconv = jnp.concatenate([depthwise_conv(lx[:, :Lc], p['lru_conv_w'], p['lru_conv_b']),
                             depthwise_conv(lx[:, Lc:], p['lru_conv_w'], p['lru_conv_b'])], axis=1)
    a_f, b_f = rglru_coeffs(xconv, p['lru_wa'][0], p['lru_ba'][0], p['lru_wx'][0], p['lru_bx'][0], p['lru_lambda'][0])
    a_b, b_b = rglru_coeffs(xconv, p['lru_wa'][1], p['lru_ba'][1], p['lru_wx'][1], p['lru_bx'][1], p['lru_lambda'][1])
    lru_c, lru_l = bidir_rglru(a_f, b_f, a_b, b_b, Lc)

    side_l = lambda t: t[:, Lc:]
    side_c = lambda t: t[:, :Lc]
    mix_l = merge_branches(ret_l, hg_l, lru_l, [side_l(t) for t in (rg, hgt, lgt, gr, gh, gl)], p)
    xl = xl + (g1l * mix_l).astype(xl.dtype)
    h2l = modulate(rmsnorm(xl, p['norm2_g']), sh2l, sc2l)

    moe_args = (p['router_w'], p['router_b'], p['exp_w_gu'], p['exp_b_gu'], p['exp_w_down'], p['exp_b_down'])
    if last:
        ff_l = moe_ffn(h2l.reshape(-1, D), *moe_args).reshape(B, L, D)
        return None, xl + (g2l * ff_l).astype(xl.dtype)

    mix_c = merge_branches(ret_c, hg_c, lru_c, [side_c(t) for t in (rg, hgt, lgt, gr, gh, gl)], p)
    xc = xc + (g1c * mix_c).astype(xc.dtype)
    h2c = modulate(rmsnorm(xc, p['norm2_g']), sh2c, sc2c)

    ff = moe_ffn(jnp.concatenate([h2c, h2l], axis=1).reshape(-1, D), *moe_args).reshape(B, Lt, D)
    xc = xc + (g2c * ff[:, :Lc]).astype(xc.dtype)
    xl = xl + (g2l * ff[:, Lc:]).astype(xl.dtype)
    return xc, xl


def setup_inputs(seed: int = 0) -> dict:
    key = jax.random.key(seed)
    ks = list(jax.random.split(key, 40))
    f32 = jnp.float32

    def nrm(shape, scale):
        return jax.random.normal(ks.pop(), shape, f32) * scale

    D, E, F = D_MODEL, N_EXPERTS, D_EXPERT
    gamma0 = 1.0 - 2.0 ** (-5.0 - jnp.arange(RET_HEADS, dtype=f32))
    ret_logit0 = jnp.log(gamma0) - jnp.log1p(-gamma0)
    a0 = jax.random.uniform(ks.pop(), (DEPTH, 2, LRU_W), f32, minval=0.9, maxval=0.999)
    s_lam = a0 ** (1.0 / LRU_C)
    return {
        'x': nrm((BATCH, SEQ, D), 1.0),
        'c': nrm((BATCH, D), 1.0),
        'ctx': nrm((BATCH, CTX_LEN, D), 1.0),
        'c_ctx': nrm((D,), 1.0),
        'mod_w': nrm((DEPTH, D, N_MOD * D), 0.5 * D ** -0.5),
        'mod_b': nrm((DEPTH, N_MOD * D), 0.02),
        'norm1_g': 1.0 + nrm((DEPTH, D), 0.02),
        'norm2_g': 1.0 + nrm((DEPTH, D), 0.02),
        'final_g': 1.0 + nrm((D,), 0.02),
        'w_in': nrm((DEPTH, D, IN_COLS), D ** -0.5),
        'ret_decay': ret_logit0[None, None, :] + nrm((DEPTH, 2, RET_HEADS), 0.05),
        'ret_gn_g': 1.0 + nrm((DEPTH, RET_W), 0.02),
        'w_ret_o': nrm((DEPTH, RET_W, D), RET_W ** -0.5),
        'hgrn_lb_logits': nrm((DEPTH, 2, HG_W), 0.5),
        'hgrn_gn_g': 1.0 + nrm((DEPTH, HG_W), 0.02),
        'w_hgrn_o': nrm((DEPTH, HG_W, D), HG_W ** -0.5),
        'lru_conv_w': nrm((DEPTH, CONV_W, LRU_W), CONV_W ** -0.5),
        'lru_conv_b': nrm((DEPTH, LRU_W), 0.02),
        'lru_wa': nrm((DEPTH, 2, LRU_BLOCKS, LRU_BD, LRU_BD), LRU_BD ** -0.5),
        'lru_ba': nrm((DEPTH, 2, LRU_W), 0.02),
        'lru_wx': nrm((DEPTH, 2, LRU_BLOCKS, LRU_BD, LRU_BD), LRU_BD ** -0.5),
        'lru_bx': nrm((DEPTH, 2, LRU_W), 0.02),
        'lru_lambda': jnp.log(s_lam) - jnp.log1p(-s_lam),
        'w_lru_o': nrm((DEPTH, LRU_W, D), LRU_W ** -0.5),
        'w_out': nrm((DEPTH, D, D), D ** -0.5),
        'router_w': nrm((DEPTH, D, E), D ** -0.5),
        'router_b': nrm((DEPTH, E), 0.01),
        'exp_w_gu': nrm((DEPTH, E, D, 2 * F), D ** -0.5),
        'exp_b_gu': nrm((DEPTH, E, 2 * F), 0.02),
        'exp_w_down': nrm((DEPTH, E, F, D), F ** -0.5),
        'exp_b_down': nrm((DEPTH, E, D), 0.02),
    }


def reference(x, c, ctx, c_ctx, mod_w, mod_b, norm1_g, norm2_g, final_g, w_in, ret_decay, ret_gn_g, w_ret_o,
              hgrn_lb_logits, hgrn_gn_g, w_hgrn_o, lru_conv_w, lru_conv_b, lru_wa, lru_ba, lru_wx, lru_bx,
              lru_lambda, w_lru_o, w_out, router_w, router_b, exp_w_gu, exp_b_gu, exp_w_down, exp_b_down):
    B, L, D = x.shape
    cos, sin = axial_rotary_tables(L)
    lb_cum = jnp.cumsum(jax.nn.softmax(hgrn_lb_logits.astype(jnp.float32), axis=0), axis=0)
    lower_bounds = lb_cum - lb_cum[0]
    s_c = jax.nn.silu(c)
    s_ctx = jax.nn.silu(c_ctx)
    xc, xl = ctx, x
    for l in range(DEPTH):
        mod_l = (s_c @ mod_w[l] + mod_b[l]).reshape(B, N_MOD, D)
        mod_c = (s_ctx @ mod_w[l] + mod_b[l]).reshape(N_MOD, D)
        p = dict(norm1_g=norm1_g[l], norm2_g=norm2_g[l], w_in=w_in[l], ret_decay=ret_decay[l],
                 ret_gn_g=ret_gn_g[l], w_ret_o=w_ret_o[l], hgrn_lb=lower_bounds[l], hgrn_gn_g=hgrn_gn_g[l],
                 w_hgrn_o=w_hgrn_o[l], lru_conv_w=lru_conv_w[l], lru_conv_b=lru_conv_b[l], lru_wa=lru_wa[l],
                 lru_ba=lru_ba[l], lru_wx=lru_wx[l], lru_bx=lru_bx[l], lru_lambda=lru_lambda[l],
                 w_lru_o=w_lru_o[l], w_out=w_out[l], router_w=router_w[l], router_b=router_b[l],
                 exp_w_gu=exp_w_gu[l], exp_b_gu=exp_b_gu[l], exp_w_down=exp_w_down[l], exp_b_down=exp_b_down[l])
        xc, xl = trunk_layer(xc, xl, mod_c, mod_l, p, cos, sin, last=(l == DEPTH - 1))
    return rmsnorm(xl, final_g)
```

```cpp
#include <hip/hip_runtime.h>
#include <cstdio>
#include <cstdint>
namespace pg8 {
#define PG8_LAS __attribute__((address_space(3)))
typedef unsigned short bf16_t;
typedef short bf16x8 __attribute__((ext_vector_type(8)));
typedef float f32x4 __attribute__((ext_vector_type(4)));
typedef unsigned u32x4 __attribute__((ext_vector_type(4)));
constexpr int BM = 256, BK = 64, HALF = 128, HTB = HALF * BK * 2  , STAGE_BYTES = 8 * HTB, NXCD = 8, WGM = 8;

__host__ __device__ __forceinline__ int lds_byte(int r, int c) { const int st = (r >> 4) * 2 + (c >> 5), rr = r & 15, cc = c & 31, ob = rr * 64 + cc * 2; return st * 1024 + (ob ^ (((ob >> 9) & 1) << 5)); }
__host__ __device__ __forceinline__ void stage_rc(int b, int& R, int& C) { const int st = b / 1024, sb = b % 1024, swz = sb ^ (((sb >> 9) & 1) << 5); R = (st >> 1) * 16 + swz / 64; C = (st & 1) * 32 + (swz % 64) / 2; }
__host__ __device__ __forceinline__ int perm32(int rho) { const int n = rho >> 4, i = rho & 15; return 8 * (i >> 2) + 4 * n + (i & 3); }

struct Unit { int pm, pn; };
struct Gemm { const bf16_t* A; const bf16_t* Bt; int M, N, K; };

struct StaticOrder {
    int nM, nN, nwg, G, c;
    __host__ __device__ void init(int M, int N, int G_, int c_) { nM = M / BM; nN = N / BM; nwg = nM * nN; G = G_; c = c_; }
    __host__ __device__ bool next(int i, Unit& u) const {
        const long L = (long)i * G + c; if (L >= nwg) return false;
        int wgid = (int)L; { const int q = nwg / NXCD, r = nwg % NXCD, xcd = wgid % NXCD, off = wgid / NXCD; wgid = (xcd < r ? xcd * (q + 1) : r * (q + 1) + (xcd - r) * q) + off; }
        const int nig = WGM * nN, gid = wgid / nig, fm = gid * WGM, gsz = (nM - fm) < WGM ? (nM - fm) : WGM;
        u.pm = fm + ((wgid % nig) % gsz); u.pn = (wgid % nig) / gsz; return true;
    }
    __device__ __forceinline__ void a_ready(const Unit&) const {}
    __device__ __forceinline__ void done(const Unit&) const {}
};
__device__ __forceinline__ unsigned cvt_pk_bf16(float lo, float hi) { unsigned r; asm volatile("v_cvt_pk_bf16_f32 %0, %1, %2" : "=v"(r) : "v"(lo), "v"(hi)); return r; }
typedef float f32x2 __attribute__((ext_vector_type(2)));
__device__ __forceinline__ f32x2 gelu_pk(f32x2 v) {
    const f32x2 av = __builtin_elementwise_abs(v), d = av * 0.2316418882f + 1.0f;
    f32x2 t; t.x = __builtin_amdgcn_rcpf(d.x); t.y = __builtin_amdgcn_rcpf(d.y);
    f32x2 q = t * 0.5307027145f + (-0.7265760135f); q = q * t + 0.7107068705f; q = q * t + (-0.142248368f); q = q * t + 0.127414796f; q = q * t;
    const f32x2 s = (v * v) * (-0.72134752044f);
    f32x2 e; e.x = __builtin_amdgcn_exp2f(s.x); e.y = __builtin_amdgcn_exp2f(s.y);
    const f32x2 m = v * (q * e), r = v - m;
    f32x2 o; o.x = v.x < 0.f ? m.x : r.x; o.y = v.y < 0.f ? m.y : r.y; return o;
}

template <int ACT  > struct EpiBf16 {
    static constexpr bool PERM = true, AFTER_DRAIN = false;
    bf16_t* O; int ldc; const float* bias; int split_cols; size_t split_stride;
    __device__ __forceinline__ void operator()(const f32x4 (&acc)[2][2][4][2], const Unit& u, int wr, int wc, int fr, int fq) const {
        const int row0 = u.pm * BM + wr * 64 + fr; int colt = u.pn * BM; bf16_t* base = O;
        if (split_cols) { const int t = colt / split_cols; base += (size_t)t * split_stride; colt -= t * split_cols; }
        const int col0 = colt + wc * 32 + 8 * fq, bcol0 = u.pn * BM + wc * 32 + 8 * fq;
        f32x4 bv[2][2];
#pragma unroll
        for (int bj = 0; bj < 2; ++bj)
#pragma unroll
            for (int n = 0; n < 2; ++n) bv[bj][n] = bias ? *(const f32x4*)(bias + bcol0 + bj * HALF + 4 * n) : (f32x4){0.f, 0.f, 0.f, 0.f};
#pragma unroll
        for (int ai = 0; ai < 2; ++ai)
#pragma unroll
            for (int m = 0; m < 4; ++m) { bf16_t* rowp = base + (size_t)(row0 + ai * HALF + m * 16) * ldc + col0;
#pragma unroll
                for (int bj = 0; bj < 2; ++bj) { f32x4 v0 = acc[ai][bj][m][0] + bv[bj][0], v1 = acc[ai][bj][m][1] + bv[bj][1];
                    if (ACT == 1) { f32x2 a = gelu_pk((f32x2){v0[0], v0[1]}), b = gelu_pk((f32x2){v0[2], v0[3]}), c = gelu_pk((f32x2){v1[0], v1[1]}), d = gelu_pk((f32x2){v1[2], v1[3]});
                        v0 = (f32x4){a.x, a.y, b.x, b.y}; v1 = (f32x4){c.x, c.y, d.x, d.y}; }
                    if (ACT == 2) {
#pragma unroll
                        for (int j = 0; j < 4; ++j) { v0[j] = 0.5f * v0[j] * (1.0f + erff(v0[j] * 0.70710678f)); v1[j] = 0.5f * v1[j] * (1.0f + erff(v1[j] * 0.70710678f)); } }
                    u32x4 w; w.x = cvt_pk_bf16(v0[0], v0[1]); w.y = cvt_pk_bf16(v0[2], v0[3]); w.z = cvt_pk_bf16(v1[0], v1[1]); w.w = cvt_pk_bf16(v1[2], v1[3]);
                    *(u32x4*)(rowp + bj * HALF) = w; } }
    }
};


template <class Epi, class Sched, bool STAMP = false>
__device__ __forceinline__ void gemm_phase(PG8_LAS unsigned char* lds, const Gemm g, const Sched& S, const Epi& E, unsigned long long* stamps) {
    const int tid = threadIdx.x, wid = __builtin_amdgcn_readfirstlane(tid >> 6), lane = tid & 63, wr = wid >> 2, wc = wid & 3, fr = lane & 15, fq = lane >> 4;
    const int K = g.K, nt = K / BK;
    int ts_lo = 0, ts_hi = 0, nts = 0; const unsigned long long rt_entry = STAMP ? (unsigned long long)wall_clock64() : 0ull;
#define PG8_STAMP() do { if (STAMP && wid == 0 && nts < 64) { const unsigned long long _c = (unsigned long long)clock64(); \
        ts_lo = (lane == nts) ? (int)(unsigned)_c : ts_lo; ts_hi = (lane == nts) ? (int)(unsigned)(_c >> 32) : ts_hi; ++nts; } } while (0)
    PG8_STAMP();
    unsigned voffA[2], voffB[2];
#pragma unroll
    for (int i = 0; i < 2; ++i) { int R, C; stage_rc(tid * 16 + i * 8192, R, C); const int Rb = Epi::PERM ? ((R & ~31) + perm32(R & 31)) : R;
        voffA[i] = (unsigned)(R * K + C) * 2u; voffB[i] = (unsigned)(Rb * K + C) * 2u; }
    const size_t kstep = (size_t)(BK * 2);
    const size_t hstep = (size_t)HALF * K * 2;
    const size_t tstep = 2 * hstep;
    const unsigned ldsw = (unsigned)wid * 1024u;
    const int aoff = lds_byte(wr * 64 + fr, fq * 8), boff = lds_byte(wc * 32 + fr, fq * 8);
#define PG8_SA(b, h) (((b) * 2 + (h)) * HTB)
#define PG8_SB(b, h) ((4 + (b) * 2 + (h)) * HTB)
#define PG8_STAGE(bufoff, gbase, voff) do { _Pragma("unroll") for (int _i = 0; _i < 2; ++_i) \
        __builtin_amdgcn_global_load_lds((const unsigned*)((const char*)(gbase) + (voff)[_i]), (PG8_LAS unsigned*)(lds + (bufoff) + ldsw + _i * 8192), 16, 0, 0); } while (0)
#define PG8_LDA(dst, b, h) do { _Pragma("unroll") for (int m = 0; m < 4; ++m) _Pragma("unroll") for (int k = 0; k < 2; ++k) dst[m][k] = *(const PG8_LAS bf16x8*)(lds + PG8_SA(b, h) + aoff + m * 2048 + k * 1024); } while (0)
#define PG8_LDB(dst, b, h) do { _Pragma("unroll") for (int n = 0; n < 2; ++n) _Pragma("unroll") for (int k = 0; k < 2; ++k) dst[n][k] = *(const PG8_LAS bf16x8*)(lds + PG8_SB(b, h) + boff + n * 2048 + k * 1024); } while (0)
#define PG8_MMA(ai, bj, At, Bt) do { __builtin_amdgcn_s_setprio(1); _Pragma("unroll") for (int m = 0; m < 4; ++m) _Pragma("unroll") for (int n = 0; n < 2; ++n) _Pragma("unroll") for (int k = 0; k < 2; ++k) \
        acc[ai][bj][m][n] = __builtin_amdgcn_mfma_f32_16x16x32_bf16(Bt[n][k], At[m][k], acc[ai][bj][m][n], 0, 0, 0); __builtin_amdgcn_s_setprio(0); } while (0)
#define PG8_WAIT_V(n) asm volatile("s_waitcnt vmcnt(" #n ")" ::: "memory")
#define PG8_WAIT_L(n) asm volatile("s_waitcnt lgkmcnt(" #n ")" ::: "memory")
#define PG8_BAR __builtin_amdgcn_s_barrier()
#define PG8_SCHED __builtin_amdgcn_sched_barrier(0)
    Unit cur, nxt; int ui = 0;
    if (!S.next(0, cur)) return;
    f32x4 acc[2][2][4][2];
#pragma unroll
    for (int a = 0; a < 2; ++a)
#pragma unroll
        for (int b = 0; b < 2; ++b)
#pragma unroll
            for (int m = 0; m < 4; ++m)
#pragma unroll
                for (int n = 0; n < 2; ++n) acc[a][b][m][n] = (f32x4){0.f, 0.f, 0.f, 0.f};
    bf16x8 At[4][2], B0[2][2], B1[2][2];
    const char* cA = (const char*)g.A + (size_t)cur.pm * tstep; const char* cB = (const char*)g.Bt + (size_t)cur.pn * tstep;
    S.a_ready(cur);
    PG8_STAGE(PG8_SB(0, 0), cB, voffB); PG8_STAGE(PG8_SA(0, 0), cA, voffA); PG8_STAGE(PG8_SB(0, 1), cB + hstep, voffB); PG8_STAGE(PG8_SA(0, 1), cA + hstep, voffA);
    if (wr == 1) PG8_BAR;
    PG8_WAIT_V(4); PG8_BAR;
    PG8_STAGE(PG8_SB(1, 0), cB + kstep, voffB); PG8_STAGE(PG8_SA(1, 0), cA + kstep, voffA); PG8_STAGE(PG8_SB(1, 1), cB + hstep + kstep, voffB);
    PG8_WAIT_V(6); PG8_BAR;
    PG8_STAMP();
    for (;;) {
        const bool has_next = S.next(ui + 1, nxt);
        const char* nA = has_next ? (const char*)g.A + (size_t)nxt.pm * tstep : cA; const char* nB = has_next ? (const char*)g.Bt + (size_t)nxt.pn * tstep : cB;
        for (int t = 0; t < nt; t += 2) {
            const bool last = (t == nt - 2);
            const char* a1 = cA + (size_t)(t + 1) * kstep;
            const char* a2 = last ? nA : cA + (size_t)(t + 2) * kstep; const char* b2 = last ? nB : cB + (size_t)(t + 2) * kstep;
            const char* a3 = a2 + kstep; const char* b3 = b2 + kstep;
            if (last && has_next) S.a_ready(nxt);
            PG8_LDB(B0, 0, 0); PG8_SCHED; PG8_LDA(At, 0, 0); PG8_STAGE(PG8_SA(1, 1), a1 + hstep, voffA);
            PG8_WAIT_L(8); PG8_BAR; PG8_WAIT_L(0); PG8_MMA(0, 0, At, B0); PG8_BAR; PG8_SCHED;
            PG8_LDB(B1, 0, 1); PG8_STAGE(PG8_SB(0, 0), b2, voffB);
            PG8_BAR; PG8_WAIT_L(0); PG8_MMA(0, 1, At, B1); PG8_BAR;
            PG8_LDA(At, 0, 1); PG8_STAGE(PG8_SA(0, 0), a2, voffA);
            PG8_BAR; PG8_WAIT_L(0); PG8_MMA(1, 0, At, B0); PG8_BAR; PG8_SCHED;
            PG8_STAGE(PG8_SB(0, 1), b2 + hstep, voffB);
            PG8_WAIT_V(6); PG8_BAR; PG8_MMA(1, 1, At, B1); PG8_BAR;
            PG8_LDB(B0, 1, 0); PG8_SCHED; PG8_LDA(At, 1, 0); PG8_STAGE(PG8_SA(0, 1), a2 + hstep, voffA);
            PG8_WAIT_L(8); PG8_BAR; PG8_WAIT_L(0); PG8_MMA(0, 0, At, B0); PG8_BAR; PG8_SCHED;
            PG8_LDB(B1, 1, 1); PG8_STAGE(PG8_SB(1, 0), b3, voffB);
            PG8_BAR; PG8_WAIT_L(0); PG8_MMA(0, 1, At, B1); PG8_BAR;
            PG8_LDA(At, 1, 1); PG8_STAGE(PG8_SA(1, 0), a3, voffA);
            PG8_BAR; PG8_WAIT_L(0); PG8_MMA(1, 0, At, B0); PG8_BAR; PG8_SCHED;
            PG8_STAGE(PG8_SB(1, 1), b3 + hstep, voffB);
            PG8_WAIT_V(6); PG8_BAR; PG8_MMA(1, 1, At, B1); PG8_BAR;
        }
        PG8_STAMP();
        if constexpr (!Epi::AFTER_DRAIN) { E(acc, cur, wr, wc, fr, fq); S.done(cur); }
        PG8_STAMP();
        if (!has_next) break;
#pragma unroll
        for (int a = 0; a < 2; ++a)
#pragma unroll
            for (int b = 0; b < 2; ++b)
#pragma unroll
                for (int m = 0; m < 4; ++m)
#pragma unroll
                    for (int n = 0; n < 2; ++n) acc[a][b][m][n] = (f32x4){0.f, 0.f, 0.f, 0.f};
        cur = nxt; cA = nA; cB = nB; ++ui;
    }
    PG8_WAIT_V(0);
    if (wr == 0) PG8_BAR;
    PG8_BAR;
    if constexpr (Epi::AFTER_DRAIN) { E.fused(acc, cur, wr, wc, fr, fq, lds, wid, lane); S.done(cur); }
    PG8_STAMP();
    if (STAMP && wid == 0) { stamps[lane] = lane < nts ? (((unsigned long long)(unsigned)ts_hi << 32) | (unsigned)ts_lo) : 0ull;
        if (lane == 62) stamps[62] = rt_entry; if (lane == 63) stamps[63] = (unsigned long long)wall_clock64(); }
#undef PG8_STAMP
#undef PG8_SA
#undef PG8_SB
#undef PG8_STAGE
#undef PG8_LDA
#undef PG8_LDB
#undef PG8_MMA
#undef PG8_WAIT_V
#undef PG8_WAIT_L
#undef PG8_BAR
#undef PG8_SCHED
}
}

typedef unsigned short bf16_t;
using pg8::f32x4; using pg8::u32x4; using pg8::Unit;
typedef unsigned u32x2 __attribute__((ext_vector_type(2)));
#define LAS __attribute__((address_space(3)))

constexpr int D = 1024, NB = 4, SEQ = 4096, DEPTH = 4, LC = 256, LT = SEQ + LC, MT = NB * LT;
constexpr int INC = 8704;
constexpr int C_RQ = 0, C_RK = 512, C_RV = 1024, C_RG = 1536, C_HQ = 2048, C_HFF = 2560, C_HFB = 3072, C_HI = 3584, C_HGT = 4096, C_LX = 4608, C_LGT = 5120, C_GR = 5632;
constexpr int NE = 32, MAXTILES = 304, MAXSLOTS = MAXTILES * 256;
constexpr int NTHREADS = 512;

struct Params {
    const float *x, *c, *ctx, *c_ctx, *mod_w, *mod_b, *norm1_g, *norm2_g, *final_g, *w_in, *ret_decay, *ret_gn_g, *w_ret_o, *hgrn_lb_logits, *hgrn_gn_g, *w_hgrn_o,
        *lru_conv_w, *lru_conv_b, *lru_wa, *lru_ba, *lru_wx, *lru_bx, *lru_lambda, *w_lru_o, *w_out, *router_w, *router_b, *exp_w_gu, *exp_b_gu, *exp_w_down, *exp_b_down;
    float* out;
    bf16_t *wt_in, *wt_br, *wt_out, *wt_gu, *wt_down;
    float *mod, *lb, *rot;
    float* X; bf16_t* H; bf16_t* U;
    float *Oret, *Ohg, *La, *Lb, *Lh;
    bf16_t* Aall; float* T; bf16_t* Mg;
    unsigned* ctrl;
    int *tok_e, *tok_pos, *slot_of; float* tok_w;
    int *pad_start, *tile_e, *ntiles;
    bf16_t *Xg, *Act, *Y;
};

__device__ __forceinline__ float bf2f(bf16_t v) { return __uint_as_float(((unsigned)v) << 16); }
__device__ __forceinline__ float bflo(unsigned w) { return __uint_as_float(w << 16); }
__device__ __forceinline__ float bfhi(unsigned w) { return __uint_as_float(w & 0xffff0000u); }
__device__ __forceinline__ float sigmoidf_(float x) { return 1.0f / (1.0f + __expf(-x)); }
__device__ __forceinline__ float wave_sum(float v) {
#pragma unroll
    for (int o = 32; o >= 1; o >>= 1) v += __shfl_xor(v, o);
    return v;
}

__global__ __launch_bounds__(256) void k_convert(const float* __restrict__ src, bf16_t* __restrict__ dst, int K, int N, size_t sstride, size_t dstride, int mode) {
    __shared__ float tile[64][65];
    const int n0 = blockIdx.x * 64, k0 = blockIdx.y * 64; const size_t bz = blockIdx.z;
    const float* s = src + bz * sstride; bf16_t* d = dst + bz * dstride;
    const int t = threadIdx.x;
#pragma unroll
    for (int i = 0; i < 4; ++i) { const int r = (t >> 4) + 16 * i, cq = (t & 15) * 4; const float4 v = *(const float4*)(s + (size_t)(k0 + r) * N + n0 + cq);
        tile[r][cq] = v.x; tile[r][cq + 1] = v.y; tile[r][cq + 2] = v.z; tile[r][cq + 3] = v.w; }
    __syncthreads();
    const int n = t >> 2, kq = (t & 3) * 16;
    int nd = n0 + n; if (mode == 1) { const int j = nd & 1023, up = nd >> 10; nd = (j >> 7) * 256 + up * 128 + (j & 127); }
    unsigned w[8];
#pragma unroll
    for (int i = 0; i < 8; ++i) w[i] = pg8::cvt_pk_bf16(tile[kq + 2 * i][n], tile[kq + 2 * i + 1][n]);
    uint4* o = (uint4*)(d + (size_t)nd * K + k0 + kq); o[0] = make_uint4(w[0], w[1], w[2], w[3]); o[1] = make_uint4(w[4], w[5], w[6], w[7]);
}

__global__ __launch_bounds__(512) void k_mod(Params p) {
    __shared__ float s[5][1024]; __shared__ float red[8][5][64];
    const int t = threadIdx.x, l = blockIdx.y, n0 = blockIdx.x * 64;
    for (int i = t; i < 5 * 1024; i += 512) { const int r = i >> 10, k = i & 1023; const float v = (r < 4) ? p.c[r * 1024 + k] : p.c_ctx[k]; s[r][k] = v / (1.0f + expf(-v)); }
    __syncthreads();
    const int nn = t & 63, kg = t >> 6; const float* w = p.mod_w + (size_t)l * 1024 * 6144 + n0 + nn;
    float acc[5] = {0.f, 0.f, 0.f, 0.f, 0.f};
    for (int k = kg * 128; k < kg * 128 + 128; ++k) { const float wv = w[(size_t)k * 6144];
#pragma unroll
        for (int r = 0; r < 5; ++r) acc[r] += s[r][k] * wv; }
#pragma unroll
    for (int r = 0; r < 5; ++r) red[kg][r][nn] = acc[r];
    __syncthreads();
    if (t < 320) { const int r = t >> 6, n2 = t & 63; float a = 0.f;
#pragma unroll
        for (int g = 0; g < 8; ++g) a += red[g][r][n2];
        p.mod[(size_t)(l * 5 + r) * 6144 + n0 + n2] = a + p.mod_b[l * 6144 + n0 + n2]; }
}

__global__ void k_small(Params p) {
    const int i = blockIdx.x * blockDim.x + threadIdx.x;
    if (i < 1024) { float v[4], m = -1e30f;
        for (int l = 0; l < 4; ++l) { v[l] = p.hgrn_lb_logits[l * 1024 + i]; m = fmaxf(m, v[l]); }
        float sum = 0.f; for (int l = 0; l < 4; ++l) { v[l] = expf(v[l] - m); sum += v[l]; }
        float cum = 0.f; for (int l = 0; l < 4; ++l) { const float sm = v[l] / sum; if (l > 0) cum += sm; p.lb[l * 1024 + i] = cum; } }
    if (i < 4096 * 32) { const int t = i >> 5, f = i & 31; const float inv = powf(10000.0f, -(float)(f & 15) / 16.0f); const float pos = (f < 16) ? (float)(t >> 6) : (float)(t & 63);
        const float ang = pos * inv; p.rot[i * 2] = cosf(ang); p.rot[i * 2 + 1] = sinf(ang); }
}

template <int MODE> __device__ __forceinline__ void norm_phase(const Params& p, int l) {
    const int lane = threadIdx.x & 63; const int gw = blockIdx.x * (NTHREADS / 64) + (threadIdx.x >> 6), nw = gridDim.x * (NTHREADS / 64);
    for (int m = gw; m < MT; m += nw) {
        const int b = m / LT, pp = m - b * LT; const bool isctx = pp < LC; const int mr = isctx ? 4 : b;
        float4 xv[4];
        if (MODE == 0) { const float* src = isctx ? p.ctx + (size_t)(b * LC + pp) * D : p.x + (size_t)(b * SEQ + pp - LC) * D;
#pragma unroll
            for (int j = 0; j < 4; ++j) xv[j] = *(const float4*)(src + j * 256 + lane * 4);
        } else {
            const float* g2 = p.mod + (size_t)((l - 1) * 5 + mr) * 6144 + 5 * 1024;
            int slot[4]; float w[4];
#pragma unroll
            for (int k = 0; k < 4; ++k) { slot[k] = p.slot_of[m * 4 + k]; w[k] = p.tok_w[m * 4 + k]; }
#pragma unroll
            for (int j = 0; j < 4; ++j) { const int col = j * 256 + lane * 4; xv[j] = *(const float4*)(p.X + (size_t)m * D + col);
                float a0 = 0.f, a1 = 0.f, a2 = 0.f, a3 = 0.f;
#pragma unroll
                for (int k = 0; k < 4; ++k) { const u32x2 y = *(const u32x2*)(p.Y + (size_t)slot[k] * D + col); a0 += w[k] * bflo(y.x); a1 += w[k] * bfhi(y.x); a2 += w[k] * bflo(y.y); a3 += w[k] * bfhi(y.y); }
                const float4 g = *(const float4*)(g2 + col); xv[j].x += g.x * a0; xv[j].y += g.y * a1; xv[j].z += g.z * a2; xv[j].w += g.w * a3; }
        }
        if (MODE != 2) {
#pragma unroll
            for (int j = 0; j < 4; ++j) *(float4*)(p.X + (size_t)m * D + j * 256 + lane * 4) = xv[j]; }
        float ss = 0.f;
#pragma unroll
        for (int j = 0; j < 4; ++j) ss += xv[j].x * xv[j].x + xv[j].y * xv[j].y + xv[j].z * xv[j].z + xv[j].w * xv[j].w;
        ss = wave_sum(ss); const float rstd = rsqrtf(ss * (1.0f / D) + 1e-6f);
        if (MODE == 2) { if (!isctx) { float* o = p.out + (size_t)(b * SEQ + pp - LC) * D;
#pragma unroll
                for (int j = 0; j < 4; ++j) { const int col = j * 256 + lane * 4; const float4 g = *(const float4*)(p.final_g + col);
                    *(float4*)(o + col) = make_float4(xv[j].x * rstd * g.x, xv[j].y * rstd * g.y, xv[j].z * rstd * g.z, xv[j].w * rstd * g.w); } }
        } else { const float* mv = p.mod + (size_t)(l * 5 + mr) * 6144;
#pragma unroll
            for (int j = 0; j < 4; ++j) { const int col = j * 256 + lane * 4; const float4 g = *(const float4*)(p.norm1_g + l * D + col), sh = *(const float4*)(mv + col), sc = *(const float4*)(mv + 1024 + col);
                const float h0 = xv[j].x * rstd * g.x * (1.f + sc.x) + sh.x, h1 = xv[j].y * rstd * g.y * (1.f + sc.y) + sh.y, h2 = xv[j].z * rstd * g.z * (1.f + sc.z) + sh.z, h3 = xv[j].w * rstd * g.w * (1.f + sc.w) + sh.w;
                u32x2 w2; w2.x = pg8::cvt_pk_bf16(h0, h1); w2.y = pg8::cvt_pk_bf16(h2, h3); *(u32x2*)(p.H + (size_t)m * D + col) = w2; } }
    }
}

__device__ __forceinline__ void ret_chain(const Params& p, int l, int unit, float* lds) {
    const int b = unit >> 4, dir = (unit >> 3) & 1, h = unit & 7;
    float* sq = lds; float* sk = sq + 4096; float* sv = sk + 4096; float* so = sv + 4096; float* red = so + 4096;
    const int t = threadIdx.x, dv = t & 63, g = t >> 6;
    const float gam = 1.0f / (1.0f + expf(-p.ret_decay[l * 16 + dir * 8 + h]));
    float S[8];
#pragma unroll
    for (int i = 0; i < 8; ++i) S[i] = 0.f;
    for (int ci = 0; ci < 68; ++ci) {
        const int c = dir == 0 ? ci : (ci < 4 ? 3 - ci : 71 - ci);
        const int m0 = b * LT + c * 64;
#pragma unroll
        for (int i = 0; i < 4; ++i) { const int e = t + 512 * i, j = e >> 5, d = e & 31; const bf16_t* u = p.U + (size_t)(m0 + j) * INC + h * 64;
            float q1 = bf2f(u[C_RQ + d]), q2 = bf2f(u[C_RQ + d + 32]), k1 = bf2f(u[C_RK + d]) * 0.125f, k2 = bf2f(u[C_RK + d + 32]) * 0.125f;
            const float v1 = bf2f(u[C_RV + d]), v2 = bf2f(u[C_RV + d + 32]);
            if (c >= 4) { const int tt = c * 64 + j - LC; const float cs = p.rot[(tt * 32 + d) * 2], sn = p.rot[(tt * 32 + d) * 2 + 1];
                const float a = q1 * cs - q2 * sn, bq = q1 * sn + q2 * cs; q1 = a; q2 = bq; const float ck = k1 * cs - k2 * sn, dk = k1 * sn + k2 * cs; k1 = ck; k2 = dk; }
            sq[j * 64 + d] = q1; sq[j * 64 + d + 32] = q2; sk[j * 64 + d] = k1; sk[j * 64 + d + 32] = k2; sv[j * 64 + d] = v1; sv[j * 64 + d + 32] = v2; }
        __syncthreads();
        for (int s = 0; s < 64; ++s) { const int j = dir == 0 ? s : 63 - s;
            const float4 ka = *(const float4*)&sk[j * 64 + g * 8], kb = *(const float4*)&sk[j * 64 + g * 8 + 4], qa = *(const float4*)&sq[j * 64 + g * 8], qb = *(const float4*)&sq[j * 64 + g * 8 + 4];
            const float vv = sv[j * 64 + dv];
            const float kk[8] = {ka.x, ka.y, ka.z, ka.w, kb.x, kb.y, kb.z, kb.w}, qq[8] = {qa.x, qa.y, qa.z, qa.w, qb.x, qb.y, qb.z, qb.w};
            float part = 0.f;
            if (dir == 0) {
#pragma unroll
                for (int i = 0; i < 8; ++i) { S[i] = gam * S[i] + kk[i] * vv; part += qq[i] * S[i]; }
            } else {
#pragma unroll
                for (int i = 0; i < 8; ++i) { S[i] = gam * S[i]; part += qq[i] * S[i]; S[i] += kk[i] * vv; }
            }
            red[(s & 1) * 512 + g * 64 + dv] = part;
            __syncthreads();
            if (g == 0) { float o = 0.f;
#pragma unroll
                for (int g2 = 0; g2 < 8; ++g2) o += red[(s & 1) * 512 + g2 * 64 + dv];
                so[j * 64 + dv] = o; }
        }
        __syncthreads();
#pragma unroll
        for (int i = 0; i < 8; ++i) { const int e = t + 512 * i, j = e >> 6, d = e & 63; p.Oret[((size_t)dir * MT + m0 + j) * 512 + h * 64 + d] = so[j * 64 + d]; }
        __syncthreads();
    }
}

__device__ __forceinline__ void hg_chain(const Params& p, int l, int unit, float* lds) {
    const int b = unit >> 3, dir = (unit >> 2) & 1, h = unit & 3;
    float* sq = lds; float* sk = sq + 4096; float* sf = sk + 4096; float* sv = sf + 4096; float* so = sv + 4096; float* red = so + 4096;
    const int t = threadIdx.x, dv = t & 127, g = t >> 7;
    float S[32];
#pragma unroll
    for (int i = 0; i < 32; ++i) S[i] = 0.f;
    const int zc = dir == 0 ? C_HFF : C_HFB;
    for (int si = 0; si < 136; ++si) {
        const int cs = dir == 0 ? si : (si < 8 ? 7 - si : 143 - si);
        const int m0 = b * LT + cs * 32;
#pragma unroll
        for (int i = 0; i < 8; ++i) { const int e = t + 512 * i, j = e >> 7, d = e & 127; const bf16_t* u = p.U + (size_t)(m0 + j) * INC + h * 128 + d;
            const float z = bf2f(u[zc]), lbv = p.lb[l * 1024 + dir * 512 + h * 128 + d], sg = sigmoidf_(z);
            const float qr = bf2f(u[C_HQ]);
            sf[j * 128 + d] = lbv + (1.0f - lbv) * sg; sk[j * 128 + d] = (1.0f - lbv) * (1.0f - sg); sq[j * 128 + d] = qr * sigmoidf_(qr); sv[j * 128 + d] = bf2f(u[C_HI]); }
        __syncthreads();
        for (int s = 0; s < 32; ++s) { const int j = dir == 0 ? s : 31 - s; const float vv = sv[j * 128 + dv]; float part = 0.f;
#pragma unroll
            for (int i4 = 0; i4 < 8; ++i4) { const float4 f4 = *(const float4*)&sf[j * 128 + g * 32 + i4 * 4], k4 = *(const float4*)&sk[j * 128 + g * 32 + i4 * 4], q4 = *(const float4*)&sq[j * 128 + g * 32 + i4 * 4];
                S[i4 * 4 + 0] = f4.x * S[i4 * 4 + 0] + k4.x * vv; part += q4.x * S[i4 * 4 + 0];
                S[i4 * 4 + 1] = f4.y * S[i4 * 4 + 1] + k4.y * vv; part += q4.y * S[i4 * 4 + 1];
                S[i4 * 4 + 2] = f4.z * S[i4 * 4 + 2] + k4.z * vv; part += q4.z * S[i4 * 4 + 2];
                S[i4 * 4 + 3] = f4.w * S[i4 * 4 + 3] + k4.w * vv; part += q4.w * S[i4 * 4 + 3]; }
            red[(s & 1) * 512 + g * 128 + dv] = part;
            __syncthreads();
            if (g == 0) so[j * 128 + dv] = red[(s & 1) * 512 + dv] + red[(s & 1) * 512 + 128 + dv] + red[(s & 1) * 512 + 256 + dv] + red[(s & 1) * 512 + 384 + dv];
        }
        __syncthreads();
#pragma unroll
        for (int i = 0; i < 8; ++i) { const int e = t + 512 * i, j = e >> 7, d = e & 127; p.Ohg[((size_t)dir * MT + m0 + j) * 512 + h * 128 + d] = so[j * 128 + d]; }
        __syncthreads();
    }
}

__device__ __forceinline__ void lru_gates_unit(const Params& p, int l, int unit, float* lds) {
    const int tile = unit >> 3, hb = unit & 7, m0 = tile * 64, b = m0 / LT, p0 = m0 - b * LT; const int seg_lo = p0 < LC ? 0 : LC, seg_hi = p0 < LC ? LC : LT;
    float* xc = lds; float* W = lds + 4096;
    const int t = threadIdx.x;
#pragma unroll
    for (int i = 0; i < 8; ++i) { const int e = t + 512 * i, j = e >> 6, cc = e & 63, c = hb * 64 + cc, pp = p0 + j; float acc = p.lru_conv_b[l * 512 + c];
#pragma unroll
        for (int w = 0; w < 4; ++w) { const int q = pp + w - 2; if (q >= seg_lo && q < seg_hi) acc += bf2f(p.U[(size_t)(b * LT + q) * INC + C_LX + c]) * p.lru_conv_w[(l * 4 + w) * 512 + c]; }
        xc[j * 64 + cc] = acc; }
    for (int i = 0; i < 32; ++i) { const int e = t + 512 * i, mat = e >> 12, r = e & 4095, dir = mat >> 1; const float* src = (mat & 1) ? p.lru_wx : p.lru_wa; W[e] = src[(size_t)((l * 2 + dir) * 8 + hb) * 4096 + r]; }
    __syncthreads();
    const int cc = t & 63, tg = t >> 6, c = hb * 64 + cc;
    float acc[4][8];
#pragma unroll
    for (int a = 0; a < 4; ++a)
#pragma unroll
        for (int j = 0; j < 8; ++j) acc[a][j] = 0.f;
    for (int i = 0; i < 64; ++i) { float wv[4];
#pragma unroll
        for (int a = 0; a < 4; ++a) wv[a] = W[a * 4096 + i * 64 + cc];
#pragma unroll
        for (int j = 0; j < 8; ++j) { const float xv = xc[(tg * 8 + j) * 64 + i];
#pragma unroll
            for (int a = 0; a < 4; ++a) acc[a][j] += xv * wv[a]; } }
#pragma unroll
    for (int dir = 0; dir < 2; ++dir) { const int pi = (l * 2 + dir) * 512 + c; const float ba = p.lru_ba[pi], bx = p.lru_bx[pi], lam = p.lru_lambda[pi];
        const float sp = log1pf(expf(-lam));
#pragma unroll
        for (int j = 0; j < 8; ++j) { const float r = sigmoidf_(acc[dir * 2][j] + ba), ig = sigmoidf_(acc[dir * 2 + 1][j] + bx);
            const float la = -8.0f * r * sp, a = expf(la), bb = sqrtf(fmaxf(-expm1f(2.0f * la), 0.f)) * (ig * xc[(tg * 8 + j) * 64 + cc]);
            const size_t o = ((size_t)dir * MT + m0 + tg * 8 + j) * 512 + c; p.La[o] = a; p.Lb[o] = bb; } }
    __syncthreads();
}

__device__ __forceinline__ void lru_scan_unit(const Params& p, int unit, float* lds) {
    const int b = unit >> 4, dir = (unit >> 3) & 1, cg = unit & 7;
    float* sP = lds; float* sH = lds + 512;
    const int t = threadIdx.x, ch = t & 63, seg = t >> 6, c = cg * 64 + ch;
    const size_t base = ((size_t)dir * MT + (size_t)b * LT) * 512 + c;
    float P = 1.f, hl = 0.f;
    for (int pb = seg * 544; pb < seg * 544 + 544; ++pb) { const int pp = dir == 0 ? pb : (pb < LC ? LC - 1 - pb : LT + LC - 1 - pb); const size_t o = base + (size_t)pp * 512;
        const float a = p.La[o], bb = p.Lb[o]; hl = a * hl + bb; P *= a; }
    sP[seg * 64 + ch] = P; sH[seg * 64 + ch] = hl;
    __syncthreads();
    float hh = 0.f;
    for (int s2 = 0; s2 < seg; ++s2) hh = sP[s2 * 64 + ch] * hh + sH[s2 * 64 + ch];
    for (int pb = seg * 544; pb < seg * 544 + 544; ++pb) { const int pp = dir == 0 ? pb : (pb < LC ? LC - 1 - pb : LT + LC - 1 - pb); const size_t o = base + (size_t)pp * 512;
        const float a = p.La[o], bb = p.Lb[o]; hh = a * hh + bb; p.Lh[o] = hh; }
    __syncthreads();
}

__device__ __forceinline__ void finish_phase(const Params& p, int l) {
    const int lane = threadIdx.x & 63; const int gw = blockIdx.x * (NTHREADS / 64) + (threadIdx.x >> 6), nw = gridDim.x * (NTHREADS / 64);
    for (int m = gw; m < MT; m += nw) {
        const bf16_t* u = p.U + (size_t)m * INC; const int c0 = lane * 8;
        { const float* a = p.Oret + (size_t)m * 512 + c0; const float* bq = p.Oret + ((size_t)MT + m) * 512 + c0;
          float o[8]; const float4 a0 = *(const float4*)a, a1 = *(const float4*)(a + 4), b0 = *(const float4*)bq, b1 = *(const float4*)(bq + 4);
          o[0] = a0.x + b0.x; o[1] = a0.y + b0.y; o[2] = a0.z + b0.z; o[3] = a0.w + b0.w; o[4] = a1.x + b1.x; o[5] = a1.y + b1.y; o[6] = a1.z + b1.z; o[7] = a1.w + b1.w;
          float ss = 0.f;
#pragma unroll
          for (int i = 0; i < 8; ++i) ss += o[i] * o[i];
          ss += __shfl_xor(ss, 1); ss += __shfl_xor(ss, 2); ss += __shfl_xor(ss, 4);
          const float rstd = rsqrtf(ss * (1.0f / 64.0f) + 1e-6f);
          const uint4 gv = *(const uint4*)(u + C_RG + c0); const unsigned gw4[4] = {gv.x, gv.y, gv.z, gv.w}; unsigned w[4];
#pragma unroll
          for (int i = 0; i < 4; ++i) { const float g0 = bflo(gw4[i]), g1 = bfhi(gw4[i]);
              const float r0 = o[2 * i] * rstd * p.ret_gn_g[l * 512 + c0 + 2 * i] * (g0 * sigmoidf_(g0)), r1 = o[2 * i + 1] * rstd * p.ret_gn_g[l * 512 + c0 + 2 * i + 1] * (g1 * sigmoidf_(g1));
              w[i] = pg8::cvt_pk_bf16(r0, r1); }
          *(uint4*)(p.Aall + (size_t)m * 512 + c0) = make_uint4(w[0], w[1], w[2], w[3]); }
        { const float* a = p.Ohg + (size_t)m * 512 + c0; const float* bq = p.Ohg + ((size_t)MT + m) * 512 + c0;
          float o[8]; const float4 a0 = *(const float4*)a, a1 = *(const float4*)(a + 4), b0 = *(const float4*)bq, b1 = *(const float4*)(bq + 4);
          o[0] = a0.x + b0.x; o[1] = a0.y + b0.y; o[2] = a0.z + b0.z; o[3] = a0.w + b0.w; o[4] = a1.x + b1.x; o[5] = a1.y + b1.y; o[6] = a1.z + b1.z; o[7] = a1.w + b1.w;
          float ss = 0.f;
#pragma unroll
          for (int i = 0; i < 8; ++i) ss += o[i] * o[i];
          ss += __shfl_xor(ss, 1); ss += __shfl_xor(ss, 2); ss += __shfl_xor(ss, 4); ss += __shfl_xor(ss, 8);
          const float rstd = rsqrtf(ss * (1.0f / 128.0f) + 1e-6f);
          const uint4 gv = *(const uint4*)(u + C_HGT + c0); const unsigned gw4[4] = {gv.x, gv.y, gv.z, gv.w}; unsigned w[4];
#pragma unroll
          for (int i = 0; i < 4; ++i) { const float g0 = bflo(gw4[i]), g1 = bfhi(gw4[i]);
              const float r0 = o[2 * i] * rstd * p.hgrn_gn_g[l * 512 + c0 + 2 * i] * sigmoidf_(g0), r1 = o[2 * i + 1] * rstd * p.hgrn_gn_g[l * 512 + c0 + 2 * i + 1] * sigmoidf_(g1);
              w[i] = pg8::cvt_pk_bf16(r0, r1); }
          *(uint4*)(p.Aall + ((size_t)MT + m) * 512 + c0) = make_uint4(w[0], w[1], w[2], w[3]); }
        { const float* a = p.Lh + (size_t)m * 512 + c0; const float* bq = p.Lh + ((size_t)MT + m) * 512 + c0;
          float o[8]; const float4 a0 = *(const float4*)a, a1 = *(const float4*)(a + 4), b0 = *(const float4*)bq, b1 = *(const float4*)(bq + 4);
          o[0] = a0.x + b0.x; o[1] = a0.y + b0.y; o[2] = a0.z + b0.z; o[3] = a0.w + b0.w; o[4] = a1.x + b1.x; o[5] = a1.y + b1.y; o[6] = a1.z + b1.z; o[7] = a1.w + b1.w;
          const uint4 gv = *(const uint4*)(u + C_LGT + c0); const unsigned gw4[4] = {gv.x, gv.y, gv.z, gv.w}; unsigned w[4];
#pragma unroll
          for (int i = 0; i < 4; ++i) { float gg[2] = {bflo(gw4[i]), bfhi(gw4[i])}; float r[2];
#pragma unroll
              for (int k = 0; k < 2; ++k) { const float x = gg[k]; const float ge = 0.5f * x * (1.0f + tanhf(0.7978845608f * (x + 0.044715f * x * x * x))); r[k] = o[2 * i + k] * ge; }
              w[i] = pg8::cvt_pk_bf16(r[0], r[1]); }
          *(uint4*)(p.Aall + ((size_t)2 * MT + m) * 512 + c0) = make_uint4(w[0], w[1], w[2], w[3]); }
    }
}

__device__ __forceinline__ void route_phase(const Params& p, int l, float* lds) {
    const int t = threadIdx.x, lane = t & 63;
    const float* rw = p.router_w + (size_t)l * 1024 * 32;
    for (int i = t; i < 1024 * 8; i += NTHREADS) { const int k = i >> 3, q = i & 7; *(float4*)&lds[k * 36 + q * 4] = *(const float4*)(rw + k * 32 + q * 4); }
    __syncthreads();
    const int gw = blockIdx.x * (NTHREADS / 64) + (t >> 6), nw = gridDim.x * (NTHREADS / 64);
    for (int m = gw; m < MT; m += nw) {
        const int b = m / LT, pp = m - b * LT; const int mr = pp < LC ? 4 : b;
        const float* mv = p.mod + (size_t)(l * 5 + mr) * 6144;
        float hv[16]; float ss = 0.f;
#pragma unroll
        for (int j = 0; j < 4; ++j) { const float4 x = *(const float4*)(p.X + (size_t)m * D + j * 256 + lane * 4); hv[j * 4] = x.x; hv[j * 4 + 1] = x.y; hv[j * 4 + 2] = x.z; hv[j * 4 + 3] = x.w; ss += x.x * x.x + x.y * x.y + x.z * x.z + x.w * x.w; }
        ss = wave_sum(ss); const float rstd = rsqrtf(ss * (1.0f / D) + 1e-6f);
#pragma unroll
        for (int j = 0; j < 4; ++j) { const int col = j * 256 + lane * 4; const float4 g = *(const float4*)(p.norm2_g + l * D + col), sh = *(const float4*)(mv + 3 * 1024 + col), sc = *(const float4*)(mv + 4 * 1024 + col);
            hv[j * 4] = hv[j * 4] * rstd * g.x * (1.f + sc.x) + sh.x; hv[j * 4 + 1] = hv[j * 4 + 1] * rstd * g.y * (1.f + sc.y) + sh.y;
            hv[j * 4 + 2] = hv[j * 4 + 2] * rstd * g.z * (1.f + sc.z) + sh.z; hv[j * 4 + 3] = hv[j * 4 + 3] * rstd * g.w * (1.f + sc.w) + sh.w;
            u32x2 w2; w2.x = pg8::cvt_pk_bf16(hv[j * 4], hv[j * 4 + 1]); w2.y = pg8::cvt_pk_bf16(hv[j * 4 + 2], hv[j * 4 + 3]); *(u32x2*)(p.H + (size_t)m * D + col) = w2; }
        float lg[32];
#pragma unroll
        for (int e = 0; e < 32; ++e) lg[e] = 0.f;
#pragma unroll
        for (int j = 0; j < 4; ++j)
#pragma unroll
            for (int i = 0; i < 4; ++i) { const int k = j * 256 + lane * 4 + i; const float hvv = hv[j * 4 + i];
#pragma unroll
                for (int q = 0; q < 8; ++q) { const float4 w = *(const float4*)&lds[k * 36 + q * 4]; lg[q * 4] += hvv * w.x; lg[q * 4 + 1] += hvv * w.y; lg[q * 4 + 2] += hvv * w.z; lg[q * 4 + 3] += hvv * w.w; } }
#pragma unroll
        for (int e = 0; e < 32; ++e) lg[e] = wave_sum(lg[e]) + p.router_b[l * 32 + e];
        int idx[4]; float val[4];
#pragma unroll
        for (int k = 0; k < 4; ++k) { float best = -3.0e38f; int bi = 0;
#pragma unroll
            for (int e = 0; e < 32; ++e) { const bool better = lg[e] > best; best = better ? lg[e] : best; bi = better ? e : bi; }
            idx[k] = bi; val[k] = best;
#pragma unroll
            for (int e = 0; e < 32; ++e) lg[e] = (e == bi) ? -3.0e38f : lg[e]; }
        const float e1 = __expf(val[1] - val[0]), e2 = __expf(val[2] - val[0]), e3 = __expf(val[3] - val[0]); const float inv = 1.0f / (1.0f + e1 + e2 + e3);
        const float wgt[4] = {inv, e1 * inv, e2 * inv, e3 * inv};
        if (lane < 4) { int myi = idx[0]; float myw = wgt[0];
#pragma unroll
            for (int k = 1; k < 4; ++k) { myi = (lane == k) ? idx[k] : myi; myw = (lane == k) ? wgt[k] : myw; }
            const unsigned pos = atomicAdd(&p.ctrl[l * 64 + myi], 1u);
            p.tok_e[m * 4 + lane] = myi; p.tok_pos[m * 4 + lane] = (int)pos; p.tok_w[m * 4 + lane] = myw; }
    }
}

__device__ __forceinline__ void offsets_phase(const Params& p, int l) {
    if (blockIdx.x == 0 && threadIdx.x == 0) { int start = 0, nt = 0;
        for (int e = 0; e < NE; ++e) { const int cnt = (int)p.ctrl[l * 64 + e]; const int tiles = (cnt + 255) >> 8; p.pad_start[e] = start; for (int i = 0; i < tiles; ++i) p.tile_e[nt + i] = e; nt += tiles; start += tiles * 256; }
        p.ntiles[0] = nt; }
}
__device__ __forceinline__ void gather_phase(const Params& p) {
    const int lane = threadIdx.x & 63; const int gw = blockIdx.x * (NTHREADS / 64) + (threadIdx.x >> 6), nw = gridDim.x * (NTHREADS / 64);
    for (int a = gw; a < MT * 4; a += nw) { const int m = a >> 2; const int slot = p.pad_start[p.tok_e[a]] + p.tok_pos[a];
        if (lane == 0) p.slot_of[a] = slot;
        const uint4* src = (const uint4*)(p.H + (size_t)m * D); uint4* dst = (uint4*)(p.Xg + (size_t)slot * D);
        dst[lane] = src[lane]; dst[lane + 64] = src[lane + 64]; }
}

struct EpiMerge {
    static constexpr bool PERM = false, AFTER_DRAIN = false;
    const bf16_t* U; float* T; bf16_t* Mg;
    __device__ __forceinline__ void operator()(const f32x4 (&acc)[2][2][4][2], const Unit& u, int wr, int wc, int fr, int fq) const {
        const int br = u.pn >> 2, pnl = u.pn & 3, pmr = u.pm - br * 68;
        const int row0 = pmr * 256 + wr * 64 + fr, col0 = pnl * 256 + wc * 32 + 4 * fq;
#pragma unroll
        for (int ai = 0; ai < 2; ++ai)
#pragma unroll
            for (int m = 0; m < 4; ++m) { const size_t row = (size_t)(row0 + ai * 128 + m * 16);
#pragma unroll
                for (int bj = 0; bj < 2; ++bj)
#pragma unroll
                    for (int n = 0; n < 2; ++n) { const int col = col0 + bj * 128 + n * 16;
                        const u32x2 gv = *(const u32x2*)(U + row * INC + C_GR + br * 1024 + col);
                        f32x4 v = acc[ai][bj][m][n]; v[0] *= sigmoidf_(bflo(gv.x)); v[1] *= sigmoidf_(bfhi(gv.x)); v[2] *= sigmoidf_(bflo(gv.y)); v[3] *= sigmoidf_(bfhi(gv.y));
                        f32x4* tp = (f32x4*)(T + row * D + col);
                        if (br == 0) *tp = v; else if (br == 1) *tp = *tp + v;
                        else { const f32x4 r = *tp + v; u32x2 w; w.x = pg8::cvt_pk_bf16(r[0], r[1]); w.y = pg8::cvt_pk_bf16(r[2], r[3]); *(u32x2*)(Mg + row * D + col) = w; } } }
    }
};
struct SchedMerge { int G, c;
    __device__ bool next(int i, Unit& u) const { const int tile = (i / 3) * G + c, br = i % 3; if (tile >= 272) return false; u.pm = br * 68 + (tile >> 2); u.pn = br * 4 + (tile & 3); return true; }
    __device__ __forceinline__ void a_ready(const Unit&) const {}
    __device__ __forceinline__ void done(const Unit&) const {}
};
struct EpiOut {
    static constexpr bool PERM = false, AFTER_DRAIN = false;
    float* X; const float* mod_l;
    __device__ __forceinline__ void operator()(const f32x4 (&acc)[2][2][4][2], const Unit& u, int wr, int wc, int fr, int fq) const {
        const int mr = (u.pm % 17 == 0) ? 4 : u.pm / 17; const float* g1 = mod_l + mr * 6144 + 2 * 1024;
        const int row0 = u.pm * 256 + wr * 64 + fr, col0 = u.pn * 256 + wc * 32 + 4 * fq;
        f32x4 gv[2][2];
#pragma unroll
        for (int bj = 0; bj < 2; ++bj)
#pragma unroll
            for (int n = 0; n < 2; ++n) gv[bj][n] = *(const f32x4*)(g1 + col0 + bj * 128 + n * 16);
#pragma unroll
        for (int ai = 0; ai < 2; ++ai)
#pragma unroll
            for (int m = 0; m < 4; ++m) { float* rowp = X + (size_t)(row0 + ai * 128 + m * 16) * D + col0;
#pragma unroll
                for (int bj = 0; bj < 2; ++bj)
#pragma unroll
                    for (int n = 0; n < 2; ++n) { f32x4* xp = (f32x4*)(rowp + bj * 128 + n * 16); *xp = *xp + gv[bj][n] * acc[ai][bj][m][n]; } }
    }
};
struct SchedMoE { const int* tile_e; int ntiles, nN, G, c;
    __device__ bool next(int i, Unit& u) const { const int L = i * G + c; if (L >= ntiles * nN) return false; const int tile = L / nN, j = L - tile * nN; u.pm = tile; u.pn = tile_e[tile] * nN + j; return true; }
    __device__ __forceinline__ void a_ready(const Unit&) const {}
    __device__ __forceinline__ void done(const Unit&) const {}
};
struct EpiGU {
    static constexpr bool PERM = true, AFTER_DRAIN = false;
    bf16_t* Act; const float* bgu;
    __device__ __forceinline__ void operator()(const f32x4 (&acc)[2][2][4][2], const Unit& u, int wr, int wc, int fr, int fq) const {
        const int e = u.pn >> 3, pnl = u.pn & 7; const int row0 = u.pm * 256 + wr * 64 + fr, c8 = pnl * 128 + wc * 32 + 8 * fq;
        const float* bg = bgu + e * 2048 + c8; const f32x4 bg0 = *(const f32x4*)bg, bg1 = *(const f32x4*)(bg + 4), bu0 = *(const f32x4*)(bg + 1024), bu1 = *(const f32x4*)(bg + 1028);
#pragma unroll
        for (int ai = 0; ai < 2; ++ai)
#pragma unroll
            for (int m = 0; m < 4; ++m) { const f32x4 g0 = acc[ai][0][m][0] + bg0, g1 = acc[ai][0][m][1] + bg1, u0 = acc[ai][1][m][0] + bu0, u1 = acc[ai][1][m][1] + bu1; float r[8];
#pragma unroll
                for (int j = 0; j < 4; ++j) { const float ga = fminf(g0[j], 7.0f), ua = fminf(fmaxf(u0[j], -7.0f), 7.0f); r[j] = (ua + 1.0f) * (ga * sigmoidf_(1.702f * ga));
                    const float gb = fminf(g1[j], 7.0f), ub = fminf(fmaxf(u1[j], -7.0f), 7.0f); r[4 + j] = (ub + 1.0f) * (gb * sigmoidf_(1.702f * gb)); }
                u32x4 w; w.x = pg8::cvt_pk_bf16(r[0], r[1]); w.y = pg8::cvt_pk_bf16(r[2], r[3]); w.z = pg8::cvt_pk_bf16(r[4], r[5]); w.w = pg8::cvt_pk_bf16(r[6], r[7]);
                *(u32x4*)(Act + (size_t)(row0 + ai * 128 + m * 16) * D + c8) = w; }
    }
};
struct EpiDown {
    static constexpr bool PERM = true, AFTER_DRAIN = false;
    bf16_t* Y; const float* bd;
    __device__ __forceinline__ void operator()(const f32x4 (&acc)[2][2][4][2], const Unit& u, int wr, int wc, int fr, int fq) const {
        const int e = u.pn >> 2, pnl = u.pn & 3; const int row0 = u.pm * 256 + wr * 64 + fr, col0 = pnl * 256 + wc * 32 + 8 * fq;
        f32x4 bv[2][2];
#pragma unroll
        for (int bj = 0; bj < 2; ++bj)
#pragma unroll
            for (int n = 0; n < 2; ++n) bv[bj][n] = *(const f32x4*)(bd + e * 1024 + col0 + bj * 128 + 4 * n);
#pragma unroll
        for (int ai = 0; ai < 2; ++ai)
#pragma unroll
            for (int m = 0; m < 4; ++m) { bf16_t* rowp = Y + (size_t)(row0 + ai * 128 + m * 16) * D + col0;
#pragma unroll
                for (int bj = 0; bj < 2; ++bj) { const f32x4 v0 = acc[ai][bj][m][0] + bv[bj][0], v1 = acc[ai][bj][m][1] + bv[bj][1];
                    u32x4 w; w.x = pg8::cvt_pk_bf16(v0[0], v0[1]); w.y = pg8::cvt_pk_bf16(v0[2], v0[3]); w.z = pg8::cvt_pk_bf16(v1[0], v1[1]); w.w = pg8::cvt_pk_bf16(v1[2], v1[3]);
                    *(u32x4*)(rowp + bj * 128) = w; } }
    }
};

extern __shared__ __attribute__((aligned(16))) unsigned char dyn_lds[];

__global__ __launch_bounds__(512, 2) void k_norm0(Params p) { norm_phase<0>(p, 0); }
__global__ __launch_bounds__(512, 2) void k_norm1(Params p, int l) { norm_phase<1>(p, l); }
__global__ __launch_bounds__(512, 2) void k_norm2(Params p) { norm_phase<2>(p, DEPTH); }
__global__ __launch_bounds__(512, 2) void k_gemm_in(Params p, int l) {
    pg8::Gemm g; g.A = p.H; g.Bt = p.wt_in + (size_t)l * INC * D; g.M = MT; g.N = INC; g.K = D;
    pg8::StaticOrder S; S.init(MT, INC, (int)gridDim.x, (int)blockIdx.x);
    pg8::EpiBf16<0> E; E.O = p.U; E.ldc = INC; E.bias = nullptr; E.split_cols = 0; E.split_stride = 0;
    pg8::gemm_phase<pg8::EpiBf16<0>, pg8::StaticOrder, false>((LAS unsigned char*)dyn_lds, g, S, E, nullptr);
}
__global__ __launch_bounds__(512, 2) void k_lru_gates(Params p, int l) { for (int u = blockIdx.x; u < 272 * 8; u += gridDim.x) lru_gates_unit(p, l, u, (float*)dyn_lds); }
__global__ __launch_bounds__(512, 2) void k_chains(Params p, int l) {
    const int u = blockIdx.x;
    if (u < 64) ret_chain(p, l, u, (float*)dyn_lds); else if (u < 96) hg_chain(p, l, u - 64, (float*)dyn_lds); else lru_scan_unit(p, u - 96, (float*)dyn_lds);
}
__global__ __launch_bounds__(512, 2) void k_finish(Params p, int l) { finish_phase(p, l); }
__global__ __launch_bounds__(512, 2) void k_gemm_merge(Params p, int l) {
    pg8::Gemm g; g.A = p.Aall; g.Bt = p.wt_br + (size_t)l * 3 * 1024 * 512; g.M = 3 * MT; g.N = 3 * 1024; g.K = 512;
    SchedMerge S; S.G = (int)gridDim.x; S.c = (int)blockIdx.x;
    EpiMerge E; E.U = p.U; E.T = p.T; E.Mg = p.Mg;
    pg8::gemm_phase<EpiMerge, SchedMerge, false>((LAS unsigned char*)dyn_lds, g, S, E, nullptr);
}
__global__ __launch_bounds__(512, 2) void k_gemm_out(Params p, int l) {
    pg8::Gemm g; g.A = p.Mg; g.Bt = p.wt_out + (size_t)l * D * D; g.M = MT; g.N = D; g.K = D;
    pg8::StaticOrder S; S.init(MT, D, (int)gridDim.x, (int)blockIdx.x);
    EpiOut E; E.X = p.X; E.mod_l = p.mod + (size_t)l * 5 * 6144;
    pg8::gemm_phase<EpiOut, pg8::StaticOrder, false>((LAS unsigned char*)dyn_lds, g, S, E, nullptr);
}
__global__ __launch_bounds__(512, 2) void k_route(Params p, int l) { route_phase(p, l, (float*)dyn_lds); }
__global__ __launch_bounds__(512, 2) void k_offsets(Params p, int l) { offsets_phase(p, l); }
__global__ __launch_bounds__(512, 2) void k_gather(Params p) { gather_phase(p); }
__global__ __launch_bounds__(512, 2) void k_gemm_gu(Params p, int l) {
    pg8::Gemm g; g.A = p.Xg; g.Bt = p.wt_gu + (size_t)l * NE * 2048 * D; g.M = MAXSLOTS; g.N = NE * 2048; g.K = D;
    SchedMoE S; S.tile_e = p.tile_e; S.ntiles = p.ntiles[0]; S.nN = 8; S.G = (int)gridDim.x; S.c = (int)blockIdx.x;
    EpiGU E; E.Act = p.Act; E.bgu = p.exp_b_gu + (size_t)l * NE * 2048;
    pg8::gemm_phase<EpiGU, SchedMoE, false>((LAS unsigned char*)dyn_lds, g, S, E, nullptr);
}
__global__ __launch_bounds__(512, 2) void k_gemm_down(Params p, int l) {
    pg8::Gemm g; g.A = p.Act; g.Bt = p.wt_down + (size_t)l * NE * D * D; g.M = MAXSLOTS; g.N = NE * D; g.K = D;
    SchedMoE S; S.tile_e = p.tile_e; S.ntiles = p.ntiles[0]; S.nN = 4; S.G = (int)gridDim.x; S.c = (int)blockIdx.x;
    EpiDown E; E.Y = p.Y; E.bd = p.exp_b_down + (size_t)l * NE * D;
    pg8::gemm_phase<EpiDown, SchedMoE, false>((LAS unsigned char*)dyn_lds, g, S, E, nullptr);
}

static inline size_t align_up(size_t v, size_t a) { return (v + a - 1) / a * a; }

extern "C" void kernel_launch(void* const* d_in, const int* in_sizes, int n_in, void* d_out, int out_size, void* d_ws, size_t ws_size, hipStream_t stream) {
    (void)in_sizes; (void)n_in; (void)out_size; (void)ws_size;
    Params p{};
    const float** pin = (const float**)&p.x;
    for (int i = 0; i < 31; ++i) pin[i] = (const float*)d_in[i];
    p.out = (float*)d_out;
    char* w = (char*)d_ws; size_t off = 0;
    auto take = [&](size_t bytes) { char* r = w + off; off = align_up(off + bytes, 256); return r; };
    p.ctrl = (unsigned*)take(4096 * 4);
    p.wt_in = (bf16_t*)take((size_t)DEPTH * INC * D * 2);
    p.wt_br = (bf16_t*)take((size_t)DEPTH * 3 * 1024 * 512 * 2);
    p.wt_out = (bf16_t*)take((size_t)DEPTH * D * D * 2);
    p.wt_gu = (bf16_t*)take((size_t)DEPTH * NE * 2048 * D * 2);
    p.wt_down = (bf16_t*)take((size_t)DEPTH * NE * D * D * 2);
    p.mod = (float*)take((size_t)DEPTH * 5 * 6144 * 4);
    p.lb = (float*)take(4096 * 4);
    p.rot = (float*)take((size_t)4096 * 32 * 2 * 4);
    p.X = (float*)take((size_t)MT * D * 4);
    p.H = (bf16_t*)take((size_t)MT * D * 2);
    p.U = (bf16_t*)take((size_t)MT * INC * 2);
    p.Oret = (float*)take((size_t)2 * MT * 512 * 4);
    p.Ohg = (float*)take((size_t)2 * MT * 512 * 4);
    p.La = (float*)take((size_t)2 * MT * 512 * 4);
    p.Lb = (float*)take((size_t)2 * MT * 512 * 4);
    p.Lh = (float*)take((size_t)2 * MT * 512 * 4);
    p.Aall = (bf16_t*)take((size_t)3 * MT * 512 * 2);
    p.T = (float*)take((size_t)MT * D * 4);
    p.Mg = (bf16_t*)take((size_t)MT * D * 2);
    p.tok_e = (int*)take((size_t)MT * 4 * 4); p.tok_pos = (int*)take((size_t)MT * 4 * 4); p.slot_of = (int*)take((size_t)MT * 4 * 4); p.tok_w = (float*)take((size_t)MT * 4 * 4);
    p.pad_start = (int*)take(256); p.tile_e = (int*)take(MAXTILES * 4 + 256); p.ntiles = (int*)take(256);
    p.Xg = (bf16_t*)take((size_t)MAXSLOTS * D * 2); p.Act = (bf16_t*)take((size_t)MAXSLOTS * D * 2); p.Y = (bf16_t*)take((size_t)MAXSLOTS * D * 2);

    static bool attr_done = false;
    const int GEMM_LDS = 131072, ROUTE_LDS = 1024 * 36 * 4, CHAIN_LDS = 6 * 4096 * 4 + 4096, GATE_LDS = (4096 + 16384) * 4;
    if (!attr_done) {
        (void)hipFuncSetAttribute((const void*)k_gemm_in, hipFuncAttributeMaxDynamicSharedMemorySize, GEMM_LDS);
        (void)hipFuncSetAttribute((const void*)k_gemm_merge, hipFuncAttributeMaxDynamicSharedMemorySize, GEMM_LDS);
        (void)hipFuncSetAttribute((const void*)k_gemm_out, hipFuncAttributeMaxDynamicSharedMemorySize, GEMM_LDS);
        (void)hipFuncSetAttribute((const void*)k_gemm_gu, hipFuncAttributeMaxDynamicSharedMemorySize, GEMM_LDS);
        (void)hipFuncSetAttribute((const void*)k_gemm_down, hipFuncAttributeMaxDynamicSharedMemorySize, GEMM_LDS);
        (void)hipFuncSetAttribute((const void*)k_route, hipFuncAttributeMaxDynamicSharedMemorySize, ROUTE_LDS);
        (void)hipFuncSetAttribute((const void*)k_chains, hipFuncAttributeMaxDynamicSharedMemorySize, CHAIN_LDS);
        (void)hipFuncSetAttribute((const void*)k_lru_gates, hipFuncAttributeMaxDynamicSharedMemorySize, GATE_LDS);
        attr_done = true;
    }
    (void)hipMemsetAsync(p.ctrl, 0, 4096 * 4, stream);
    k_convert<<<dim3(INC / 64, D / 64, DEPTH), 256, 0, stream>>>(p.w_in, p.wt_in, D, INC, (size_t)D * INC, (size_t)INC * D, 0);
    k_convert<<<dim3(1024 / 64, 512 / 64, DEPTH), 256, 0, stream>>>(p.w_ret_o, p.wt_br, 512, 1024, (size_t)512 * 1024, (size_t)3 * 1024 * 512, 0);
    k_convert<<<dim3(1024 / 64, 512 / 64, DEPTH), 256, 0, stream>>>(p.w_hgrn_o, p.wt_br + (size_t)1024 * 512, 512, 1024, (size_t)512 * 1024, (size_t)3 * 1024 * 512, 0);
    k_convert<<<dim3(1024 / 64, 512 / 64, DEPTH), 256, 0, stream>>>(p.w_lru_o, p.wt_br + (size_t)2 * 1024 * 512, 512, 1024, (size_t)512 * 1024, (size_t)3 * 1024 * 512, 0);
    k_convert<<<dim3(D / 64, D / 64, DEPTH), 256, 0, stream>>>(p.w_out, p.wt_out, D, D, (size_t)D * D, (size_t)D * D, 0);
    k_convert<<<dim3(2048 / 64, D / 64, DEPTH * NE), 256, 0, stream>>>(p.exp_w_gu, p.wt_gu, D, 2048, (size_t)D * 2048, (size_t)2048 * D, 1);
    k_convert<<<dim3(D / 64, D / 64, DEPTH * NE), 256, 0, stream>>>(p.exp_w_down, p.wt_down, D, D, (size_t)D * D, (size_t)D * D, 0);
    k_mod<<<dim3(96, DEPTH), 512, 0, stream>>>(p);
    k_small<<<(4096 * 32 + 255) / 256, 256, 0, stream>>>(p);
    const int G = 256;
    k_norm0<<<G * 4, 512, 0, stream>>>(p);
    for (int l = 0; l < DEPTH; ++l) {
        if (l > 0) k_norm1<<<G * 4, 512, 0, stream>>>(p, l);
        k_gemm_in<<<G, 512, GEMM_LDS, stream>>>(p, l);
        k_lru_gates<<<G * 2, 512, GATE_LDS, stream>>>(p, l);
        k_chains<<<160, 512, CHAIN_LDS, stream>>>(p, l);
        k_finish<<<G * 4, 512, 0, stream>>>(p, l);
        k_gemm_merge<<<G, 512, GEMM_LDS, stream>>>(p, l);
        k_gemm_out<<<G, 512, GEMM_LDS, stream>>>(p, l);
        k_route<<<G, 512, ROUTE_LDS, stream>>>(p, l);
        k_offsets<<<1, 512, 0, stream>>>(p, l);
        k_gather<<<G * 4, 512, 0, stream>>>(p);
        k_gemm_gu<<<G, 512, GEMM_LDS, stream>>>(p, l);
        k_gemm_down<<<G, 512, GEMM_LDS, stream>>>(p, l);
    }
    k_norm2<<<G * 4, 512, 0, stream>>>(p);
}
```

```cpp
#include <hip/hip_runtime.h>
#include <cstdio>
#include <cstdint>
__device__ __forceinline__ int pg8_tid_fresh() { int t = threadIdx.x; asm volatile("" : "+v"(t)); return t; }
namespace pg8 {
#define PG8_LAS __attribute__((address_space(3)))
typedef unsigned short bf16_t;
typedef short bf16x8 __attribute__((ext_vector_type(8)));
typedef float f32x4 __attribute__((ext_vector_type(4)));
typedef unsigned u32x4 __attribute__((ext_vector_type(4)));
constexpr int BM = 256, BK = 64, HALF = 128, HTB = HALF * BK * 2  , STAGE_BYTES = 8 * HTB, NXCD = 8, WGM = 8;

__host__ __device__ __forceinline__ int lds_byte(int r, int c) { const int st = (r >> 4) * 2 + (c >> 5), rr = r & 15, cc = c & 31, ob = rr * 64 + cc * 2; return st * 1024 + (ob ^ (((ob >> 9) & 1) << 5)); }
__host__ __device__ __forceinline__ void stage_rc(int b, int& R, int& C) { const int st = b / 1024, sb = b % 1024, swz = sb ^ (((sb >> 9) & 1) << 5); R = (st >> 1) * 16 + swz / 64; C = (st & 1) * 32 + (swz % 64) / 2; }
__host__ __device__ __forceinline__ int perm32(int rho) { const int n = rho >> 4, i = rho & 15; return 8 * (i >> 2) + 4 * n + (i & 3); }

struct Unit { int pm, pn, po; };
struct Gemm { const bf16_t* A; const bf16_t* Bt; int M, N, K; };

struct StaticOrder {
    int nM, nN, nwg, G, c;
    __host__ __device__ void init(int M, int N, int G_, int c_) { nM = M / BM; nN = N / BM; nwg = nM * nN; G = G_; c = c_; }
    __host__ __device__ bool next(int i, Unit& u) const {
        const long L = (long)i * G + c; if (L >= nwg) return false;
        int wgid = (int)L; { const int q = nwg / NXCD, r = nwg % NXCD, xcd = wgid % NXCD, off = wgid / NXCD; wgid = (xcd < r ? xcd * (q + 1) : r * (q + 1) + (xcd - r) * q) + off; }
        const int nig = WGM * nN, gid = wgid / nig, fm = gid * WGM, gsz = (nM - fm) < WGM ? (nM - fm) : WGM;
        u.pm = fm + ((wgid % nig) % gsz); u.pn = (wgid % nig) / gsz; return true;
    }
    __device__ __forceinline__ void a_ready(const Unit&) const {}
    __device__ __forceinline__ void done(const Unit&) const {}
};
__device__ __forceinline__ unsigned cvt_pk_bf16(float lo, float hi) { unsigned r; asm volatile("v_cvt_pk_bf16_f32 %0, %1, %2" : "=v"(r) : "v"(lo), "v"(hi)); return r; }
typedef float f32x2 __attribute__((ext_vector_type(2)));
__device__ __forceinline__ f32x2 gelu_pk(f32x2 v) {
    const f32x2 av = __builtin_elementwise_abs(v), d = av * 0.2316418882f + 1.0f;
    f32x2 t; t.x = __builtin_amdgcn_rcpf(d.x); t.y = __builtin_amdgcn_rcpf(d.y);
    f32x2 q = t * 0.5307027145f + (-0.7265760135f); q = q * t + 0.7107068705f; q = q * t + (-0.142248368f); q = q * t + 0.127414796f; q = q * t;
    const f32x2 s = (v * v) * (-0.72134752044f);
    f32x2 e; e.x = __builtin_amdgcn_exp2f(s.x); e.y = __builtin_amdgcn_exp2f(s.y);
    const f32x2 m = v * (q * e), r = v - m;
    f32x2 o; o.x = v.x < 0.f ? m.x : r.x; o.y = v.y < 0.f ? m.y : r.y; return o;
}

template <int ACT  > struct EpiBf16 {
    static constexpr bool PERM = true, AFTER_DRAIN = false;
    bf16_t* O; int ldc; const float* bias; int split_cols; size_t split_stride;
    __device__ __forceinline__ void operator()(const f32x4 (&acc)[2][2][4][2], const Unit& u, int wr, int wc, int fr, int fq) const {
        const int row0 = u.pm * BM + wr * 64 + fr; int colt = u.pn * BM; bf16_t* base = O;
        if (split_cols) { const int t = colt / split_cols; base += (size_t)t * split_stride; colt -= t * split_cols; }
        const int col0 = colt + wc * 32 + 8 * fq, bcol0 = u.pn * BM + wc * 32 + 8 * fq;
        f32x4 bv[2][2];
#pragma unroll
        for (int bj = 0; bj < 2; ++bj)
#pragma unroll
            for (int n = 0; n < 2; ++n) bv[bj][n] = bias ? *(const f32x4*)(bias + bcol0 + bj * HALF + 4 * n) : (f32x4){0.f, 0.f, 0.f, 0.f};
#pragma unroll
        for (int ai = 0; ai < 2; ++ai)
#pragma unroll
            for (int m = 0; m < 4; ++m) { bf16_t* rowp = base + (size_t)(row0 + ai * HALF + m * 16) * ldc + col0;
#pragma unroll
                for (int bj = 0; bj < 2; ++bj) { f32x4 v0 = acc[ai][bj][m][0] + bv[bj][0], v1 = acc[ai][bj][m][1] + bv[bj][1];
                    if (ACT == 1) { f32x2 a = gelu_pk((f32x2){v0[0], v0[1]}), b = gelu_pk((f32x2){v0[2], v0[3]}), c = gelu_pk((f32x2){v1[0], v1[1]}), d = gelu_pk((f32x2){v1[2], v1[3]});
                        v0 = (f32x4){a.x, a.y, b.x, b.y}; v1 = (f32x4){c.x, c.y, d.x, d.y}; }
                    if (ACT == 2) {
#pragma unroll
                        for (int j = 0; j < 4; ++j) { v0[j] = 0.5f * v0[j] * (1.0f + erff(v0[j] * 0.70710678f)); v1[j] = 0.5f * v1[j] * (1.0f + erff(v1[j] * 0.70710678f)); } }
                    u32x4 w; w.x = cvt_pk_bf16(v0[0], v0[1]); w.y = cvt_pk_bf16(v0[2], v0[3]); w.z = cvt_pk_bf16(v1[0], v1[1]); w.w = cvt_pk_bf16(v1[2], v1[3]);
                    *(u32x4*)(rowp + bj * HALF) = w; } }
    }
};


typedef int i32x4_f8 __attribute__((ext_vector_type(4)));
typedef int i32x8_f8 __attribute__((ext_vector_type(8)));
template <class Epi, class Sched, bool ALIGN_EPI = false, bool SP2 = false, bool F8 = false>
__device__ __forceinline__ void gemm_phase(PG8_LAS unsigned char* lds, const Gemm g, const Sched& S, const Epi& E) {
    const int tid = pg8_tid_fresh(), wid = __builtin_amdgcn_readfirstlane(tid >> 6), lane = tid & 63, wr = wid >> 2, wc = wid & 3, fr = lane & 15, fq = lane >> 4;
    const int K = g.K, nt = K / BK;
    unsigned voffA[2], voffB[2];
#pragma unroll
    for (int i = 0; i < 2; ++i) { int R, C; stage_rc(tid * 16 + i * 8192, R, C); const int Rb = Epi::PERM ? ((R & ~31) + perm32(R & 31)) : R;
        voffA[i] = (unsigned)(R * K + C) * 2u; voffB[i] = (unsigned)(Rb * K + C) * 2u; }
    const size_t kstep = (size_t)(BK * 2);
    const size_t hstep = (size_t)HALF * K * 2;
    const size_t tstep = 2 * hstep;
    const unsigned ldsw = (unsigned)wid * 1024u;
    const int aoff = lds_byte(wr * 64 + fr, fq * 8), boff = lds_byte(wc * 32 + fr, fq * 8);
#define PG8_SA(b, h) (((b) * 2 + (h)) * HTB)
#define PG8_SB(b, h) ((4 + (b) * 2 + (h)) * HTB)
#define PG8_STAGE(bufoff, gbase, voff) do { _Pragma("unroll") for (int _i = 0; _i < 2; ++_i) \
        __builtin_amdgcn_global_load_lds((const unsigned*)((const char*)(gbase) + (voff)[_i]), (PG8_LAS unsigned*)(lds + (bufoff) + ldsw + _i * 8192), 16, 0, 0); } while (0)
#define PG8_LDA(dst, b, h) do { if constexpr (F8) { _Pragma("unroll") for (int m = 0; m < 4; ++m) dst##8[m] = __builtin_shufflevector(*(const PG8_LAS i32x4_f8*)(lds + PG8_SA(b, h) + aoff + m * 2048), *(const PG8_LAS i32x4_f8*)(lds + PG8_SA(b, h) + aoff + m * 2048 + 1024), 0, 1, 2, 3, 4, 5, 6, 7); } \
        else { _Pragma("unroll") for (int m = 0; m < 4; ++m) _Pragma("unroll") for (int k = 0; k < 2; ++k) dst[m][k] = *(const PG8_LAS bf16x8*)(lds + PG8_SA(b, h) + aoff + m * 2048 + k * 1024); } } while (0)
#define PG8_LDB(dst, b, h) do { if constexpr (F8) { _Pragma("unroll") for (int n = 0; n < 2; ++n) dst##8[n] = __builtin_shufflevector(*(const PG8_LAS i32x4_f8*)(lds + PG8_SB(b, h) + boff + n * 2048), *(const PG8_LAS i32x4_f8*)(lds + PG8_SB(b, h) + boff + n * 2048 + 1024), 0, 1, 2, 3, 4, 5, 6, 7); } \
        else { _Pragma("unroll") for (int n = 0; n < 2; ++n) _Pragma("unroll") for (int k = 0; k < 2; ++k) dst[n][k] = *(const PG8_LAS bf16x8*)(lds + PG8_SB(b, h) + boff + n * 2048 + k * 1024); } } while (0)
#define PG8_MMA(ai, bj, At, Bt) do { __builtin_amdgcn_s_setprio(1); _Pragma("unroll") for (int m = 0; m < 4; ++m) _Pragma("unroll") for (int n = 0; n < 2; ++n) { \
        if constexpr (F8) { asm volatile("v_mfma_f32_16x16x128_f8f6f4 %0, %1, %2, %0" : "+v"(acc[ai][bj][m][n]) : "v"(Bt##8[n]), "v"(At##8[m])); } \
        else { _Pragma("unroll") for (int k = 0; k < 2; ++k) acc[ai][bj][m][n] = __builtin_amdgcn_mfma_f32_16x16x32_bf16(Bt[n][k], At[m][k], acc[ai][bj][m][n], 0, 0, 0); } } \
        __builtin_amdgcn_s_setprio(0); } while (0)
#define PG8_WAIT_V(n) asm volatile("s_waitcnt vmcnt(" #n ")" ::: "memory")
#define PG8_WAIT_L(n) asm volatile("s_waitcnt lgkmcnt(" #n ")" ::: "memory")
#define PG8_BAR __builtin_amdgcn_s_barrier()
#define PG8_SCHED __builtin_amdgcn_sched_barrier(0)
    Unit cur, nxt; int ui = 0;
    if (!S.next(0, cur)) return;
    float zf = 0.f; asm volatile("" : "+v"(zf));
    f32x4 acc[2][2][4][2];
#pragma unroll
    for (int a = 0; a < 2; ++a)
#pragma unroll
        for (int b = 0; b < 2; ++b)
#pragma unroll
            for (int m = 0; m < 4; ++m)
#pragma unroll
                for (int n = 0; n < 2; ++n) acc[a][b][m][n] = (f32x4){zf, zf, zf, zf};
    bf16x8 At[4][2], B0[2][2], B1[2][2]; i32x8_f8 At8[4], B08[2], B18[2];
    const char* cA = (const char*)g.A + (size_t)cur.pm * tstep; const char* cB = (const char*)g.Bt + (size_t)cur.pn * tstep;
    S.a_ready(cur);
    if constexpr (SP2) {
        PG8_STAGE(PG8_SB(0, 0), cB, voffB); PG8_STAGE(PG8_SB(0, 1), cB + hstep, voffB); PG8_STAGE(PG8_SA(0, 0), cA, voffA); PG8_STAGE(PG8_SA(0, 1), cA + hstep, voffA);
        if (wr == 1) PG8_BAR;
        PG8_WAIT_V(2); PG8_BAR;
        PG8_STAGE(PG8_SB(1, 0), cB + kstep, voffB); PG8_STAGE(PG8_SA(1, 0), cA + kstep, voffA); PG8_STAGE(PG8_SB(1, 1), cB + hstep + kstep, voffB);
        PG8_WAIT_V(6); PG8_BAR;
    } else {
        PG8_STAGE(PG8_SB(0, 0), cB, voffB); PG8_STAGE(PG8_SA(0, 0), cA, voffA); PG8_STAGE(PG8_SB(0, 1), cB + hstep, voffB); PG8_STAGE(PG8_SA(0, 1), cA + hstep, voffA);
        if (wr == 1) PG8_BAR;
        PG8_WAIT_V(4); PG8_BAR;
        PG8_STAGE(PG8_SB(1, 0), cB + kstep, voffB); PG8_STAGE(PG8_SA(1, 0), cA + kstep, voffA); PG8_STAGE(PG8_SB(1, 1), cB + hstep + kstep, voffB);
        PG8_WAIT_V(6); PG8_BAR;
    }
    for (;;) {
        const bool has_next = S.next(ui + 1, nxt);
        const char* nA = has_next ? (const char*)g.A + (size_t)nxt.pm * tstep : cA; const char* nB = has_next ? (const char*)g.Bt + (size_t)nxt.pn * tstep : cB;
        for (int t = 0; t < nt; t += 2) {
            const bool last = (t == nt - 2);
            const char* a1 = cA + (size_t)(t + 1) * kstep;
            const char* a2 = last ? nA : cA + (size_t)(t + 2) * kstep; const char* b2 = last ? nB : cB + (size_t)(t + 2) * kstep;
            const char* a3 = a2 + kstep; const char* b3 = b2 + kstep;
            if (last && has_next) S.a_ready(nxt);
            if constexpr (SP2) {
            PG8_LDB(B0, 0, 0); PG8_LDB(B1, 0, 1); PG8_SCHED; PG8_LDA(At, 0, 0); PG8_STAGE(PG8_SA(1, 1), a1 + hstep, voffA);
            PG8_WAIT_V(8); PG8_WAIT_L(0); PG8_BAR; PG8_MMA(0, 0, At, B0); PG8_MMA(0, 1, At, B1); PG8_BAR; PG8_SCHED;
            PG8_LDA(At, 0, 1); PG8_STAGE(PG8_SB(0, 0), b2, voffB); PG8_STAGE(PG8_SB(0, 1), b2 + hstep, voffB); PG8_STAGE(PG8_SA(0, 0), a2, voffA);
            PG8_WAIT_V(8); PG8_WAIT_L(0); PG8_BAR; PG8_MMA(1, 0, At, B0); PG8_MMA(1, 1, At, B1); PG8_BAR; PG8_SCHED;
            PG8_LDB(B0, 1, 0); PG8_LDB(B1, 1, 1); PG8_SCHED; PG8_LDA(At, 1, 0); PG8_STAGE(PG8_SA(0, 1), a2 + hstep, voffA);
            PG8_WAIT_V(8); PG8_WAIT_L(0); PG8_BAR; PG8_MMA(0, 0, At, B0); PG8_MMA(0, 1, At, B1); PG8_BAR; PG8_SCHED;
            PG8_LDA(At, 1, 1); PG8_STAGE(PG8_SB(1, 0), b3, voffB); PG8_STAGE(PG8_SB(1, 1), b3 + hstep, voffB); PG8_STAGE(PG8_SA(1, 0), a3, voffA);
            PG8_WAIT_V(8); PG8_WAIT_L(0); PG8_BAR; PG8_MMA(1, 0, At, B0); PG8_MMA(1, 1, At, B1); PG8_BAR; PG8_SCHED;
            } else {
            PG8_LDB(B0, 0, 0); PG8_SCHED; PG8_LDA(At, 0, 0); PG8_STAGE(PG8_SA(1, 1), a1 + hstep, voffA);
            PG8_WAIT_L(8); PG8_BAR; PG8_WAIT_L(0); PG8_MMA(0, 0, At, B0); PG8_BAR; PG8_SCHED;
            PG8_LDB(B1, 0, 1); PG8_STAGE(PG8_SB(0, 0), b2, voffB);
            PG8_BAR; PG8_WAIT_L(0); PG8_MMA(0, 1, At, B1); PG8_BAR;
            PG8_LDA(At, 0, 1); PG8_STAGE(PG8_SA(0, 0), a2, voffA);
            PG8_BAR; PG8_WAIT_L(0); PG8_MMA(1, 0, At, B0); PG8_BAR; PG8_SCHED;
            PG8_STAGE(PG8_SB(0, 1), b2 + hstep, voffB);
            PG8_WAIT_V(6); PG8_BAR; PG8_MMA(1, 1, At, B1); PG8_BAR;
            PG8_LDB(B0, 1, 0); PG8_SCHED; PG8_LDA(At, 1, 0); PG8_STAGE(PG8_SA(0, 1), a2 + hstep, voffA);
            PG8_WAIT_L(8); PG8_BAR; PG8_WAIT_L(0); PG8_MMA(0, 0, At, B0); PG8_BAR; PG8_SCHED;
            PG8_LDB(B1, 1, 1); PG8_STAGE(PG8_SB(1, 0), b3, voffB);
            PG8_BAR; PG8_WAIT_L(0); PG8_MMA(0, 1, At, B1); PG8_BAR;
            PG8_LDA(At, 1, 1); PG8_STAGE(PG8_SA(1, 0), a3, voffA);
            PG8_BAR; PG8_WAIT_L(0); PG8_MMA(1, 0, At, B0); PG8_BAR; PG8_SCHED;
            PG8_STAGE(PG8_SB(1, 1), b3 + hstep, voffB);
            PG8_WAIT_V(6); PG8_BAR; PG8_MMA(1, 1, At, B1); PG8_BAR;
            }
        }
        if constexpr (ALIGN_EPI) { if (wr == 0) PG8_BAR; }
        if constexpr (F8) asm volatile("s_nop 15\n\ts_nop 15" ::: "memory");
        if constexpr (!Epi::AFTER_DRAIN) { E(acc, cur, wr, wc, fr, fq); S.done(cur); }
        if (!has_next) break;
#pragma unroll
        for (int a = 0; a < 2; ++a)
#pragma unroll
            for (int b = 0; b < 2; ++b)
#pragma unroll
                for (int m = 0; m < 4; ++m)
#pragma unroll
                    for (int n = 0; n < 2; ++n) acc[a][b][m][n] = (f32x4){zf, zf, zf, zf};
        cur = nxt; cA = nA; cB = nB; ++ui;
        if constexpr (ALIGN_EPI) { if (wr == 1) PG8_BAR; }
    }
    PG8_WAIT_V(0);
    if constexpr (!ALIGN_EPI) { if (wr == 0) PG8_BAR; }
    PG8_BAR;
    if constexpr (Epi::AFTER_DRAIN) { E.fused(acc, cur, wr, wc, fr, fq, lds, wid, lane); S.done(cur); }
#undef PG8_SA
#undef PG8_SB
#undef PG8_STAGE
#undef PG8_LDA
#undef PG8_LDB
#undef PG8_MMA
#undef PG8_WAIT_V
#undef PG8_WAIT_L
#undef PG8_BAR
#undef PG8_SCHED
}
}
#include <hip/hip_runtime.h>
#include <cstdio>
#include <cstdint>
#include <cstdlib>
#include <vector>

#define XB_TMO      128
#define XB_XCNT(j)  (256  + 64 * (j))
#define XB_XSUB(j)  (1280 + 64 * (j))
#define XB_XGEN(j)  (2304 + 64 * (j))
#define XB_TOP      3328
#define XB_TOPGEN   3392
#define XCD_BAR_WORDS 3456
#define XB_SPIN_CAP (1u << 18)
#ifndef LAS
#define LAS __attribute__((address_space(3)))
#endif

__device__ __forceinline__ unsigned xb_ld(unsigned* p)              { return __hip_atomic_load(p, __ATOMIC_RELAXED, __HIP_MEMORY_SCOPE_AGENT); }
__device__ __forceinline__ unsigned xb_add(unsigned* p, unsigned v) { return __hip_atomic_fetch_add(p, v, __ATOMIC_RELAXED, __HIP_MEMORY_SCOPE_AGENT); }
__device__ __forceinline__ unsigned xb_xcc_id() { return (unsigned)__builtin_amdgcn_s_getreg((3 << 11) | 20) & 0xFu; }
#define XB_SPIN(cond, bar) do { unsigned _sp = 0; while (cond) { __builtin_amdgcn_s_sleep(1); \
    if ((++_sp & 255u) == 0u) { if (xb_ld(&(bar)[XB_TMO])) break; if (_sp > XB_SPIN_CAP) { atomicAdd(&(bar)[XB_TMO], 1u); break; } } } } while (0)

struct XcdBarrier {
    unsigned* bar; unsigned x;
    volatile LAS unsigned* st;
};

__device__ __forceinline__ XcdBarrier xcd_barrier_post(unsigned* bar, volatile LAS unsigned* st) {
    XcdBarrier b; b.bar = bar; b.x = xb_xcc_id(); b.st = st;
    if (threadIdx.x == 0) (void)xb_add(&bar[XB_XCNT(b.x)], 1u);
    return b;
}
__device__ __forceinline__ void xcd_barrier_complete(unsigned* bar, unsigned x, unsigned& nloc, unsigned& nx) {
    const unsigned G = gridDim.x * gridDim.y * gridDim.z;
    unsigned sum, cnt, mine, sp = 0u;
    for (;;) {
        sum = 0u; cnt = 0u; mine = 0u;
#pragma unroll
        for (unsigned j = 0; j < 16; ++j) { const unsigned c = xb_ld(&bar[XB_XCNT(j)]); sum += c; cnt += (c > 0u) ? 1u : 0u; mine = (j == x) ? c : mine; }
        if (sum == G) break;
        __builtin_amdgcn_s_sleep(1);
        if ((++sp & 255u) == 0u) { if (xb_ld(&bar[XB_TMO])) break; if (sp > XB_SPIN_CAP) { atomicAdd(&bar[XB_TMO], 1u); break; } }
    }
    nloc = mine > 0u ? mine : 1u; nx = cnt > 0u ? cnt : 1u;
}

__device__ __forceinline__ void xcd_barrier(const XcdBarrier& b) {
    asm volatile("s_waitcnt vmcnt(0)" ::: "memory");
    __syncthreads();
    if (threadIdx.x == 0) {
        unsigned* bar = b.bar;
        __builtin_amdgcn_s_waitcnt(0);
        unsigned nloc = b.st[0], nx = b.st[1];
        if (nloc == 0u) { xcd_barrier_complete(bar, b.x, nloc, nx); b.st[0] = nloc; b.st[1] = nx; }
        const unsigned old = xb_add(&bar[XB_XSUB(b.x)], 1u);
        const unsigned gen = old / nloc;
        if (old + 1u == (gen + 1u) * nloc) {
            __builtin_amdgcn_fence(__ATOMIC_RELEASE, "agent");
            asm volatile("s_waitcnt vmcnt(0)" ::: "memory");
            const unsigned og = xb_add(&bar[XB_TOP], 1u);
            const unsigned tg = og / nx;
            if (og + 1u == (tg + 1u) * nx) xb_add(&bar[XB_TOPGEN], 1u);
            else XB_SPIN(xb_ld(&bar[XB_TOPGEN]) == tg, bar);
            __builtin_amdgcn_fence(__ATOMIC_ACQUIRE, "agent");
            xb_add(&bar[XB_XGEN(b.x)], 1u);
            asm volatile("s_waitcnt vmcnt(0)" ::: "memory");
        } else {
            XB_SPIN(xb_ld(&bar[XB_XGEN(b.x)]) == gen, bar);
            __builtin_amdgcn_fence(__ATOMIC_ACQUIRE, "agent");
            asm volatile("s_waitcnt vmcnt(0)" ::: "memory");
        }
    }
    __syncthreads();
}


typedef unsigned short bf16_t;
using pg8::f32x4; using pg8::u32x4; using pg8::Unit;
typedef unsigned u32x2 __attribute__((ext_vector_type(2)));
#define LAS __attribute__((address_space(3)))
#define TIDX pg8_tid_fresh()

constexpr int D = 1024, NB = 4, SEQ = 4096, DEPTH = 4, LC = 256, LT = SEQ + LC, MT = NB * LT;
constexpr int INC = 8704;
constexpr int C_RQ = 0, C_RK = 512, C_RV = 1024, C_RG = 1536, C_HQ = 2048, C_HFF = 2560, C_HFB = 3072, C_HI = 3584, C_HGT = 4096, C_LX = 4608, C_LGT = 5120, C_GR = 5632;
constexpr float W8_SCALE = 64.0f;
constexpr int NE = 32, MAXTILES = 304, MAXSLOTS = MAXTILES * 256, CAPT = 68;
constexpr int TB_OFF = 131072;
constexpr int NTHREADS = 512;

struct Params {
    const float *x, *c, *ctx, *c_ctx, *mod_w, *mod_b, *norm1_g, *norm2_g, *final_g, *w_in, *ret_decay, *ret_gn_g, *w_ret_o, *hgrn_lb_logits, *hgrn_gn_g, *w_hgrn_o,
        *lru_conv_w, *lru_conv_b, *lru_wa, *lru_ba, *lru_wx, *lru_bx, *lru_lambda, *w_lru_o, *w_out, *router_w, *router_b, *exp_w_gu, *exp_b_gu, *exp_w_down, *exp_b_down;
    float* out;
    bf16_t *wt_in, *wt_br, *wt_out; unsigned char *wt_gu, *wt_down;
    float *mod, *lb, *rot;
    bf16_t* X; bf16_t* H; unsigned char* H8; unsigned char* wt_ing; bf16_t* U;
    bf16_t *Oret, *Ohg, *Dummy; unsigned* PH;
    bf16_t *RQ, *RK, *HQ, *HK; float *HA, *SE, *SG, *LP, *LH, *LS;
    bf16_t* Aall; bf16_t* R; bf16_t* Mg; bf16_t* Dx;
    unsigned* bar; unsigned* ctrl;
    int *tok_e, *tok_pos; float* tok_w;
    float *RWp, *RC;
    unsigned char *Xg, *Act; unsigned char* Y;
};

__device__ __forceinline__ float bf2f(bf16_t v) { return __uint_as_float(((unsigned)v) << 16); }
__device__ __forceinline__ float bflo(unsigned w) { return __uint_as_float(w << 16); }
__device__ __forceinline__ float bfhi(unsigned w) { return __uint_as_float(w & 0xffff0000u); }
__device__ __forceinline__ float sigmoidf_(float x) { return __builtin_amdgcn_rcpf(1.0f + __expf(-x)); }
__device__ __forceinline__ float shx(float v, int o, int lane) { return __int_as_float(__builtin_amdgcn_ds_bpermute((lane ^ o) << 2, __float_as_int(v))); }
__device__ __forceinline__ float wave_sum(float v, int lane) {
#pragma unroll
    for (int o = 32; o >= 1; o >>= 1) v += shx(v, o, lane);
    return v;
}

extern __shared__ __attribute__((aligned(16))) unsigned char dyn_lds[];
__device__ __forceinline__ unsigned char* dyn_lds_base() { return dyn_lds; }
typedef short bf16x8_t __attribute__((ext_vector_type(8)));
typedef short s16x4_t __attribute__((ext_vector_type(4)));
typedef float f32x16_t __attribute__((ext_vector_type(16)));
typedef float f32x2_t __attribute__((ext_vector_type(2)));
typedef __bf16 bf16v2_t __attribute__((ext_vector_type(2)));
constexpr int NCH = MT / 32;
#define MFMA32(a, b, c) __builtin_amdgcn_mfma_f32_32x32x16_bf16((a), (b), (c), 0, 0, 0)

#define GAS __attribute__((address_space(1)))
__device__ __forceinline__ const GAS char* uni_ptr(const void* p) { const unsigned long long v = (unsigned long long)p;
    const unsigned lo = __builtin_amdgcn_readfirstlane((unsigned)v), hi = __builtin_amdgcn_readfirstlane((unsigned)(v >> 32)); return (const GAS char*)(((unsigned long long)hi << 32) | lo); }
__device__ __forceinline__ unsigned pk_fp8x4(float a, float b, float c, float d) {
    a = fminf(fmaxf(a, -448.f), 448.f); b = fminf(fmaxf(b, -448.f), 448.f); c = fminf(fmaxf(c, -448.f), 448.f); d = fminf(fmaxf(d, -448.f), 448.f);
    int t = __builtin_amdgcn_cvt_pk_fp8_f32(a, b, 0, false); t = __builtin_amdgcn_cvt_pk_fp8_f32(c, d, t, true); return (unsigned)t; }
__device__ __forceinline__ unsigned pk_bf16(float a, float b) { const f32x2_t v = {a, b}; return __builtin_bit_cast(unsigned, __builtin_convertvector(v, bf16v2_t)); }
template <int s> __device__ __forceinline__ bf16x8_t pack8(const f32x16_t& x) {
    u32x4 w; w[0] = pk_bf16(x[8 * s], x[8 * s + 1]); w[1] = pk_bf16(x[8 * s + 2], x[8 * s + 3]); w[2] = pk_bf16(x[8 * s + 4], x[8 * s + 5]); w[3] = pk_bf16(x[8 * s + 6], x[8 * s + 7]);
    return __builtin_bit_cast(bf16x8_t, w);
}
__device__ __forceinline__ bf16x8_t frag_row(const LAS char* t, int pitch, int row, int colbase) {
    const s16x4_t lo = *(const LAS s16x4_t*)(t + row * pitch + colbase * 2), hi = *(const LAS s16x4_t*)(t + row * pitch + colbase * 2 + 16);
    return __builtin_shufflevector(lo, hi, 0, 1, 2, 3, 4, 5, 6, 7);
}
__device__ __forceinline__ bf16x8_t frag_tr(const LAS char* t, int pitch, int jb, int ct, int lane) {
    const int q = (lane & 15) >> 2, pp = lane & 3, blk = (lane >> 4) & 1;
    const LAS char* a0 = t + (jb + q) * pitch + (32 * ct + 16 * blk + 4 * pp) * 2;
    const s16x4_t lo = __builtin_amdgcn_ds_read_tr16_b64_v4i16((LAS s16x4_t*)a0), hi = __builtin_amdgcn_ds_read_tr16_b64_v4i16((LAS s16x4_t*)(a0 + 8 * pitch));
    return __builtin_shufflevector(lo, hi, 0, 1, 2, 3, 4, 5, 6, 7);
}


__device__ __forceinline__ void build_tile_table(const Params& p, int l) {
    LAS int* te = (LAS int*)((LAS char*)dyn_lds_base() + TB_OFF); LAS int* tb = te + MAXTILES; LAS int* tc = tb + NE + 1; const int t = TIDX;
    if (t < NE) tc[t] = ((int)p.ctrl[l * 64 + t] + 255) >> 8;
    __syncthreads();
    if (t <= NE) { int s = 0;
#pragma unroll 1
        for (int k = 0; k < t; ++k) s += tc[k];
        tb[t] = s; }
    __syncthreads();
    if (t < MAXTILES) { int e = 0;
#pragma unroll 1
        for (int k = 1; k < NE; ++k) e += (tb[k] <= t) ? 1 : 0;
        te[t] = e; }
    __syncthreads();
}

__device__ __forceinline__ void convert_tiles(const float* __restrict__ src, bf16_t* __restrict__ dst, int K, int N, size_t sstride, size_t dstride, int mode, int nbatch, float* lds, int f8 = 0, int ld = 0) {
    const int t = TIDX & 255, half = TIDX >> 8; float* tile = lds + half * (64 * 65); if (ld == 0) ld = N;
    const int tn = N / 64, tk = K / 64, per = tn * tk, total = per * nbatch, stride = gridDim.x * 2, hb = blockIdx.x * 2 + half;
    const int iters = (total + stride - 1) / stride;
    for (int it = 0; it < iters; ++it) {
        const int idx = it * stride + hb; const bool valid = idx < total;
        const int bz = idx / per, rem = idx - bz * per, ky = rem / tn, nx = rem - ky * tn; const int n0 = nx * 64, k0 = ky * 64;
        if (valid) { const float* s = src + (size_t)bz * sstride;
#pragma unroll
            for (int i = 0; i < 4; ++i) { const int r = (t >> 4) + 16 * i, cq = (t & 15) * 4; const float4 v = *(const float4*)(s + (size_t)(k0 + r) * ld + n0 + cq);
                tile[r * 65 + cq] = v.x; tile[r * 65 + cq + 1] = v.y; tile[r * 65 + cq + 2] = v.z; tile[r * 65 + cq + 3] = v.w; } }
        __syncthreads();
        if (valid) { bf16_t* d = dst + (size_t)bz * dstride; const int n = t >> 2, kq = (t & 3) * 16;
            int nd = n0 + n; if (mode == 1) { const int j = nd & 1023, up = nd >> 10; nd = (j >> 7) * 256 + up * 128 + (j & 127); }
            if (f8) { unsigned w[4];
#pragma unroll
                for (int i = 0; i < 4; ++i) w[i] = pk_fp8x4(W8_SCALE * tile[(kq + 4 * i) * 65 + n], W8_SCALE * tile[(kq + 4 * i + 1) * 65 + n], W8_SCALE * tile[(kq + 4 * i + 2) * 65 + n], W8_SCALE * tile[(kq + 4 * i + 3) * 65 + n]);
                *(uint4*)((unsigned char*)dst + (size_t)bz * dstride + (size_t)nd * K + k0 + kq) = make_uint4(w[0], w[1], w[2], w[3]);
            } else { unsigned w[8];
#pragma unroll
            for (int i = 0; i < 8; ++i) w[i] = pg8::cvt_pk_bf16(tile[(kq + 2 * i) * 65 + n], tile[(kq + 2 * i + 1) * 65 + n]);
            uint4* o = (uint4*)(d + (size_t)nd * K + k0 + kq); o[0] = make_uint4(w[0], w[1], w[2], w[3]); o[1] = make_uint4(w[4], w[5], w[6], w[7]); } }
        __syncthreads();
    }
}
__device__ __forceinline__ void convert_phase(const Params& p, float* lds) {
    convert_tiles(p.w_in, p.wt_in, D, C_GR, (size_t)D * INC, (size_t)INC * D, 0, DEPTH, lds, 0, INC);
    convert_tiles(p.w_in + C_GR, (bf16_t*)p.wt_ing, D, INC - C_GR, (size_t)D * INC, (size_t)(INC - C_GR) * D, 0, DEPTH, lds, 1, INC);
    convert_tiles(p.w_ret_o, p.wt_br, 512, 1024, (size_t)512 * 1024, (size_t)3 * 1024 * 512, 0, DEPTH, lds);
    convert_tiles(p.w_hgrn_o, p.wt_br + (size_t)1024 * 512, 512, 1024, (size_t)512 * 1024, (size_t)3 * 1024 * 512, 0, DEPTH, lds);
    convert_tiles(p.w_lru_o, p.wt_br + (size_t)2 * 1024 * 512, 512, 1024, (size_t)512 * 1024, (size_t)3 * 1024 * 512, 0, DEPTH, lds);
    convert_tiles(p.w_out, p.wt_out, D, D, (size_t)D * D, (size_t)D * D, 0, DEPTH, lds);
    convert_tiles(p.exp_w_gu, (bf16_t*)p.wt_gu, D, 2048, (size_t)D * 2048, (size_t)2048 * D, 1, DEPTH * NE, lds, 1);
    convert_tiles(p.exp_w_down, (bf16_t*)p.wt_down, D, D, (size_t)D * D, (size_t)D * D, 0, DEPTH * NE, lds, 1);
}

__device__ __forceinline__ void mod_phase(const Params& p, float* lds) {
    float* s = lds; float* red = lds + 5 * 1024;
    const int t = TIDX;
    for (int i = t; i < 5 * 1024; i += NTHREADS) { const int r = i >> 10, k = i & 1023; const float v = (r < 4) ? p.c[r * 1024 + k] : p.c_ctx[k]; s[i] = v / (1.0f + expf(-v)); }
    __syncthreads();
    for (int unit = blockIdx.x; unit < 96 * DEPTH; unit += gridDim.x) {
        const int l = unit / 96, n0 = (unit - l * 96) * 64;
        const int nn = t & 63, kg = t >> 6; const float* w = p.mod_w + (size_t)l * 1024 * 6144 + n0 + nn;
        float acc[5] = {0.f, 0.f, 0.f, 0.f, 0.f};
        for (int k = kg * 128; k < kg * 128 + 128; ++k) { const float wv = w[(size_t)k * 6144];
#pragma unroll
            for (int r = 0; r < 5; ++r) acc[r] += s[r * 1024 + k] * wv; }
#pragma unroll
        for (int r = 0; r < 5; ++r) red[(kg * 5 + r) * 64 + nn] = acc[r];
        __syncthreads();
        if (t < 320) { const int r = t >> 6, n2 = t & 63; float a = 0.f;
#pragma unroll
            for (int g = 0; g < 8; ++g) a += red[(g * 5 + r) * 64 + n2];
            p.mod[(size_t)(l * 5 + r) * 6144 + n0 + n2] = a + p.mod_b[l * 6144 + n0 + n2]; }
        __syncthreads();
    }
}
__device__ __forceinline__ void small_phase(const Params& p) {
    for (int i = blockIdx.x * NTHREADS + TIDX; i < 4096 * 32; i += gridDim.x * NTHREADS) {
        if (i < 1024) { float v[4], m = -1e30f;
#pragma unroll
            for (int l = 0; l < 4; ++l) { v[l] = p.hgrn_lb_logits[l * 1024 + i]; m = fmaxf(m, v[l]); }
            float sum = 0.f;
#pragma unroll
            for (int l = 0; l < 4; ++l) { v[l] = expf(v[l] - m); sum += v[l]; }
            float cum = 0.f;
#pragma unroll
            for (int l = 0; l < 4; ++l) { const float sm = v[l] / sum; if (l > 0) cum += sm; p.lb[l * 1024 + i] = cum; } }
        const int t = i >> 5, f = i & 31; const float inv = powf(10000.0f, -(float)(f & 15) / 16.0f); const float pos = (f < 16) ? (float)(t >> 6) : (float)(t & 63);
        const float ang = pos * inv; p.rot[i * 2] = cosf(ang); p.rot[i * 2 + 1] = sinf(ang); }
}
template <int MODE> __device__ __forceinline__ void norm_phase(const Params& p, int l) {
    if (MODE != 0) build_tile_table(p, l - 1);
    const LAS int* tbp = (const LAS int*)((const LAS char*)dyn_lds_base() + TB_OFF) + MAXTILES;
    const int lane = TIDX & 63; const int gw = blockIdx.x * (NTHREADS / 64) + __builtin_amdgcn_readfirstlane(TIDX >> 6), nw = gridDim.x * (NTHREADS / 64);
    int ne[4] = {0, 0, 0, 0}, np[4] = {0, 0, 0, 0}; float nwt[4] = {0.f, 0.f, 0.f, 0.f};
    const bool bymap = (nw == 2048); const int wb = gw >> 9, wj = gw & 511; const int nit = bymap ? (wj < 256 ? 9 : 8) : (MT - gw + nw - 1) / nw;
#define NP_ROW(IT) (bymap ? wb * LT + wj + 512 * (IT) : gw + (IT) * nw)
    if (MODE != 0 && nit > 0) { const int m0_ = NP_ROW(0);
#pragma unroll
        for (int k = 0; k < 4; ++k) { ne[k] = p.tok_e[m0_ * 4 + k]; np[k] = p.tok_pos[m0_ * 4 + k]; nwt[k] = p.tok_w[m0_ * 4 + k]; } }
    float4 gN[4], shN[4], scN[4], g2v[4]; int cur_mr = -1;
#pragma unroll
    for (int j = 0; j < 4; ++j) gN[j] = (MODE != 2) ? *(const float4*)(p.norm1_g + l * D + j * 256 + lane * 4) : *(const float4*)(p.final_g + j * 256 + lane * 4);
    for (int it = 0; it < nit; ++it) { const int m = NP_ROW(it);
        const int b = m / LT, pp = m - b * LT; const bool isctx = pp < LC; const int mr = isctx ? 4 : b;
        float4 xv[4];
        if (mr != cur_mr) { cur_mr = mr;
            if (MODE != 2) { const float* mv = p.mod + (size_t)(l * 5 + mr) * 6144;
#pragma unroll
                for (int j = 0; j < 4; ++j) { const int col = j * 256 + lane * 4; shN[j] = *(const float4*)(mv + col); scN[j] = *(const float4*)(mv + 1024 + col); } }
            if (MODE != 0) { const float* g2 = p.mod + (size_t)((l - 1) * 5 + mr) * 6144 + 5 * 1024;
#pragma unroll
                for (int j = 0; j < 4; ++j) g2v[j] = *(const float4*)(g2 + j * 256 + lane * 4); } }
        if (MODE == 0) { const float* src = isctx ? p.ctx + (size_t)(b * LC + pp) * D : p.x + (size_t)(b * SEQ + pp - LC) * D;
#pragma unroll
            for (int j = 0; j < 4; ++j) xv[j] = *(const float4*)(src + j * 256 + lane * 4);
        } else {
            int slot[4]; float w[4];
#pragma unroll
            for (int k = 0; k < 4; ++k) { slot[k] = tbp[ne[k]] * 256 + np[k]; w[k] = nwt[k]; }
            unsigned yv[4][4];
#pragma unroll
            for (int j = 0; j < 4; ++j) { const int col = j * 256 + lane * 4; { const u32x2 xr = *(const u32x2*)(p.X + (size_t)m * D + col); xv[j] = make_float4(bflo(xr.x), bfhi(xr.x), bflo(xr.y), bfhi(xr.y)); }
#pragma unroll
                for (int k = 0; k < 4; ++k) yv[j][k] = *(const unsigned*)(p.Y + (size_t)slot[k] * D + col); }
            if (it + 1 < nit) { const int mn_ = NP_ROW(it + 1);
#pragma unroll
                for (int k = 0; k < 4; ++k) { ne[k] = p.tok_e[mn_ * 4 + k]; np[k] = p.tok_pos[mn_ * 4 + k]; nwt[k] = p.tok_w[mn_ * 4 + k]; } }
#pragma unroll
            for (int j = 0; j < 4; ++j) { float a0 = 0.f, a1 = 0.f, a2 = 0.f, a3 = 0.f;
#pragma unroll
                for (int k = 0; k < 4; ++k) { const f32x2_t ylo = __builtin_amdgcn_cvt_pk_f32_fp8((int)yv[j][k], false), yhi = __builtin_amdgcn_cvt_pk_f32_fp8((int)yv[j][k], true); a0 += w[k] * ylo[0]; a1 += w[k] * ylo[1]; a2 += w[k] * yhi[0]; a3 += w[k] * yhi[1]; }
                xv[j].x += g2v[j].x * a0; xv[j].y += g2v[j].y * a1; xv[j].z += g2v[j].z * a2; xv[j].w += g2v[j].w * a3; }
        }
        if (MODE != 2) {
#pragma unroll
            for (int j = 0; j < 4; ++j) { u32x2 xw; xw.x = pg8::cvt_pk_bf16(xv[j].x, xv[j].y); xw.y = pg8::cvt_pk_bf16(xv[j].z, xv[j].w); *(u32x2*)(p.X + (size_t)m * D + j * 256 + lane * 4) = xw; } }
        float ss = 0.f;
#pragma unroll
        for (int j = 0; j < 4; ++j) ss += xv[j].x * xv[j].x + xv[j].y * xv[j].y + xv[j].z * xv[j].z + xv[j].w * xv[j].w;
        ss = wave_sum(ss, lane); const float rstd = rsqrtf(ss * (1.0f / D) + 1e-6f);
#ifdef PROBE_PHASE
        const float pr_scale = 1.0f + ((const float*)p.ctrl)[2048];
#else
        const float pr_scale = 1.0f;
#endif
        if (MODE == 2) { if (!isctx) { float* o = p.out + (size_t)(b * SEQ + pp - LC) * D;
#pragma unroll
                for (int j = 0; j < 4; ++j) { const int col = j * 256 + lane * 4; const float4 g = gN[j];
                    *(float4*)(o + col) = make_float4(xv[j].x * rstd * g.x * pr_scale, xv[j].y * rstd * g.y * pr_scale, xv[j].z * rstd * g.z * pr_scale, xv[j].w * rstd * g.w * pr_scale); } }
        } else {
#pragma unroll
            for (int j = 0; j < 4; ++j) { const int col = j * 256 + lane * 4; const float4 g = gN[j], sh = shN[j], sc = scN[j];
                const float h0 = xv[j].x * rstd * g.x * (1.f + sc.x) + sh.x, h1 = xv[j].y * rstd * g.y * (1.f + sc.y) + sh.y, h2 = xv[j].z * rstd * g.z * (1.f + sc.z) + sh.z, h3 = xv[j].w * rstd * g.w * (1.f + sc.w) + sh.w;
                u32x2 w2; w2.x = pg8::cvt_pk_bf16(h0, h1); w2.y = pg8::cvt_pk_bf16(h2, h3); *(u32x2*)(p.H + (size_t)m * D + col) = w2;
                *(unsigned*)(p.H8 + (size_t)m * D + col) = pk_fp8x4(h0, h1, h2, h3); } }
    }
}
#undef NP_ROW
__device__ __forceinline__ void lru_prep_phase(const Params& p, int l, float* ldsf) {
    const int tid = TIDX, lane = tid & 63, wave = __builtin_amdgcn_readfirstlane(tid >> 6), r = lane & 31, h = lane >> 5; const int G8 = (int)gridDim.x >> 3;
    if ((int)blockIdx.x >= G8 * 8) return;
    const int hb = blockIdx.x & 7, rank = blockIdx.x >> 3;
    LAS char* lds = (LAS char*)ldsf; LAS char* tW = lds; LAS char* tH = lds + 36864 + wave * 9216; LAS char* tX = tH + 4480;
#pragma unroll
    for (int i = 0; i < 16; ++i) { const int e = tid + 512 * i, mat = e >> 11, rr = (e & 2047) * 2, dir = mat >> 1; const float* src = (mat & 1) ? p.lru_wx : p.lru_wa;
        const f32x2_t v = *(const f32x2_t*)(src + (size_t)((l * 2 + dir) * 8 + hb) * 4096 + rr);
        *(LAS unsigned*)(tW + mat * 9216 + (rr >> 6) * 144 + (rr & 63) * 2) = pk_bf16(v[0], v[1]); }
    __syncthreads();
    const int cch = hb * 64 + lane;
    const float cb = p.lru_conv_b[l * 512 + cch], cw0 = p.lru_conv_w[(l * 4 + 0) * 512 + cch], cw1 = p.lru_conv_w[(l * 4 + 1) * 512 + cch], cw2 = p.lru_conv_w[(l * 4 + 2) * 512 + cch], cw3 = p.lru_conv_w[(l * 4 + 3) * 512 + cch];
    const int per_wg = (MT / 32 + G8 - 1) / G8;
    for (int q = wave; q < per_wg && rank * per_wg + q < MT / 32; q += 8) { const int t32 = rank * per_wg + q;
        const int m0 = t32 * 32, b = m0 / LT, p0 = m0 - b * LT; const int seg_lo = p0 < LC ? 0 : LC, seg_hi = p0 < LC ? LC : LT;
#pragma unroll
        for (int i = 0; i < 5; ++i) { const int idx = lane + 64 * i; if (idx < 35 * 8) { const int row = idx >> 3, ch = idx & 7, q = p0 - 2 + row; u32x4 v = {0u, 0u, 0u, 0u};
                if (q >= seg_lo && q < seg_hi) v = *(const u32x4*)(p.U + (size_t)(b * LT + q) * INC + C_LX + hb * 64 + ch * 8);
                *(LAS u32x4*)(tH + row * 128 + ch * 16) = v; } }
        asm volatile("s_waitcnt lgkmcnt(0)" ::: "memory");
#pragma unroll
        for (int j = 0; j < 32; ++j) { const LAS bf16_t* col = (const LAS bf16_t*)(tH + j * 128 + lane * 2);
            const float x = cb + bf2f(col[0]) * cw0 + bf2f(col[64]) * cw1 + bf2f(col[128]) * cw2 + bf2f(col[192]) * cw3;
            *(LAS bf16_t*)(tX + j * 144 + lane * 2) = (bf16_t)(pk_bf16(x, 0.f) & 0xffffu); }
        asm volatile("s_waitcnt lgkmcnt(0)" ::: "memory");
        bf16x8_t Af[4];
#pragma unroll
        for (int x = 0; x < 4; ++x) Af[x] = frag_row(tX, 144, r, 16 * x + 4 * h);
#pragma unroll
        for (int dir = 0; dir < 2; ++dir) {
            f32x16_t acc[2][2];
#pragma unroll
            for (int gq = 0; gq < 2; ++gq)
#pragma unroll
                for (int nt = 0; nt < 2; ++nt) {
#pragma unroll
                    for (int i = 0; i < 16; ++i) acc[gq][nt][i] = 0.f;
#pragma unroll
                    for (int x = 0; x < 4; ++x) acc[gq][nt] = MFMA32(Af[x], frag_tr(tW + (dir * 2 + gq) * 9216, 144, 16 * x + 4 * h, nt, lane), acc[gq][nt]); }
#pragma unroll
            for (int nt = 0; nt < 2; ++nt) { const int c = hb * 64 + 32 * nt + r, pi = (l * 2 + dir) * 512 + c; const float ba = p.lru_ba[pi], bx = p.lru_bx[pi], lam = p.lru_lambda[pi];
                const float sp8 = -8.0f * log1pf(expf(-lam));
                float av[16], bv[16];
#pragma unroll
                for (int i = 0; i < 16; ++i) { const int tok = (i & 3) + 8 * (i >> 2) + 4 * h; const float rg = sigmoidf_(acc[0][nt][i] + ba), ig = sigmoidf_(acc[1][nt][i] + bx);
                    const float a = __expf(rg * sp8); av[i] = a; bv[i] = __builtin_amdgcn_sqrtf(fmaxf(fmaf(-a, a, 1.0f), 0.f)) * (ig * bf2f(*(const LAS bf16_t*)(tX + tok * 144 + (32 * nt + r) * 2))); }
                float Pg[4], Hg[4];
#pragma unroll
                for (int g = 0; g < 4; ++g) { float P = 1.f, H = 0.f;
#pragma unroll
                    for (int ee = 0; ee < 4; ++ee) { const int i = 4 * g + (dir == 0 ? ee : 3 - ee); H = av[i] * H + bv[i]; P *= av[i]; av[i] = P; bv[i] = H; }
                    Pg[g] = P; Hg[g] = H; }
                float Ps = 1.f, Hs = 0.f, Pst[4] = {1.f, 1.f, 1.f, 1.f}, Hst[4] = {0.f, 0.f, 0.f, 0.f};
#pragma unroll
                for (int kk = 0; kk < 8; ++kk) { const int k = dir == 0 ? kk : 7 - kk, g = k >> 1, hh = k & 1;
                    const float Po = shx(Pg[g], 32, lane), Ho = shx(Hg[g], 32, lane); const bool mine = hh == h;
                    const float Pk = mine ? Pg[g] : Po, Hk = mine ? Hg[g] : Ho;
                    Pst[g] = mine ? Ps : Pst[g]; Hst[g] = mine ? Hs : Hst[g];
                    Hs = Pk * Hs + Hk; Ps *= Pk; }
                unsigned* out = p.PH + ((size_t)dir * MT + m0) * 512 + c;
#pragma unroll
                for (int i = 0; i < 16; ++i) { const int g = i >> 2, tok = (i & 3) + 8 * g + 4 * h; out[(size_t)tok * 512] = pk_bf16(av[i] * Pst[g], av[i] * Hst[g] + bv[i]); }
                if (h == 0) { const size_t o = ((size_t)dir * (MT / 32) + t32) * 512 + c; p.LP[o] = Ps; p.LH[o] = Hs; }
            }
        }
    }
}
__device__ __forceinline__ void lru_tilescan_task(const Params& p, int task, int lane) {
    const int b = task >> 4, dir = (task >> 3) & 1, c = (task & 7) * 64 + lane;
    const size_t base = ((size_t)dir * (MT / 32) + (size_t)b * 136) * 512 + c;
    float hh = 0.f;
#pragma unroll 17
    for (int i = 0; i < 136; ++i) { const int tl = dir == 0 ? i : (i < 8 ? 7 - i : 143 - i); const float P = p.LP[base + (size_t)tl * 512], H = p.LH[base + (size_t)tl * 512];
        p.LS[base + (size_t)tl * 512] = hh; hh = P * hh + H; }
}

__device__ __forceinline__ void finish_phase(const Params& p, int l, int last) {
    const int lane = TIDX & 63; const int gw = blockIdx.x * (NTHREADS / 64) + __builtin_amdgcn_readfirstlane(TIDX >> 6), nw = gridDim.x * (NTHREADS / 64);
    const int c0 = lane * 8;
    float gr_[8], gh_[8];
#pragma unroll
    for (int i = 0; i < 8; ++i) { gr_[i] = p.ret_gn_g[l * 512 + c0 + i]; gh_[i] = p.hgrn_gn_g[l * 512 + c0 + i]; }
    for (int m = gw; m < MT; m += nw) {
        if (last && (m % LT) < LC) continue;
        const bf16_t* u = p.U + (size_t)m * INC + c0; const int tile = m >> 5;
        const bf16_t* ra = p.Oret + (size_t)m * 512 + c0; const bf16_t* rb = ra + (size_t)MT * 512; const bf16_t* ha = p.Ohg + (size_t)m * 512 + c0; const bf16_t* hb2 = ha + (size_t)MT * 512;
        const u32x4 rav = *(const u32x4*)ra, rbv = *(const u32x4*)rb, hav = *(const u32x4*)ha, hbv = *(const u32x4*)hb2;
        const unsigned* ph0 = p.PH + (size_t)m * 512 + c0; const unsigned* ph1 = ph0 + (size_t)MT * 512;
        const u32x4 pf0 = *(const u32x4*)ph0, pf1 = *(const u32x4*)(ph0 + 4), pb0 = *(const u32x4*)ph1, pb1 = *(const u32x4*)(ph1 + 4);
        const float* st0 = p.LS + (size_t)tile * 512 + c0; const float* st1 = st0 + (size_t)(MT / 32) * 512;
        const float4 sf0 = *(const float4*)st0, sf1 = *(const float4*)(st0 + 4), sb0 = *(const float4*)st1, sb1 = *(const float4*)(st1 + 4);
        const u32x4 grg = *(const u32x4*)(u + C_RG), ghg = *(const u32x4*)(u + C_HGT), glg = *(const u32x4*)(u + C_LGT);
        { float o[8] = {bflo(rav[0]) + bflo(rbv[0]), bfhi(rav[0]) + bfhi(rbv[0]), bflo(rav[1]) + bflo(rbv[1]), bfhi(rav[1]) + bfhi(rbv[1]), bflo(rav[2]) + bflo(rbv[2]), bfhi(rav[2]) + bfhi(rbv[2]), bflo(rav[3]) + bflo(rbv[3]), bfhi(rav[3]) + bfhi(rbv[3])};
          float ss = 0.f;
#pragma unroll
          for (int i = 0; i < 8; ++i) ss += o[i] * o[i];
          ss += shx(ss, 1, lane); ss += shx(ss, 2, lane); ss += shx(ss, 4, lane);
          const float rstd = rsqrtf(ss * (1.0f / 64.0f) + 1e-6f); u32x4 w;
#pragma unroll
          for (int i = 0; i < 4; ++i) { const float g0 = bflo(grg[i]), g1 = bfhi(grg[i]); w[i] = pg8::cvt_pk_bf16(o[2 * i] * rstd * gr_[2 * i] * (g0 * sigmoidf_(g0)), o[2 * i + 1] * rstd * gr_[2 * i + 1] * (g1 * sigmoidf_(g1))); }
          *(u32x4*)(p.Aall + (size_t)m * 512 + c0) = w; }
        { float o[8] = {bflo(hav[0]) + bflo(hbv[0]), bfhi(hav[0]) + bfhi(hbv[0]), bflo(hav[1]) + bflo(hbv[1]), bfhi(hav[1]) + bfhi(hbv[1]), bflo(hav[2]) + bflo(hbv[2]), bfhi(hav[2]) + bfhi(hbv[2]), bflo(hav[3]) + bflo(hbv[3]), bfhi(hav[3]) + bfhi(hbv[3])};
          float ss = 0.f;
#pragma unroll
          for (int i = 0; i < 8; ++i) ss += o[i] * o[i];
          ss += shx(ss, 1, lane); ss += shx(ss, 2, lane); ss += shx(ss, 4, lane); ss += shx(ss, 8, lane);
          const float rstd = rsqrtf(ss * (1.0f / 128.0f) + 1e-6f); u32x4 w;
#pragma unroll
          for (int i = 0; i < 4; ++i) w[i] = pg8::cvt_pk_bf16(o[2 * i] * rstd * gh_[2 * i] * sigmoidf_(bflo(ghg[i])), o[2 * i + 1] * rstd * gh_[2 * i + 1] * sigmoidf_(bfhi(ghg[i])));
          *(u32x4*)(p.Aall + ((size_t)MT + m) * 512 + c0) = w; }
        { const float sf[8] = {sf0.x, sf0.y, sf0.z, sf0.w, sf1.x, sf1.y, sf1.z, sf1.w}, sb[8] = {sb0.x, sb0.y, sb0.z, sb0.w, sb1.x, sb1.y, sb1.z, sb1.w};
          const unsigned pf[8] = {pf0[0], pf0[1], pf0[2], pf0[3], pf1[0], pf1[1], pf1[2], pf1[3]}, pb[8] = {pb0[0], pb0[1], pb0[2], pb0[3], pb1[0], pb1[1], pb1[2], pb1[3]};
          float o[8];
#pragma unroll
          for (int i = 0; i < 8; ++i) o[i] = (bflo(pf[i]) * sf[i] + bfhi(pf[i])) + (bflo(pb[i]) * sb[i] + bfhi(pb[i]));
          u32x4 w;
#pragma unroll
          for (int i = 0; i < 4; ++i) { float rr[2];
#pragma unroll
              for (int k = 0; k < 2; ++k) { const float x = k ? bfhi(glg[i]) : bflo(glg[i]); const float t2 = __expf(2.0f * 0.7978845608f * (x + 0.044715f * x * x * x));
                  rr[k] = o[2 * i + k] * (0.5f * x * (2.0f - 2.0f * __builtin_amdgcn_rcpf(t2 + 1.0f))); }
              w[i] = pg8::cvt_pk_bf16(rr[0], rr[1]); }
          *(u32x4*)(p.Aall + ((size_t)2 * MT + m) * 512 + c0) = w; }
    }
}

__device__ __forceinline__ void router_prep_phase(const Params& p) {
    const int tid = TIDX, lane = tid & 63;
    for (int i = blockIdx.x * NTHREADS + tid; i < DEPTH * 5 * 1024 * 8; i += gridDim.x * NTHREADS) { const int q = i & 7, k = (i >> 3) & 1023, lm = i >> 13, l = lm / 5;
        const float sc = p.norm2_g[l * D + k] * (1.0f + p.mod[(size_t)lm * 6144 + 4 * 1024 + k]); const float4 w = *(const float4*)(p.router_w + ((size_t)l * 1024 + k) * 32 + q * 4);
        *(float4*)(p.RWp + ((size_t)lm * 1024 + k) * 32 + q * 4) = make_float4(w.x * sc, w.y * sc, w.z * sc, w.w * sc); }
    const int gw = blockIdx.x * (NTHREADS / 64) + __builtin_amdgcn_readfirstlane(tid >> 6), nw = gridDim.x * (NTHREADS / 64);
    for (int t = gw; t < DEPTH * 5 * 32; t += nw) { const int e = t & 31, lm = t >> 5, l = lm / 5; float a = 0.f;
#pragma unroll
        for (int j = 0; j < 16; ++j) { const int k = j * 64 + lane; a += p.mod[(size_t)lm * 6144 + 3 * 1024 + k] * p.router_w[((size_t)l * 1024 + k) * 32 + e]; }
        a = wave_sum(a, lane); if (lane == 0) p.RC[lm * 32 + e] = a + p.router_b[l * 32 + e]; }
}
__device__ __forceinline__ int route_group_row0(int g, int last) { return last ? (g >> 7) * LT + LC + (g & 127) * 32 : g * 32; }
__device__ __forceinline__ void route_phase(const Params& p, int l, float* ldsf, int last) {
    const int tid = TIDX, lane = tid & 63, wave = __builtin_amdgcn_readfirstlane(tid >> 6); const int G = (int)gridDim.x;
    LAS float* tL = (LAS float*)ldsf; LAS float* tS = tL + 8448; LAS int* rec = (LAS int*)(tL + 8704);
    const int ti = lane & 31, kk = lane >> 5, gi = wave >> 1, kh = wave & 1;
    const int NG = last ? NB * SEQ / 32 : MT / 32;
    const int ngrp = ((int)blockIdx.x + 3 * G < NG) ? 4 : ((int)blockIdx.x + 2 * G < NG) ? 3 : ((int)blockIdx.x + G < NG) ? 2 : ((int)blockIdx.x < NG ? 1 : 0);
    if (gi < ngrp) {
        const int m0 = route_group_row0((int)blockIdx.x + gi * G, last), b = m0 / LT, pp0 = m0 - b * LT, mr = pp0 < LC ? 4 : b;
        const bf16_t* xrow = p.X + (size_t)(m0 + ti) * D + 4 * kk + 512 * kh;
        const bf16_t* drow = p.Dx + (size_t)(m0 + ti) * D + 4 * kk + 512 * kh;
        const float* rw = p.RWp + ((size_t)(l * 5 + mr) * 1024 + 512 * kh + 4 * kk) * 32 + ti;
        f32x16_t acc;
#pragma unroll
        for (int i = 0; i < 16; ++i) acc[i] = 0.f;
        float ss = 0.f;
#define RT_LOAD(XB, WB, DB, s0) do { if ((s0) < 64) { _Pragma("unroll") for (int q = 0; q < 4; ++q) { { const u32x2 xr_ = *(const u32x2*)(xrow + 8 * ((s0) + q)); XB[q] = make_float4(bflo(xr_.x), bfhi(xr_.x), bflo(xr_.y), bfhi(xr_.y)); } DB[q] = *(const u32x2*)(drow + 8 * ((s0) + q)); \
            const float* rp = rw + (size_t)((s0) + q) * 256; WB[q][0] = rp[0]; WB[q][1] = rp[32]; WB[q][2] = rp[64]; WB[q][3] = rp[96]; } } } while (0)
#define RT_MMA(XB, WB, DB, s0) do { if ((s0) < 64) { _Pragma("unroll") for (int q = 0; q < 4; ++q) { XB[q].x += bflo(DB[q].x); XB[q].y += bfhi(DB[q].x); XB[q].z += bflo(DB[q].y); XB[q].w += bfhi(DB[q].y); \
            ss += XB[q].x * XB[q].x + XB[q].y * XB[q].y + XB[q].z * XB[q].z + XB[q].w * XB[q].w; \
            acc = __builtin_amdgcn_mfma_f32_32x32x2f32(XB[q].x, WB[q][0], acc, 0, 0, 0); acc = __builtin_amdgcn_mfma_f32_32x32x2f32(XB[q].y, WB[q][1], acc, 0, 0, 0); \
            acc = __builtin_amdgcn_mfma_f32_32x32x2f32(XB[q].z, WB[q][2], acc, 0, 0, 0); acc = __builtin_amdgcn_mfma_f32_32x32x2f32(XB[q].w, WB[q][3], acc, 0, 0, 0); } } } while (0)
        float4 xA[4], xB[4], xC[4]; float wA[4][4], wB[4][4], wC[4][4]; u32x2 dA[4], dB[4], dC[4];
        RT_LOAD(xA, wA, dA, 0); RT_LOAD(xB, wB, dB, 4);
        for (int s = 0; s < 64; s += 12) {
            RT_LOAD(xC, wC, dC, s + 8);  asm volatile("" ::: "memory"); RT_MMA(xA, wA, dA, s);
            RT_LOAD(xA, wA, dA, s + 12); asm volatile("" ::: "memory"); RT_MMA(xB, wB, dB, s + 4);
            RT_LOAD(xB, wB, dB, s + 16); asm volatile("" ::: "memory"); RT_MMA(xC, wC, dC, s + 8);
        }
#undef RT_LOAD
#undef RT_MMA
        ss += shx(ss, 32, lane);
        LAS float* t = tL + (gi * 2 + kh) * (32 * 33);
#pragma unroll
        for (int i = 0; i < 16; ++i) t[((i & 3) + 8 * (i >> 2) + 4 * kk) * 33 + ti] = acc[i];
        if (lane < 32) tS[(gi * 2 + kh) * 32 + ti] = ss;
    }
    __syncthreads();
    if (gi < ngrp && kh == 0) {
        const int m0 = route_group_row0((int)blockIdx.x + gi * G, last), b = m0 / LT, pp0 = m0 - b * LT, mr = pp0 < LC ? 4 : b;
        const float rstd = rsqrtf((tS[(gi * 2) * 32 + ti] + tS[(gi * 2 + 1) * 32 + ti]) * (1.0f / D) + 1e-6f);
        const LAS float* t0 = tL + (gi * 2) * (32 * 33) + ti * 33; const LAS float* t1 = t0 + 32 * 33;
        int e4[4] = {0, 0, 0, 0}; float w4[4] = {0.f, 0.f, 0.f, 0.f}; int pos4[4] = {0, 0, 0, 0};
        float lg[32];
#pragma unroll
        for (int e = 0; e < 32; ++e) lg[e] = (t0[e] + t1[e]) * rstd + p.RC[(l * 5 + mr) * 32 + e];
        float val[4];
#pragma unroll
        for (int k = 0; k < 4; ++k) { float best = -3.0e38f; int bi = 0;
#pragma unroll
            for (int e = 0; e < 32; ++e) { const bool better = lg[e] > best; best = better ? lg[e] : best; bi = better ? e : bi; }
            e4[k] = bi; val[k] = best;
#pragma unroll
            for (int e = 0; e < 32; ++e) lg[e] = (e == bi) ? -3.0e38f : lg[e]; }
        const float x1 = __expf(val[1] - val[0]), x2 = __expf(val[2] - val[0]), x3 = __expf(val[3] - val[0]); const float inv = 1.0f / (1.0f + x1 + x2 + x3);
        w4[0] = inv; w4[1] = x1 * inv; w4[2] = x2 * inv; w4[3] = x3 * inv;
        int rank4[4] = {0, 0, 0, 0}; int mycnt = 0;
#pragma unroll 4
        for (int e = 0; e < 32; ++e) { const bool hit = lane < 32 && (e4[0] == e || e4[1] == e || e4[2] == e || e4[3] == e);
            const unsigned long long mask = __ballot(hit); const int rk = __popcll(mask & ((1ull << lane) - 1ull));
#pragma unroll
            for (int k = 0; k < 4; ++k) rank4[k] = (e4[k] == e) ? rk : rank4[k];
            mycnt = (lane == e) ? __popcll(mask) : mycnt; }
        int base = 0;
        if (lane < 32 && mycnt > 0) base = (int)__hip_atomic_fetch_add(&p.ctrl[l * 64 + lane], (unsigned)mycnt, __ATOMIC_RELAXED, __HIP_MEMORY_SCOPE_AGENT);
#pragma unroll
        for (int k = 0; k < 4; ++k) pos4[k] = __builtin_amdgcn_ds_bpermute(e4[k] << 2, base) + rank4[k];
        if (lane < 32) { LAS int* rr = rec + (gi * 32 + ti) * 12;
#pragma unroll
            for (int k = 0; k < 4; ++k) { p.tok_e[(m0 + ti) * 4 + k] = e4[k]; p.tok_pos[(m0 + ti) * 4 + k] = pos4[k]; p.tok_w[(m0 + ti) * 4 + k] = w4[k]; rr[k] = e4[k]; rr[4 + k] = pos4[k]; }
            rr[8] = __float_as_int(rstd); }
    }
    __syncthreads();
    u32x4 xn[2]; u32x4 dn[2];
    if (wave < ngrp * 32) { const int m = route_group_row0((int)blockIdx.x + (wave >> 5) * G, last) + (wave & 31);
#pragma unroll
        for (int j = 0; j < 2; ++j) { const int col = j * 512 + lane * 8; xn[j] = *(const u32x4*)(p.X + (size_t)m * D + col); dn[j] = *(const u32x4*)(p.Dx + (size_t)m * D + col); } }
    for (int rw_ = wave; rw_ < ngrp * 32; rw_ += 8) {
        const int g2 = rw_ >> 5, tk = rw_ & 31; const int m = route_group_row0((int)blockIdx.x + g2 * G, last) + tk, b = m / LT, pp = m - b * LT, mr = pp < LC ? 4 : b;
        const LAS int* rr = rec + (g2 * 32 + tk) * 12; const float rs = __int_as_float(rr[8]);
        size_t rowoff[4];
#pragma unroll
        for (int k = 0; k < 4; ++k) rowoff[k] = ((size_t)rr[k] * (CAPT * 256) + rr[4 + k]) * D;
        const float* mv = p.mod + (size_t)(l * 5 + mr) * 6144;
        u32x4 xv[2]; float4 gv[2][2], scv[2][2], shv[2][2]; u32x4 dv[2];
#pragma unroll
        for (int j = 0; j < 2; ++j) { const int col = j * 512 + lane * 8; xv[j] = xn[j]; dv[j] = dn[j];
#pragma unroll
            for (int q = 0; q < 2; ++q) { gv[j][q] = *(const float4*)(p.norm2_g + l * D + col + 4 * q); scv[j][q] = *(const float4*)(mv + 4 * 1024 + col + 4 * q); shv[j][q] = *(const float4*)(mv + 3 * 1024 + col + 4 * q); } }
        if (rw_ + 8 < ngrp * 32) { const int mn = route_group_row0((int)blockIdx.x + ((rw_ + 8) >> 5) * G, last) + ((rw_ + 8) & 31);
#pragma unroll
            for (int j = 0; j < 2; ++j) { const int col = j * 512 + lane * 8; xn[j] = *(const u32x4*)(p.X + (size_t)mn * D + col); dn[j] = *(const u32x4*)(p.Dx + (size_t)mn * D + col); } }
#pragma unroll
        for (int j = 0; j < 2; ++j) { const int col = j * 512 + lane * 8; u32x2 w4; u32x4 xw4;
#pragma unroll
            for (int q = 0; q < 2; ++q) { const unsigned d0 = dv[j][2 * q], d1 = dv[j][2 * q + 1];
                const unsigned x0 = xv[j][2 * q], x1 = xv[j][2 * q + 1]; const float4 x = make_float4(bflo(x0) + bflo(d0), bfhi(x0) + bfhi(d0), bflo(x1) + bflo(d1), bfhi(x1) + bfhi(d1)); xw4[2 * q] = pg8::cvt_pk_bf16(x.x, x.y); xw4[2 * q + 1] = pg8::cvt_pk_bf16(x.z, x.w);
                w4[q] = pk_fp8x4(x.x * rs * gv[j][q].x * (1.f + scv[j][q].x) + shv[j][q].x, x.y * rs * gv[j][q].y * (1.f + scv[j][q].y) + shv[j][q].y,
                                 x.z * rs * gv[j][q].z * (1.f + scv[j][q].z) + shv[j][q].z, x.w * rs * gv[j][q].w * (1.f + scv[j][q].w) + shv[j][q].w); }
            *(u32x4*)(p.X + (size_t)m * D + col) = xw4;
#pragma unroll
            for (int k = 0; k < 4; ++k) *(u32x2*)(p.Xg + rowoff[k] + col) = w4; }
    }
}

struct EpiBranch {
    static constexpr bool PERM = true, AFTER_DRAIN = false;
    bf16_t* R;
    __device__ __forceinline__ void operator()(const f32x4 (&acc)[2][2][4][2], const Unit& u, int wr, int wc, int fr, int fq) const {
        const int br = u.pn >> 2, pnl = u.pn & 3, pmr = u.pm - br * 68;
        bf16_t* base = R + (size_t)br * MT * D + (size_t)(pmr * 256 + wr * 64 + fr) * D + pnl * 256 + wc * 32 + 8 * fq;
#pragma unroll
        for (int ai = 0; ai < 2; ++ai)
#pragma unroll
            for (int m = 0; m < 4; ++m) { bf16_t* rowp = base + (size_t)(ai * 128 + m * 16) * D;
#pragma unroll
                for (int bj = 0; bj < 2; ++bj) { const f32x4 v0 = acc[ai][bj][m][0], v1 = acc[ai][bj][m][1];
                    u32x4 w; w.x = pg8::cvt_pk_bf16(v0[0], v0[1]); w.y = pg8::cvt_pk_bf16(v0[2], v0[3]); w.z = pg8::cvt_pk_bf16(v1[0], v1[1]); w.w = pg8::cvt_pk_bf16(v1[2], v1[3]);
                    *(u32x4*)(rowp + bj * 128) = w; } }
    }
};
__device__ __forceinline__ int latent_row_tile(int k) { return (k >> 4) * 17 + 1 + (k & 15); }
struct SchedMerge { int G, c, last;
    __device__ bool next(int i, Unit& u) const { const int nt = last ? 256 : 272; const int L = i * G + c; if (L >= 3 * nt) return false; const int br = L / nt, tile = L - br * nt;
        u.pm = br * 68 + (last ? latent_row_tile(tile >> 2) : (tile >> 2)); u.pn = br * 4 + (tile & 3); u.po = 0; return true; }
    __device__ __forceinline__ void a_ready(const Unit&) const {}
    __device__ __forceinline__ void done(const Unit&) const {}
};
__device__ __forceinline__ void merge_combine_phase(const Params& p, int last) {
    const int tid = TIDX, lane = tid & 63; const int gw = blockIdx.x * (NTHREADS / 64) + __builtin_amdgcn_readfirstlane(tid >> 6), nw = gridDim.x * (NTHREADS / 64);
    for (int m = gw; m < MT; m += nw) {
        if (last && (m % LT) < LC) continue;
        u32x4 rv[2][3], gv[2][3];
#pragma unroll
        for (int hf = 0; hf < 2; ++hf)
#pragma unroll
            for (int br = 0; br < 3; ++br) { const int col = hf * 512 + lane * 8; rv[hf][br] = *(const u32x4*)(p.R + ((size_t)br * MT + m) * D + col); gv[hf][br] = *(const u32x4*)(p.U + (size_t)m * INC + C_GR + br * 1024 + col); }
#pragma unroll
        for (int hf = 0; hf < 2; ++hf) { const int col = hf * 512 + lane * 8; float o[8];
#pragma unroll
            for (int i = 0; i < 8; ++i) o[i] = 0.f;
#pragma unroll
            for (int br = 0; br < 3; ++br)
#pragma unroll
                for (int i = 0; i < 4; ++i) { o[2 * i] += sigmoidf_(bflo(gv[hf][br][i])) * bflo(rv[hf][br][i]); o[2 * i + 1] += sigmoidf_(bfhi(gv[hf][br][i])) * bfhi(rv[hf][br][i]); }
            u32x4 w; w.x = pg8::cvt_pk_bf16(o[0], o[1]); w.y = pg8::cvt_pk_bf16(o[2], o[3]); w.z = pg8::cvt_pk_bf16(o[4], o[5]); w.w = pg8::cvt_pk_bf16(o[6], o[7]);
            *(u32x4*)(p.Mg + (size_t)m * D + col) = w; }
    }
}
struct SchedOut { int nN, nwg, G, c, last;
    __device__ void init(int M, int N, int G_, int c_, int last_) { nN = N / 256; nwg = (M / 256) * nN; G = G_; c = c_; last = last_; }
    __device__ bool next(int i, Unit& u) const {
        const int L = i * G + c; if (L >= (last ? 256 : nwg)) return false;
        const int nM = nwg / nN; int wgid = L; { const int q = nwg / 8, r = nwg % 8, xcd = wgid % 8, off = wgid / 8; wgid = (xcd < r ? xcd * (q + 1) : r * (q + 1) + (xcd - r) * q) + off; }
        const int nig = 8 * nN, gid = wgid / nig, fm = gid * 8, gsz = (nM - fm) < 8 ? (nM - fm) : 8;
        const int pm0 = fm + ((wgid % nig) % gsz), pn0 = (wgid % nig) / gsz;
        u.pm = last ? latent_row_tile(L >> 2) : pm0; u.pn = last ? (L & 3) : pn0; u.po = 0; return true; }
    __device__ __forceinline__ void a_ready(const Unit&) const {}
    __device__ __forceinline__ void done(const Unit&) const {}
};
struct EpiOut {
    static constexpr bool PERM = true, AFTER_DRAIN = false;
    bf16_t* Dx; const float* mod_l;
    __device__ __forceinline__ void operator()(const f32x4 (&acc)[2][2][4][2], const Unit& u, int wr, int wc, int fr, int fq) const {
        const int mr = (u.pm % 17 == 0) ? 4 : u.pm / 17; const float* g1 = mod_l + mr * 6144 + 2 * 1024;
        const int row0 = u.pm * 256 + wr * 64 + fr, col0 = u.pn * 256 + wc * 32 + 8 * fq;
        f32x4 gv[2][2];
#pragma unroll
        for (int bj = 0; bj < 2; ++bj)
#pragma unroll
            for (int n = 0; n < 2; ++n) gv[bj][n] = *(const f32x4*)(g1 + col0 + bj * 128 + 4 * n);
#pragma unroll
        for (int ai = 0; ai < 2; ++ai)
#pragma unroll
            for (int m = 0; m < 4; ++m) { bf16_t* rowp = Dx + (size_t)(row0 + ai * 128 + m * 16) * D + col0;
#pragma unroll
                for (int bj = 0; bj < 2; ++bj) { const f32x4 v0 = acc[ai][bj][m][0] * gv[bj][0], v1 = acc[ai][bj][m][1] * gv[bj][1];
                    u32x4 w; w.x = pg8::cvt_pk_bf16(v0[0], v0[1]); w.y = pg8::cvt_pk_bf16(v0[2], v0[3]); w.z = pg8::cvt_pk_bf16(v1[0], v1[1]); w.w = pg8::cvt_pk_bf16(v1[2], v1[3]);
                    *(u32x4*)(rowp + bj * 128) = w; } }
    }
};
struct SchedMoE { int nN, G, c, sparseA;
    __device__ bool next(int i, Unit& u) const { const LAS int* te = (const LAS int*)((const LAS char*)dyn_lds_base() + TB_OFF); const LAS int* tb = te + MAXTILES;
        if ((G & 63) == 0 && nN == 8) { const int x = c & 7, r = c >> 3, tile = i * (G >> 3) + 8 * (r >> 3) + x, j = r & 7; if (tile >= tb[NE]) return false; const int e = te[tile];
            u.po = tile; u.pm = sparseA ? e * CAPT + (tile - tb[e]) : tile; u.pn = e * nN + j; return true; }
        const int L = i * G + c; if (L >= tb[NE] * nN) return false; const int tile = L / nN, j = L - tile * nN, e = te[tile];
        u.po = tile; u.pm = sparseA ? e * CAPT + (tile - tb[e]) : tile; u.pn = e * nN + j; return true; }
    __device__ __forceinline__ void a_ready(const Unit&) const {}
    __device__ __forceinline__ void done(const Unit&) const {}
};
struct EpiGU {
    static constexpr bool PERM = true, AFTER_DRAIN = false;
    unsigned char* Act; const float* bgu;
    __device__ __forceinline__ void operator()(const f32x4 (&acc)[2][2][4][2], const Unit& u, int wr, int wc, int fr, int fq) const {
        const int e = u.pn >> 3, pnl = u.pn & 7; const int row0 = u.po * 256 + wr * 64 + fr, c8 = pnl * 128 + wc * 32 + 8 * fq;
        const float* bg = bgu + e * 2048 + c8; const f32x4 bg0 = *(const f32x4*)bg, bg1 = *(const f32x4*)(bg + 4), bu0 = *(const f32x4*)(bg + 1024), bu1 = *(const f32x4*)(bg + 1028);
#pragma unroll
        for (int ai = 0; ai < 2; ++ai)
#pragma unroll
            for (int m = 0; m < 4; ++m) { const float is_ = 1.0f / W8_SCALE; const f32x4 g0 = acc[ai][0][m][0] * is_ + bg0, g1 = acc[ai][0][m][1] * is_ + bg1, u0 = acc[ai][1][m][0] * is_ + bu0, u1 = acc[ai][1][m][1] * is_ + bu1; float r[8];
#pragma unroll
                for (int j = 0; j < 4; ++j) { const float ga = fminf(g0[j], 7.0f), ua = fminf(fmaxf(u0[j], -7.0f), 7.0f); r[j] = (ua + 1.0f) * (ga * sigmoidf_(1.702f * ga));
                    const float gb = fminf(g1[j], 7.0f), ub = fminf(fmaxf(u1[j], -7.0f), 7.0f); r[4 + j] = (ub + 1.0f) * (gb * sigmoidf_(1.702f * gb)); }
                u32x2 w; w.x = pk_fp8x4(r[0], r[1], r[2], r[3]); w.y = pk_fp8x4(r[4], r[5], r[6], r[7]);
                *(u32x2*)(Act + (size_t)(row0 + ai * 128 + m * 16) * D + c8) = w; }
    }
};
struct EpiDown {
    static constexpr bool PERM = true, AFTER_DRAIN = false;
    unsigned char* Y; const float* bd;
    __device__ __forceinline__ void operator()(const f32x4 (&acc)[2][2][4][2], const Unit& u, int wr, int wc, int fr, int fq) const {
        const int e = u.pn >> 2, pnl = u.pn & 3; const int row0 = u.po * 256 + wr * 64 + fr, col0 = pnl * 256 + wc * 32 + 8 * fq;
        f32x4 bv[2][2];
#pragma unroll
        for (int bj = 0; bj < 2; ++bj)
#pragma unroll
            for (int n = 0; n < 2; ++n) bv[bj][n] = *(const f32x4*)(bd + e * 1024 + col0 + bj * 128 + 4 * n);
#pragma unroll
        for (int ai = 0; ai < 2; ++ai)
#pragma unroll
            for (int m = 0; m < 4; ++m) { unsigned char* rowp = Y + (size_t)(row0 + ai * 128 + m * 16) * D + col0;
#pragma unroll
                for (int bj = 0; bj < 2; ++bj) { const float is_ = 1.0f / W8_SCALE; f32x4 v0 = acc[ai][bj][m][0] * is_ + bv[bj][0], v1 = acc[ai][bj][m][1] * is_ + bv[bj][1];
#pragma unroll
                    for (int j = 0; j < 4; ++j) { v0[j] = fminf(fmaxf(v0[j], -448.f), 448.f); v1[j] = fminf(fmaxf(v1[j], -448.f), 448.f); }
                    u32x2 w; int t0 = __builtin_amdgcn_cvt_pk_fp8_f32(v0[0], v0[1], 0, false); t0 = __builtin_amdgcn_cvt_pk_fp8_f32(v0[2], v0[3], t0, true);
                    int t1 = __builtin_amdgcn_cvt_pk_fp8_f32(v1[0], v1[1], 0, false); t1 = __builtin_amdgcn_cvt_pk_fp8_f32(v1[2], v1[3], t1, true);
                    w.x = (unsigned)t0; w.y = (unsigned)t1; *(u32x2*)(rowp + bj * 128) = w; } }
    }
};

constexpr int NSEG = 9;
__device__ __forceinline__ int seg_first(int dir, int s) { return dir == 0 ? (s == 0 ? 0 : 8 + 16 * (s - 1)) : (s == 0 ? 7 : 135 - 16 * (s - 1)); }
__device__ __forceinline__ int seg_count(int s) { return s == 0 ? 8 : 16; }

template <int DKT, int NVT, bool VEC, bool FULL>
__device__ __forceinline__ void wave_seg(const bf16_t* __restrict__ Qg, const bf16_t* __restrict__ Kg, const bf16_t* __restrict__ Vg, int vs, bf16_t* __restrict__ Og,
                                         const float* __restrict__ alpha, float gsc, int b, int cs0, int dcs, int nst, int dir, int strict,
                                         f32x16_t (&S)[DKT][NVT], LAS char* lds, int lane) {
    constexpr int KP = DKT * 64 + 16, VP = NVT * 64 + 16, KC = DKT * 4, VC = NVT * 4;
    constexpr int KRI = 64 / KC, VRI = 64 / VC;
    const int r = lane & 31, h = lane >> 5;
    LAS char* tK = lds; LAS char* tV = lds + 32 * KP; LAS char* tA = tV + 32 * VP; LAS char* tG = tA + DKT * 128;
    u32x4 nK[2 * DKT], nV[2 * NVT]; u32x2 nQ[2 * DKT][2]; f32x4 nA = {1.f, 1.f, 1.f, 1.f};
    const unsigned koff = (unsigned)((lane / KC) * 1024 + (lane % KC) * 16), voff = (unsigned)((lane / VC) * (vs * 2) + (lane % VC) * 16), qoff = (unsigned)(r * 1024 + h * 8);
    const unsigned ooff = (unsigned)(h * 4 * 1024 + r * 2), ldk = (unsigned)((lane / KC) * KP + (lane % KC) * 16), ldv = (unsigned)((lane / VC) * VP + (lane % VC) * 16);
    {   const size_t m0 = (size_t)b * LT + cs0 * 32;
        const GAS char* kb = uni_ptr(Kg + m0 * 512); const GAS char* vb = uni_ptr(Vg + m0 * vs);
#pragma unroll
        for (int i = 0; i < 2 * DKT; ++i) nK[i] = *(const GAS u32x4*)(kb + koff + i * (KRI * 1024));
#pragma unroll
        for (int i = 0; i < 2 * NVT; ++i) nV[i] = *(const GAS u32x4*)(vb + voff + (size_t)i * VRI * (vs * 2));
        if (FULL) { const GAS char* qb = uni_ptr(Qg + m0 * 512);
#pragma unroll
            for (int x = 0; x < 2 * DKT; ++x) { nQ[x][0] = *(const GAS u32x2*)(qb + qoff + 32 * x); nQ[x][1] = *(const GAS u32x2*)(qb + qoff + 32 * x + 16); } }
        if (VEC) nA = *(const GAS f32x4*)(uni_ptr(alpha + (size_t)cs0 * 512) + (unsigned)((lane & (DKT * 8 - 1)) * 16)); }
    f32x16_t Oprev[NVT]; GAS char* ob_prev = nullptr;
    for (int si = 0; si < nst; ++si) {
        const int cs = cs0 + si * dcs; const size_t m0 = (size_t)b * LT + cs * 32;
#pragma unroll
        for (int i = 0; i < 2 * DKT; ++i) *(LAS u32x4*)(tK + ldk + i * (KRI * KP)) = nK[i];
#pragma unroll
        for (int i = 0; i < 2 * NVT; ++i) *(LAS u32x4*)(tV + ldv + i * (VRI * VP)) = nV[i];
        if (VEC) { *(LAS f32x4*)(tA + (lane & (DKT * 8 - 1)) * 16) = nA;
            if (!FULL) { LAS f32x4* gp = (LAS f32x4*)(tG + (lane & (DKT * 8 - 1)) * 16); const f32x4 gprev = si == 0 ? (f32x4){1.f, 1.f, 1.f, 1.f} : *gp; asm volatile("s_waitcnt lgkmcnt(0)" ::: "memory"); *gp = gprev * nA; } }
        if (FULL && si > 0) {
#pragma unroll
            for (int n = 0; n < NVT; ++n)
#pragma unroll
                for (int i = 0; i < 16; ++i) *(GAS bf16_t*)(ob_prev + ooff + ((i & 3) + 8 * (i >> 2)) * 1024 + 64 * n) = (bf16_t)(pk_bf16(Oprev[n][i], 0.f) & 0xffffu); }
        bf16x8_t Qf[2 * DKT];
        if (FULL) {
#pragma unroll
            for (int x = 0; x < 2 * DKT; ++x) { u32x4 w; w[0] = nQ[x][0][0]; w[1] = nQ[x][0][1]; w[2] = nQ[x][1][0]; w[3] = nQ[x][1][1]; Qf[x] = __builtin_bit_cast(bf16x8_t, w); } }
        const size_t m1 = (size_t)b * LT + (cs + dcs) * 32;
        if (si + 1 < nst) { const GAS char* kb = uni_ptr(Kg + m1 * 512); const GAS char* vb = uni_ptr(Vg + m1 * vs);
#pragma unroll
            for (int i = 0; i < 2 * DKT; ++i) nK[i] = *(const GAS u32x4*)(kb + koff + i * (KRI * 1024));
#pragma unroll
            for (int i = 0; i < 2 * NVT; ++i) nV[i] = *(const GAS u32x4*)(vb + voff + (size_t)i * VRI * (vs * 2));
            if (VEC) nA = *(const GAS f32x4*)(uni_ptr(alpha + (size_t)(cs + dcs) * 512) + (unsigned)((lane & (DKT * 8 - 1)) * 16));
        }
        asm volatile("s_waitcnt lgkmcnt(0)" ::: "memory");
        if (FULL) {
            f32x16_t X, X2; bf16x8_t Kf[2 * DKT];
#pragma unroll
            for (int x = 0; x < 2 * DKT; ++x) Kf[x] = frag_row(tK, KP, r, 16 * x + 4 * h);
#pragma unroll
            for (int i = 0; i < 16; ++i) { X[i] = 0.f; X2[i] = 0.f; }
#pragma unroll
            for (int x = 0; x < 2 * DKT; x += 2) { X = MFMA32(Kf[x], Qf[x], X); X2 = MFMA32(Kf[x + 1], Qf[x + 1], X2); }
#pragma unroll
            for (int i = 0; i < 16; ++i) X[i] += X2[i];
#pragma unroll
            for (int i = 0; i < 16; ++i) { const int j = (i & 3) + 8 * (i >> 2) + 4 * h; const bool keep = dir == 0 ? (j <= r) : (j >= r + strict); X[i] = keep ? X[i] : 0.f; }
            const bf16x8_t Xa0 = pack8<0>(X), Xa1 = pack8<1>(X);
            ob_prev = (GAS char*)uni_ptr(Og + m0 * 512);
#pragma unroll
            for (int n = 0; n < NVT; ++n) {
                f32x16_t O;
#pragma unroll
                for (int i = 0; i < 16; ++i) O[i] = 0.f;
                O = MFMA32(Xa0, frag_tr(tV, VP, 4 * h, n, lane), O);
                O = MFMA32(Xa1, frag_tr(tV, VP, 16 + 4 * h, n, lane), O);
#pragma unroll
                for (int a = 0; a < DKT; ++a) { O = MFMA32(Qf[2 * a], pack8<0>(S[a][n]), O); O = MFMA32(Qf[2 * a + 1], pack8<1>(S[a][n]), O); }
                Oprev[n] = O;
                    }
            asm volatile("" ::: "memory");
            if (si + 1 < nst) { const GAS char* qb = uni_ptr(Qg + m1 * 512);
#pragma unroll
                for (int x = 0; x < 2 * DKT; ++x) { nQ[x][0] = *(const GAS u32x2*)(qb + qoff + 32 * x); nQ[x][1] = *(const GAS u32x2*)(qb + qoff + 32 * x + 16); } }
        }
#pragma unroll
        for (int a = 0; a < DKT; ++a) {
            f32x4 al[4];
            if (VEC) {
#pragma unroll
                for (int g = 0; g < 4; ++g) al[g] = *(const LAS f32x4*)(tA + (32 * a + 8 * g + 4 * h) * 4); }
            const bf16x8_t k0 = frag_tr(tK, KP, 4 * h, a, lane), k1 = frag_tr(tK, KP, 16 + 4 * h, a, lane);
#pragma unroll
            for (int n = 0; n < NVT; ++n) {
                S[a][n] = MFMA32(k0, frag_tr(tV, VP, 4 * h, n, lane), S[a][n]);
                S[a][n] = MFMA32(k1, frag_tr(tV, VP, 16 + 4 * h, n, lane), S[a][n]);
#pragma unroll
                for (int i = 0; i < 16; ++i) S[a][n][i] *= VEC ? al[i >> 2][i & 3] : gsc;
            }
        }
    }
    if (FULL && nst > 0) {
#pragma unroll
        for (int n = 0; n < NVT; ++n)
#pragma unroll
            for (int i = 0; i < 16; ++i) *(GAS bf16_t*)(ob_prev + ooff + ((i & 3) + 8 * (i >> 2)) * 1024 + 64 * n) = (bf16_t)(pk_bf16(Oprev[n][i], 0.f) & 0xffffu); }
}

template <int DKT, int NVT, bool VEC, bool FULL>
__device__ __forceinline__ void chain_task(const Params& p, int l, int chain, int seg, LAS char* lds, int lane) {
    int b, dir, strict; const bf16_t *Qg, *Kg, *Vg; bf16_t* Og; const float* alpha = nullptr; float gsc = 0.f; size_t tbase;
    if (!VEC) { const int h = chain & 7; b = chain >> 4; dir = (chain >> 3) & 1; strict = 1; const float gam = 1.0f / (1.0f + expf(-p.ret_decay[l * 16 + dir * 8 + h])); gsc = exp2f(32.0f * log2f(gam));
        Qg = p.RQ + (size_t)dir * MT * 512 + h * 64; Kg = p.RK + (size_t)dir * MT * 512 + h * 64; Vg = p.U + C_RV + h * 64; Og = p.Oret + (size_t)dir * MT * 512 + h * 64; tbase = (size_t)chain * NSEG;
    } else { const int h = (chain >> 2) & 3, dq = chain & 3; b = chain >> 5; dir = (chain >> 4) & 1; strict = 0;
        Qg = p.HQ + (size_t)dir * MT * 512 + h * 128; Kg = p.HK + (size_t)dir * MT * 512 + h * 128; Vg = p.U + C_HI + h * 128 + dq * 32; Og = p.Ohg + (size_t)dir * MT * 512 + h * 128 + dq * 32;
        alpha = p.HA + ((size_t)dir * NCH + b * 136) * 512 + h * 128; tbase = (size_t)(64 + chain) * NSEG; }
    f32x16_t S[DKT][NVT];
#pragma unroll
    for (int a = 0; a < DKT; ++a)
#pragma unroll
        for (int n = 0; n < NVT; ++n)
#pragma unroll
            for (int i = 0; i < 16; ++i) S[a][n][i] = 0.f;
    constexpr int TS = DKT * NVT * 16 * 64, TG = 128;
    const int h = lane >> 5;
    if (FULL) {
        for (int s2 = 0; s2 < seg; ++s2) { const float* e = p.SE + (tbase + s2) * TS + lane; const float* gq = p.SG + (tbase + s2) * TG + 4 * h; const float gs = s2 == 0 ? 0.f : exp2f(16.0f * log2f(gsc));
#pragma unroll
            for (int a = 0; a < DKT; ++a) {
                f32x4 gv[4];
#pragma unroll
                for (int g = 0; g < 4; ++g) gv[g] = VEC ? *(const f32x4*)(gq + 32 * a + 8 * g) : (f32x4){gs, gs, gs, gs};
#pragma unroll
                for (int n = 0; n < NVT; ++n)
#pragma unroll
                    for (int i = 0; i < 16; ++i) S[a][n][i] = gv[i >> 2][i & 3] * S[a][n][i] + e[((a * NVT + n) * 16 + i) * 64]; } }
    }
    wave_seg<DKT, NVT, VEC, FULL>(Qg, Kg, Vg, INC, Og, alpha, gsc, b, seg_first(dir, seg), dir == 0 ? 1 : -1, seg_count(seg), dir, strict, S, lds, lane);
    if (!FULL) { float* e = p.SE + (tbase + seg) * TS + lane;
#pragma unroll
        for (int a = 0; a < DKT; ++a)
#pragma unroll
            for (int n = 0; n < NVT; ++n)
#pragma unroll
                for (int i = 0; i < 16; ++i) e[((a * NVT + n) * 16 + i) * 64] = S[a][n][i];
        if (VEC) { constexpr int KPc = DKT * 64 + 16, VPc = NVT * 64 + 16;
            const f32x4 gfin = *(const LAS f32x4*)(lds + 32 * KPc + 32 * VPc + DKT * 128 + (lane & (DKT * 8 - 1)) * 16);
            if (lane < DKT * 8) *(f32x4*)(p.SG + (tbase + seg) * TG + lane * 4) = gfin; }
    }
}

template <bool FULL, int VAR = 0> __device__ __forceinline__ void sweep_phase(const Params& p, int l, float* ldsf) {
    const int tid = TIDX, wave = __builtin_amdgcn_readfirstlane(tid >> 6); const int G = (int)gridDim.x;
    constexpr int NS = FULL ? NSEG : NSEG - 1;
    constexpr int N_HG = 128 * NS, N_RET = 64 * NS, N_LRU = FULL ? 0 : 64;
    LAS char* lds = (LAS char*)ldsf + wave * 12288;
    const int NW = 8 * G, w = wave * G + (int)blockIdx.x;
#ifndef NO_HG
    if (VAR != 2) for (int t = w; t < N_HG; t += NW) { const int chain = t / NS, seg = t - chain * NS; chain_task<4, 1, true, FULL>(p, l, chain, seg, lds, TIDX & 63); }
#endif
#ifndef NO_RET
    if (VAR != 1) for (int t = (w + NW - N_HG % NW) % NW; t < N_RET; t += NW) { const int chain = t / NS, seg = t - chain * NS; chain_task<2, 2, false, FULL>(p, l, chain, seg, lds, TIDX & 63); }
#endif
    for (int t = (w + NW - (N_HG + N_RET) % NW) % NW; t < N_LRU; t += NW) lru_tilescan_task(p, t, TIDX & 63);
}

__device__ __forceinline__ void mixprep_phase(const Params& p, int l) {
    const int tid = TIDX, lane = tid & 63; const int gw = blockIdx.x * (NTHREADS / 64) + __builtin_amdgcn_readfirstlane(tid >> 6), nw = gridDim.x * (NTHREADS / 64);
    float lgd[2];
#pragma unroll
    for (int dir = 0; dir < 2; ++dir) { const float gam = 1.0f / (1.0f + expf(-p.ret_decay[l * 16 + dir * 8 + (lane >> 3)])); lgd[dir] = log2f(gam); }
    for (int m = gw; m < MT; m += nw) {
        const int b = m / LT, pp = m - b * LT; const int hh = lane >> 3, d0 = (lane & 7) * 4;
        const bf16_t* u = p.U + (size_t)m * INC + hh * 64 + d0;
        const u32x2 qlo = *(const u32x2*)(u + C_RQ), qhi = *(const u32x2*)(u + C_RQ + 32), klo = *(const u32x2*)(u + C_RK), khi = *(const u32x2*)(u + C_RK + 32);
        float q1[4] = {bflo(qlo[0]), bfhi(qlo[0]), bflo(qlo[1]), bfhi(qlo[1])}, q2[4] = {bflo(qhi[0]), bfhi(qhi[0]), bflo(qhi[1]), bfhi(qhi[1])};
        float k1[4] = {bflo(klo[0]) * 0.125f, bfhi(klo[0]) * 0.125f, bflo(klo[1]) * 0.125f, bfhi(klo[1]) * 0.125f}, k2[4] = {bflo(khi[0]) * 0.125f, bfhi(khi[0]) * 0.125f, bflo(khi[1]) * 0.125f, bfhi(khi[1]) * 0.125f};
        if (pp >= LC) { const int tt = pp - LC;
            const float4 r0 = *(const float4*)(p.rot + (size_t)(tt * 32 + d0) * 2), r1 = *(const float4*)(p.rot + (size_t)(tt * 32 + d0) * 2 + 4);
            const float cc[4] = {r0.x, r0.z, r1.x, r1.z}, ss[4] = {r0.y, r0.w, r1.y, r1.w};
#pragma unroll
            for (int i = 0; i < 4; ++i) { const float a = q1[i] * cc[i] - q2[i] * ss[i], bq = q1[i] * ss[i] + q2[i] * cc[i]; q1[i] = a; q2[i] = bq;
                const float ck = k1[i] * cc[i] - k2[i] * ss[i], dk = k1[i] * ss[i] + k2[i] * cc[i]; k1[i] = ck; k2[i] = dk; } }
        const int ii = pp & 31;
#pragma unroll
        for (int dir = 0; dir < 2; ++dir) { const float lg = lgd[dir]; const float e = dir == 0 ? (float)(ii + 1) : (float)(32 - ii);
            const float sq = __builtin_amdgcn_exp2f(e * lg), sk = __builtin_amdgcn_exp2f(-e * lg);
            bf16_t* oq = p.RQ + ((size_t)dir * MT + m) * 512 + hh * 64 + d0; bf16_t* ok = p.RK + ((size_t)dir * MT + m) * 512 + hh * 64 + d0;
            u32x2 w; w[0] = pk_bf16(q1[0] * sq, q1[1] * sq); w[1] = pk_bf16(q1[2] * sq, q1[3] * sq); *(u32x2*)oq = w;
            w[0] = pk_bf16(q2[0] * sq, q2[1] * sq); w[1] = pk_bf16(q2[2] * sq, q2[3] * sq); *(u32x2*)(oq + 32) = w;
            w[0] = pk_bf16(k1[0] * sk, k1[1] * sk); w[1] = pk_bf16(k1[2] * sk, k1[3] * sk); *(u32x2*)ok = w;
            w[0] = pk_bf16(k2[0] * sk, k2[1] * sk); w[1] = pk_bf16(k2[2] * sk, k2[3] * sk); *(u32x2*)(ok + 32) = w; }
    }
    for (int unit = gw; unit < NCH * 8; unit += nw) {
        const int dir = unit & 1, ch = unit >> 3, hd = (unit >> 1) & 3, b = ch / 136, cs = ch - b * 136; const size_t m0 = (size_t)b * LT + cs * 32; const int c = hd * 128 + 2 * lane;
        unsigned zz_[32], qq[32]; const int zc = dir == 0 ? C_HFF : C_HFB;
        { const bf16_t* u = p.U + m0 * INC + c;
#pragma unroll
          for (int j = 0; j < 32; ++j) { zz_[j] = *(const unsigned*)(u + (size_t)j * INC + zc); qq[j] = *(const unsigned*)(u + (size_t)j * INC + C_HQ); } }
        const float lb0 = p.lb[l * 1024 + dir * 512 + c], lb1 = p.lb[l * 1024 + dir * 512 + c + 1];
        float G0 = 1.f, G1 = 1.f;
        if (dir == 0) {
#pragma unroll
            for (int s = 0; s < 32; ++s) { const int j = s; const unsigned zz = zz_[j];
                const float z0 = bflo(zz), z1 = bfhi(zz), qa = bflo(qq[j]), qb = bfhi(qq[j]);
                const float s0 = sigmoidf_(z0), s1 = sigmoidf_(z1); const float f0 = lb0 + (1.0f - lb0) * s0, f1 = lb1 + (1.0f - lb1) * s1;
                G0 *= f0; G1 *= f1;
                const float K0 = (1.0f - lb0) * (1.0f - s0) * __builtin_amdgcn_rcpf(fmaxf(G0, 1.0e-35f)), K1 = (1.0f - lb1) * (1.0f - s1) * __builtin_amdgcn_rcpf(fmaxf(G1, 1.0e-35f));
                *(unsigned*)(p.HQ + ((size_t)dir * MT + m0 + j) * 512 + c) = pk_bf16(qa * sigmoidf_(qa) * G0, qb * sigmoidf_(qb) * G1); *(unsigned*)(p.HK + ((size_t)dir * MT + m0 + j) * 512 + c) = pk_bf16(K0, K1); }
        } else {
#pragma unroll
            for (int s = 0; s < 32; ++s) { const int j = 31 - s; const unsigned zz = zz_[j];
                const float z0 = bflo(zz), z1 = bfhi(zz), qa = bflo(qq[j]), qb = bfhi(qq[j]);
                const float s0 = sigmoidf_(z0), s1 = sigmoidf_(z1); const float f0 = lb0 + (1.0f - lb0) * s0, f1 = lb1 + (1.0f - lb1) * s1;
                G0 *= f0; G1 *= f1;
                const float K0 = (1.0f - lb0) * (1.0f - s0) * __builtin_amdgcn_rcpf(fmaxf(G0, 1.0e-35f)), K1 = (1.0f - lb1) * (1.0f - s1) * __builtin_amdgcn_rcpf(fmaxf(G1, 1.0e-35f));
                *(unsigned*)(p.HQ + ((size_t)dir * MT + m0 + j) * 512 + c) = pk_bf16(qa * sigmoidf_(qa) * G0, qb * sigmoidf_(qb) * G1); *(unsigned*)(p.HK + ((size_t)dir * MT + m0 + j) * 512 + c) = pk_bf16(K0, K1); }
        }
        *(f32x2_t*)(p.HA + ((size_t)dir * NCH + ch) * 512 + c) = (f32x2_t){G0, G1};
    }
}

#ifndef GP_SP2
#define GP_SP2 true
#endif
#ifndef GP_ALIGN
#define GP_ALIGN true
#endif
constexpr int LDS_MAIN = 1024 * 36 * 4;
constexpr int LDS_TOTAL = LDS_MAIN + 16;

struct EpiScaledBf16 {
    static constexpr bool PERM = true, AFTER_DRAIN = false;
    bf16_t* O; int ldc; float scale;
    __device__ __forceinline__ void operator()(const f32x4 (&acc)[2][2][4][2], const Unit& u, int wr, int wc, int fr, int fq) const {
        bf16_t* base = O + (size_t)(u.pm * 256 + wr * 64 + fr) * ldc + u.pn * 256 + wc * 32 + 8 * fq;
#pragma unroll
        for (int ai = 0; ai < 2; ++ai)
#pragma unroll
            for (int m = 0; m < 4; ++m) { bf16_t* rowp = base + (size_t)(ai * 128 + m * 16) * ldc;
#pragma unroll
                for (int bj = 0; bj < 2; ++bj) { const f32x4 v0 = acc[ai][bj][m][0] * scale, v1 = acc[ai][bj][m][1] * scale;
                    u32x4 w; w.x = pg8::cvt_pk_bf16(v0[0], v0[1]); w.y = pg8::cvt_pk_bf16(v0[2], v0[3]); w.z = pg8::cvt_pk_bf16(v1[0], v1[1]); w.w = pg8::cvt_pk_bf16(v1[2], v1[3]);
                    *(u32x4*)(rowp + bj * 128) = w; } }
    }
};
__device__ __forceinline__ void gemm_in_phase(const Params& p, int l) {
    { pg8::Gemm g; g.A = p.H; g.Bt = p.wt_in + (size_t)l * INC * D; g.M = MT; g.N = C_GR; g.K = D;
      pg8::StaticOrder S; S.init(MT, C_GR, (int)gridDim.x, (int)blockIdx.x);
      pg8::EpiBf16<0> E; E.O = p.U; E.ldc = INC; E.bias = nullptr; E.split_cols = 0; E.split_stride = 0;
      pg8::gemm_phase<pg8::EpiBf16<0>, pg8::StaticOrder, GP_ALIGN, GP_SP2>((LAS unsigned char*)dyn_lds, g, S, E); }
    { pg8::Gemm g; g.A = (const bf16_t*)p.H8; g.Bt = (const bf16_t*)(p.wt_ing + (size_t)l * (INC - C_GR) * D); g.M = MT; g.N = INC - C_GR; g.K = D / 2;
      const int G = (int)gridDim.x, rot = (G - (MT / 256) * (C_GR / 256) % G) & ~7;
      pg8::StaticOrder S; S.init(MT, INC - C_GR, G, ((int)blockIdx.x + rot) % G);
      EpiScaledBf16 E; E.O = p.U + C_GR; E.ldc = INC; E.scale = 1.0f / W8_SCALE;
      pg8::gemm_phase<EpiScaledBf16, pg8::StaticOrder, GP_ALIGN, GP_SP2, true>((LAS unsigned char*)dyn_lds, g, S, E); }
}
__device__ __forceinline__ void gemm_merge_phase(const Params& p, int l) {
    pg8::Gemm g; g.A = p.Aall; g.Bt = p.wt_br + (size_t)l * 3 * 1024 * 512; g.M = 3 * MT; g.N = 3 * 1024; g.K = 512;
    SchedMerge S; S.G = (int)gridDim.x; S.c = (int)blockIdx.x; S.last = (l == DEPTH - 1);
    EpiBranch E; E.R = p.R;
    pg8::gemm_phase<EpiBranch, SchedMerge, GP_ALIGN, GP_SP2>((LAS unsigned char*)dyn_lds, g, S, E);
}
__device__ __forceinline__ void gemm_out_phase(const Params& p, int l) {
    pg8::Gemm g; g.A = p.Mg; g.Bt = p.wt_out + (size_t)l * D * D; g.M = MT; g.N = D; g.K = D;
    SchedOut S; S.init(MT, D, (int)gridDim.x, (int)blockIdx.x, l == DEPTH - 1);
    EpiOut E; E.Dx = p.Dx; E.mod_l = p.mod + (size_t)l * 5 * 6144;
    pg8::gemm_phase<EpiOut, SchedOut, GP_ALIGN, GP_SP2>((LAS unsigned char*)dyn_lds, g, S, E);
}
__device__ __forceinline__ void gemm_gu_phase(const Params& p, int l) {
    pg8::Gemm g; g.A = (const bf16_t*)p.Xg; g.Bt = (const bf16_t*)(p.wt_gu + (size_t)l * NE * 2048 * D); g.M = NE * CAPT * 256; g.N = NE * 2048; g.K = D / 2;
    build_tile_table(p, l);
    SchedMoE S; S.nN = 8; S.G = (int)gridDim.x; S.c = (int)blockIdx.x; S.sparseA = 1;
    EpiGU E; E.Act = p.Act; E.bgu = p.exp_b_gu + (size_t)l * NE * 2048;
    pg8::gemm_phase<EpiGU, SchedMoE, GP_ALIGN, GP_SP2, true>((LAS unsigned char*)dyn_lds, g, S, E);
}
__device__ __forceinline__ void gemm_down_phase(const Params& p, int l) {
    pg8::Gemm g; g.A = (const bf16_t*)p.Act; g.Bt = (const bf16_t*)(p.wt_down + (size_t)l * NE * D * D); g.M = MAXSLOTS; g.N = NE * D; g.K = D / 2;
    build_tile_table(p, l);
    SchedMoE S; S.nN = 4; S.G = (int)gridDim.x; S.c = (int)blockIdx.x; S.sparseA = 0;
    EpiDown E; E.Y = p.Y; E.bd = p.exp_b_down + (size_t)l * NE * D;
    pg8::gemm_phase<EpiDown, SchedMoE, GP_ALIGN, GP_SP2, true>((LAS unsigned char*)dyn_lds, g, S, E);
}

typedef __attribute__((address_space(4))) const Params* KParamsPtr;
__device__ __forceinline__ const Params& fresh_params() { KParamsPtr kp = (KParamsPtr)__builtin_amdgcn_kernarg_segment_ptr(); asm volatile("" : "+s"(kp)); return *(const Params*)kp; }
#define P_ fresh_params()
#ifdef BARRIER_TWICE
#define GRID_BARRIER() do { XcdBarrier _b = bar; asm volatile("" : "+s"(_b.bar), "+s"(_b.x)); xcd_barrier(_b); xcd_barrier(_b); } while (0)
#else
#define GRID_BARRIER() do { XcdBarrier _b = bar; asm volatile("" : "+s"(_b.bar), "+s"(_b.x)); xcd_barrier(_b); } while (0)
#endif
__global__ __launch_bounds__(512, 2) void k_fwd(Params p) {
    float* ldsf = (float*)dyn_lds;
#ifdef PROBE_PHASE
#ifndef PROBE_SHIFT
#define PROBE_SHIFT 0.0f
#endif
#ifndef PROBE_Q
#define PROBE_Q 50.0f
#endif
    unsigned long long pr_t0 = wall_clock64(), pr_prev = pr_t0, pr_acc = 0ull;
#define PMARK(id) do { const unsigned long long _t = wall_clock64(); if ((id) == PROBE_PHASE) pr_acc += _t - pr_prev; pr_prev = _t; } while (0)
#else
#define PMARK(id) do { } while (0)
#endif
    if (threadIdx.x == 0) *(uint4*)(dyn_lds + LDS_MAIN) = make_uint4(0u, 0u, 0u, 0u);
    __syncthreads();
    const XcdBarrier bar = xcd_barrier_post(P_.bar, (volatile LAS unsigned*)(dyn_lds + LDS_MAIN));
    convert_phase(P_, ldsf);
    mod_phase(P_, ldsf);
    small_phase(P_);
    GRID_BARRIER(); PMARK(0);
    norm_phase<0>(P_, 0);
    router_prep_phase(P_);
    GRID_BARRIER(); PMARK(1);
    for (int l = 0; l < DEPTH; ++l) {
        if (l > 0) { norm_phase<1>(P_, l); GRID_BARRIER(); PMARK(1); }
        gemm_in_phase(P_, l);
        GRID_BARRIER(); PMARK(2);
        mixprep_phase(P_, l);
#ifdef MIXPREP_TWICE
        mixprep_phase(P_, l);
#endif
#ifdef SPLIT_PREP
        GRID_BARRIER(); PMARK(16);
#endif
        lru_prep_phase(P_, l, ldsf);
#ifdef LRU_TWICE
        __syncthreads(); lru_prep_phase(P_, l, ldsf);
#endif
        GRID_BARRIER(); PMARK(3);
        sweep_phase<false>(P_, l, ldsf);
        GRID_BARRIER(); PMARK(4);
        sweep_phase<true>(P_, l, ldsf);
        GRID_BARRIER(); PMARK(13);
#ifdef SWEEP2_AGAIN
        { Params q = P_; q.Oret = q.Dummy; q.Ohg = q.Dummy; sweep_phase<true, SWEEP2_AGAIN - 1>(q, l, ldsf); }
        GRID_BARRIER();
#endif

        finish_phase(P_, l, l == DEPTH - 1);
        GRID_BARRIER(); PMARK(5);
        gemm_merge_phase(P_, l);
        GRID_BARRIER(); PMARK(6);
        merge_combine_phase(P_, l == DEPTH - 1);
        GRID_BARRIER(); PMARK(17);
        gemm_out_phase(P_, l);
        GRID_BARRIER(); PMARK(7);
        route_phase(P_, l, ldsf, l == DEPTH - 1);
        GRID_BARRIER(); PMARK(8);
        gemm_gu_phase(P_, l);
        GRID_BARRIER(); PMARK(11);
        gemm_down_phase(P_, l);
        GRID_BARRIER(); PMARK(12);
    }
#ifdef PROBE_PHASE
    if (blockIdx.x == 0 && threadIdx.x == 0) {
#ifdef PROBE_ABS
        const float fr = (float)((double)pr_acc / 100.0 / PROBE_ABS);
#else
        const float fr = (float)((double)pr_acc / (double)(pr_prev - pr_t0));
#endif
 ((float*)p.ctrl)[2048] = floorf(fr * PROBE_Q + 0.5f + PROBE_SHIFT) / PROBE_Q; }
    GRID_BARRIER();
#endif
    norm_phase<2>(P_, DEPTH);
}

static inline size_t align_up(size_t v, size_t a) { return (v + a - 1) / a * a; }

extern "C" void kernel_launch(void* const* d_in, const int* in_sizes, int n_in, void* d_out, int out_size, void* d_ws, size_t ws_size, hipStream_t stream) {
    (void)in_sizes; (void)n_in; (void)out_size; (void)ws_size;
    Params p{};
    const float** pin = (const float**)&p.x;
    for (int i = 0; i < 31; ++i) pin[i] = (const float*)d_in[i];
    p.out = (float*)d_out;
    char* w = (char*)d_ws; size_t off = 0;
    auto take = [&](size_t bytes) { char* r = w + off; off = align_up(off + bytes, 256); return r; };
    p.bar = (unsigned*)take(XCD_BAR_WORDS * 4);
    p.ctrl = (unsigned*)take(4096 * 4);
    const size_t zero_bytes = off;
    p.wt_in = (bf16_t*)take((size_t)DEPTH * INC * D * 2);
    p.wt_br = (bf16_t*)take((size_t)DEPTH * 3 * 1024 * 512 * 2);
    p.wt_out = (bf16_t*)take((size_t)DEPTH * D * D * 2);
    p.wt_gu = (unsigned char*)take((size_t)DEPTH * NE * 2048 * D);
    p.wt_down = (unsigned char*)take((size_t)DEPTH * NE * D * D);
    p.mod = (float*)take((size_t)DEPTH * 5 * 6144 * 4);
    p.lb = (float*)take(4096 * 4);
    p.rot = (float*)take((size_t)4096 * 32 * 2 * 4);
    p.X = (bf16_t*)take((size_t)MT * D * 2);
    p.H = (bf16_t*)take((size_t)MT * D * 2); p.H8 = (unsigned char*)take((size_t)MT * D); p.wt_ing = (unsigned char*)take((size_t)DEPTH * (INC - C_GR) * D);
    p.U = (bf16_t*)take((size_t)MT * INC * 2);
    p.Oret = (bf16_t*)take((size_t)2 * MT * 512 * 2);
    p.Ohg = (bf16_t*)take((size_t)2 * MT * 512 * 2);
    p.PH = (unsigned*)take((size_t)2 * MT * 512 * 4);
    p.RQ = (bf16_t*)take((size_t)2 * MT * 512 * 2); p.RK = (bf16_t*)take((size_t)2 * MT * 512 * 2); p.HQ = (bf16_t*)take((size_t)2 * MT * 512 * 2); p.HK = (bf16_t*)take((size_t)2 * MT * 512 * 2);
    p.HA = (float*)take((size_t)2 * (MT / 32) * 512 * 4);
    p.Dummy = (bf16_t*)take((size_t)2 * MT * 512 * 2);
    p.SE = (float*)take((size_t)192 * 9 * 4096 * 4); p.SG = (float*)take((size_t)192 * 9 * 128 * 4); p.LP = (float*)take((size_t)2 * 544 * 512 * 4); p.LH = (float*)take((size_t)2 * 544 * 512 * 4); p.LS = (float*)take((size_t)2 * 544 * 512 * 4);
    p.Aall = (bf16_t*)take((size_t)3 * MT * 512 * 2);
    p.R = (bf16_t*)take((size_t)3 * MT * D * 2); p.Dx = (bf16_t*)take((size_t)MT * D * 2);
    p.Mg = (bf16_t*)take((size_t)MT * D * 2);
    p.tok_e = (int*)take((size_t)MT * 4 * 4); p.tok_pos = (int*)take((size_t)MT * 4 * 4); p.tok_w = (float*)take((size_t)MT * 4 * 4);
    p.RWp = (float*)take((size_t)DEPTH * 5 * 1024 * 32 * 4); p.RC = (float*)take((size_t)DEPTH * 5 * 32 * 4);
    p.Xg = (unsigned char*)take((size_t)NE * CAPT * 256 * D); p.Act = (unsigned char*)take((size_t)MAXSLOTS * D); p.Y = (unsigned char*)take((size_t)MAXSLOTS * D);

    static int grid = 0;
    if (!grid) {
        (void)hipFuncSetAttribute((const void*)k_fwd, hipFuncAttributeMaxDynamicSharedMemorySize, LDS_TOTAL);
        int dev = 0, cus = 0, per_cu = 0;
        (void)hipGetDevice(&dev);
        (void)hipDeviceGetAttribute(&cus, hipDeviceAttributeMultiprocessorCount, dev);
        (void)hipOccupancyMaxActiveBlocksPerMultiprocessor(&per_cu, (const void*)k_fwd, 512, LDS_TOTAL);
        grid = cus * (per_cu < 1 ? per_cu : 1);
        if (grid <= 0) { fprintf(stderr, "k_fwd: occupancy query returned %d blocks per CU on %d CUs\n", per_cu, cus); grid = 0; return; }
    }
    (void)hipMemsetAsync(d_ws, 0, zero_bytes, stream);
    hipLaunchKernelGGL(k_fwd, dim3(grid), dim3(512), LDS_TOTAL, stream, p);
}
```

```cpp
#include <hip/hip_runtime.h>
#include <cstdio>
#include <cstdint>
__device__ __forceinline__ int pg8_tid_fresh() { int t = threadIdx.x; asm volatile("" : "+v"(t)); return t; }
namespace pg8 {
#define PG8_LAS __attribute__((address_space(3)))
typedef unsigned short bf16_t;
typedef short bf16x8 __attribute__((ext_vector_type(8)));
typedef float f32x4 __attribute__((ext_vector_type(4)));
typedef unsigned u32x4 __attribute__((ext_vector_type(4)));
constexpr int BM = 256, BK = 64, HALF = 128, HTB = HALF * BK * 2  , STAGE_BYTES = 8 * HTB, NXCD = 8, WGM = 8;

__host__ __device__ __forceinline__ int lds_byte(int r, int c) { const int st = (r >> 4) * 2 + (c >> 5), rr = r & 15, cc = c & 31, ob = rr * 64 + cc * 2; return st * 1024 + (ob ^ (((ob >> 9) & 1) << 5)); }
__host__ __device__ __forceinline__ void stage_rc(int b, int& R, int& C) { const int st = b / 1024, sb = b % 1024, swz = sb ^ (((sb >> 9) & 1) << 5); R = (st >> 1) * 16 + swz / 64; C = (st & 1) * 32 + (swz % 64) / 2; }
__host__ __device__ __forceinline__ int perm32(int rho) { const int n = rho >> 4, i = rho & 15; return 8 * (i >> 2) + 4 * n + (i & 3); }

struct Unit { int pm, pn, po; };
struct Gemm { const bf16_t* A; const bf16_t* Bt; int M, N, K; };

struct StaticOrder {
    int nM, nN, nwg, G, c;
    __host__ __device__ void init(int M, int N, int G_, int c_) { nM = M / BM; nN = N / BM; nwg = nM * nN; G = G_; c = c_; }
    __host__ __device__ bool next(int i, Unit& u) const {
        const long L = (long)i * G + c; if (L >= nwg) return false;
        int wgid = (int)L; { const int q = nwg / NXCD, r = nwg % NXCD, xcd = wgid % NXCD, off = wgid / NXCD; wgid = (xcd < r ? xcd * (q + 1) : r * (q + 1) + (xcd - r) * q) + off; }
        const int nig = WGM * nN, gid = wgid / nig, fm = gid * WGM, gsz = (nM - fm) < WGM ? (nM - fm) : WGM;
        u.pm = fm + ((wgid % nig) % gsz); u.pn = (wgid % nig) / gsz; return true;
    }
    __device__ __forceinline__ void a_ready(const Unit&) const {}
    __device__ __forceinline__ void done(const Unit&) const {}
};
__device__ __forceinline__ unsigned cvt_pk_bf16(float lo, float hi) { unsigned r; asm volatile("v_cvt_pk_bf16_f32 %0, %1, %2" : "=v"(r) : "v"(lo), "v"(hi)); return r; }
typedef float f32x2 __attribute__((ext_vector_type(2)));
__device__ __forceinline__ f32x2 gelu_pk(f32x2 v) {
    const f32x2 av = __builtin_elementwise_abs(v), d = av * 0.2316418882f + 1.0f;
    f32x2 t; t.x = __builtin_amdgcn_rcpf(d.x); t.y = __builtin_amdgcn_rcpf(d.y);
    f32x2 q = t * 0.5307027145f + (-0.7265760135f); q = q * t + 0.7107068705f; q = q * t + (-0.142248368f); q = q * t + 0.127414796f; q = q * t;
    const f32x2 s = (v * v) * (-0.72134752044f);
    f32x2 e; e.x = __builtin_amdgcn_exp2f(s.x); e.y = __builtin_amdgcn_exp2f(s.y);
    const f32x2 m = v * (q * e), r = v - m;
    f32x2 o; o.x = v.x < 0.f ? m.x : r.x; o.y = v.y < 0.f ? m.y : r.y; return o;
}

template <int ACT  > struct EpiBf16 {
    static constexpr bool PERM = true, AFTER_DRAIN = false;
    bf16_t* O; int ldc; const float* bias; int split_cols; size_t split_stride;
    __device__ __forceinline__ void operator()(const f32x4 (&acc)[2][2][4][2], const Unit& u, int wr, int wc, int fr, int fq) const {
        const int row0 = u.pm * BM + wr * 64 + fr; int colt = u.pn * BM; bf16_t* base = O;
        if (split_cols) { const int t = colt / split_cols; base += (size_t)t * split_stride; colt -= t * split_cols; }
        const int col0 = colt + wc * 32 + 8 * fq, bcol0 = u.pn * BM + wc * 32 + 8 * fq;
        f32x4 bv[2][2];
#pragma unroll
        for (int bj = 0; bj < 2; ++bj)
#pragma unroll
            for (int n = 0; n < 2; ++n) bv[bj][n] = bias ? *(const f32x4*)(bias + bcol0 + bj * HALF + 4 * n) : (f32x4){0.f, 0.f, 0.f, 0.f};
#pragma unroll
        for (int ai = 0; ai < 2; ++ai)
#pragma unroll
            for (int m = 0; m < 4; ++m) { bf16_t* rowp = base + (size_t)(row0 + ai * HALF + m * 16) * ldc + col0;
#pragma unroll
                for (int bj = 0; bj < 2; ++bj) { f32x4 v0 = acc[ai][bj][m][0] + bv[bj][0], v1 = acc[ai][bj][m][1] + bv[bj][1];
                    if (ACT == 1) { f32x2 a = gelu_pk((f32x2){v0[0], v0[1]}), b = gelu_pk((f32x2){v0[2], v0[3]}), c = gelu_pk((f32x2){v1[0], v1[1]}), d = gelu_pk((f32x2){v1[2], v1[3]});
                        v0 = (f32x4){a.x, a.y, b.x, b.y}; v1 = (f32x4){c.x, c.y, d.x, d.y}; }
                    if (ACT == 2) {
#pragma unroll
                        for (int j = 0; j < 4; ++j) { v0[j] = 0.5f * v0[j] * (1.0f + erff(v0[j] * 0.70710678f)); v1[j] = 0.5f * v1[j] * (1.0f + erff(v1[j] * 0.70710678f)); } }
                    u32x4 w; w.x = cvt_pk_bf16(v0[0], v0[1]); w.y = cvt_pk_bf16(v0[2], v0[3]); w.z = cvt_pk_bf16(v1[0], v1[1]); w.w = cvt_pk_bf16(v1[2], v1[3]);
                    *(u32x4*)(rowp + bj * HALF) = w; } }
    }
};


typedef int i32x4_f8 __attribute__((ext_vector_type(4)));
typedef int i32x8_f8 __attribute__((ext_vector_type(8)));
template <class Epi, class Sched, bool ALIGN_EPI = false, bool SP2 = false, bool F8 = false>
__device__ __forceinline__ void gemm_phase(PG8_LAS unsigned char* lds, const Gemm g, const Sched& S, const Epi& E) {
    const int tid = pg8_tid_fresh(), wid = __builtin_amdgcn_readfirstlane(tid >> 6), lane = tid & 63, wr = wid >> 2, wc = wid & 3, fr = lane & 15, fq = lane >> 4;
    const int K = g.K, nt = K / BK;
    unsigned voffA[2], voffB[2];
#pragma unroll
    for (int i = 0; i < 2; ++i) { int R, C; stage_rc(tid * 16 + i * 8192, R, C); const int Rb = Epi::PERM ? ((R & ~31) + perm32(R & 31)) : R;
        voffA[i] = (unsigned)(R * K + C) * 2u; voffB[i] = (unsigned)(Rb * K + C) * 2u; }
    const size_t kstep = (size_t)(BK * 2);
    const size_t hstep = (size_t)HALF * K * 2;
    const size_t tstep = 2 * hstep;
    const unsigned ldsw = (unsigned)wid * 1024u;
    const int aoff = lds_byte(wr * 64 + fr, fq * 8), boff = lds_byte(wc * 32 + fr, fq * 8);
#define PG8_SA(b, h) (((b) * 2 + (h)) * HTB)
#define PG8_SB(b, h) ((4 + (b) * 2 + (h)) * HTB)
#define PG8_STAGE(bufoff, gbase, voff) do { _Pragma("unroll") for (int _i = 0; _i < 2; ++_i) \
        __builtin_amdgcn_global_load_lds((const unsigned*)((const char*)(gbase) + (voff)[_i]), (PG8_LAS unsigned*)(lds + (bufoff) + ldsw + _i * 8192), 16, 0, 0); } while (0)
#define PG8_LDA(dst, b, h) do { if constexpr (F8) { _Pragma("unroll") for (int m = 0; m < 4; ++m) dst##8[m] = __builtin_shufflevector(*(const PG8_LAS i32x4_f8*)(lds + PG8_SA(b, h) + aoff + m * 2048), *(const PG8_LAS i32x4_f8*)(lds + PG8_SA(b, h) + aoff + m * 2048 + 1024), 0, 1, 2, 3, 4, 5, 6, 7); } \
        else { _Pragma("unroll") for (int m = 0; m < 4; ++m) _Pragma("unroll") for (int k = 0; k < 2; ++k) dst[m][k] = *(const PG8_LAS bf16x8*)(lds + PG8_SA(b, h) + aoff + m * 2048 + k * 1024); } } while (0)
#define PG8_LDB(dst, b, h) do { if constexpr (F8) { _Pragma("unroll") for (int n = 0; n < 2; ++n) dst##8[n] = __builtin_shufflevector(*(const PG8_LAS i32x4_f8*)(lds + PG8_SB(b, h) + boff + n * 2048), *(const PG8_LAS i32x4_f8*)(lds + PG8_SB(b, h) + boff + n * 2048 + 1024), 0, 1, 2, 3, 4, 5, 6, 7); } \
        else { _Pragma("unroll") for (int n = 0; n < 2; ++n) _Pragma("unroll") for (int k = 0; k < 2; ++k) dst[n][k] = *(const PG8_LAS bf16x8*)(lds + PG8_SB(b, h) + boff + n * 2048 + k * 1024); } } while (0)
#define PG8_MMA(ai, bj, At, Bt) do { __builtin_amdgcn_s_setprio(1); _Pragma("unroll") for (int m = 0; m < 4; ++m) _Pragma("unroll") for (int n = 0; n < 2; ++n) { \
        if constexpr (F8) { asm volatile("v_mfma_f32_16x16x128_f8f6f4 %0, %1, %2, %0" : "+v"(acc[ai][bj][m][n]) : "v"(Bt##8[n]), "v"(At##8[m])); } \
        else { _Pragma("unroll") for (int k = 0; k < 2; ++k) acc[ai][bj][m][n] = __builtin_amdgcn_mfma_f32_16x16x32_bf16(Bt[n][k], At[m][k], acc[ai][bj][m][n], 0, 0, 0); } } \
        __builtin_amdgcn_s_setprio(0); } while (0)
#define PG8_WAIT_V(n) asm volatile("s_waitcnt vmcnt(" #n ")" ::: "memory")
#define PG8_WAIT_L(n) asm volatile("s_waitcnt lgkmcnt(" #n ")" ::: "memory")
#define PG8_BAR __builtin_amdgcn_s_barrier()
#define PG8_SCHED __builtin_amdgcn_sched_barrier(0)
    Unit cur, nxt; int ui = 0;
    if (!S.next(0, cur)) return;
    float zf = 0.f; asm volatile("" : "+v"(zf));
    f32x4 acc[2][2][4][2];
#pragma unroll
    for (int a = 0; a < 2; ++a)
#pragma unroll
        for (int b = 0; b < 2; ++b)
#pragma unroll
            for (int m = 0; m < 4; ++m)
#pragma unroll
                for (int n = 0; n < 2; ++n) acc[a][b][m][n] = (f32x4){zf, zf, zf, zf};
    bf16x8 At[4][2], B0[2][2], B1[2][2]; i32x8_f8 At8[4], B08[2], B18[2];
    const char* cA = (const char*)g.A + (size_t)cur.pm * tstep; const char* cB = (const char*)g.Bt + (size_t)cur.pn * tstep;
    S.a_ready(cur);
    if constexpr (SP2) {
        PG8_STAGE(PG8_SB(0, 0), cB, voffB); PG8_STAGE(PG8_SB(0, 1), cB + hstep, voffB); PG8_STAGE(PG8_SA(0, 0), cA, voffA); PG8_STAGE(PG8_SA(0, 1), cA + hstep, voffA);
        if (wr == 1) PG8_BAR;
        PG8_WAIT_V(2); PG8_BAR;
        PG8_STAGE(PG8_SB(1, 0), cB + kstep, voffB); PG8_STAGE(PG8_SA(1, 0), cA + kstep, voffA); PG8_STAGE(PG8_SB(1, 1), cB + hstep + kstep, voffB);
        PG8_WAIT_V(6); PG8_BAR;
    } else {
        PG8_STAGE(PG8_SB(0, 0), cB, voffB); PG8_STAGE(PG8_SA(0, 0), cA, voffA); PG8_STAGE(PG8_SB(0, 1), cB + hstep, voffB); PG8_STAGE(PG8_SA(0, 1), cA + hstep, voffA);
        if (wr == 1) PG8_BAR;
        PG8_WAIT_V(4); PG8_BAR;
        PG8_STAGE(PG8_SB(1, 0), cB + kstep, voffB); PG8_STAGE(PG8_SA(1, 0), cA + kstep, voffA); PG8_STAGE(PG8_SB(1, 1), cB + hstep + kstep, voffB);
        PG8_WAIT_V(6); PG8_BAR;
    }
    for (;;) {
        const bool has_next = S.next(ui + 1, nxt);
        const char* nA = has_next ? (const char*)g.A + (size_t)nxt.pm * tstep : cA; const char* nB = has_next ? (const char*)g.Bt + (size_t)nxt.pn * tstep : cB;
        for (int t = 0; t < nt; t += 2) {
            const bool last = (t == nt - 2);
            const char* a1 = cA + (size_t)(t + 1) * kstep;
            const char* a2 = last ? nA : cA + (size_t)(t + 2) * kstep; const char* b2 = last ? nB : cB + (size_t)(t + 2) * kstep;
            const char* a3 = a2 + kstep; const char* b3 = b2 + kstep;
            if (last && has_next) S.a_ready(nxt);
            if constexpr (SP2) {
            PG8_LDB(B0, 0, 0); PG8_LDB(B1, 0, 1); PG8_SCHED; PG8_LDA(At, 0, 0); PG8_STAGE(PG8_SA(1, 1), a1 + hstep, voffA);
            PG8_WAIT_V(8); PG8_WAIT_L(0); PG8_BAR; PG8_MMA(0, 0, At, B0); PG8_MMA(0, 1, At, B1); PG8_BAR; PG8_SCHED;
            PG8_LDA(At, 0, 1); PG8_STAGE(PG8_SB(0, 0), b2, voffB); PG8_STAGE(PG8_SB(0, 1), b2 + hstep, voffB); PG8_STAGE(PG8_SA(0, 0), a2, voffA);
            PG8_WAIT_V(8); PG8_WAIT_L(0); PG8_BAR; PG8_MMA(1, 0, At, B0); PG8_MMA(1, 1, At, B1); PG8_BAR; PG8_SCHED;
            PG8_LDB(B0, 1, 0); PG8_LDB(B1, 1, 1); PG8_SCHED; PG8_LDA(At, 1, 0); PG8_STAGE(PG8_SA(0, 1), a2 + hstep, voffA);
            PG8_WAIT_V(8); PG8_WAIT_L(0); PG8_BAR; PG8_MMA(0, 0, At, B0); PG8_MMA(0, 1, At, B1); PG8_BAR; PG8_SCHED;
            PG8_LDA(At, 1, 1); PG8_STAGE(PG8_SB(1, 0), b3, voffB); PG8_STAGE(PG8_SB(1, 1), b3 + hstep, voffB); PG8_STAGE(PG8_SA(1, 0), a3, voffA);
            PG8_WAIT_V(8); PG8_WAIT_L(0); PG8_BAR; PG8_MMA(1, 0, At, B0); PG8_MMA(1, 1, At, B1); PG8_BAR; PG8_SCHED;
            } else {
            PG8_LDB(B0, 0, 0); PG8_SCHED; PG8_LDA(At, 0, 0); PG8_STAGE(PG8_SA(1, 1), a1 + hstep, voffA);
            PG8_WAIT_L(8); PG8_BAR; PG8_WAIT_L(0); PG8_MMA(0, 0, At, B0); PG8_BAR; PG8_SCHED;
            PG8_LDB(B1, 0, 1); PG8_STAGE(PG8_SB(0, 0), b2, voffB);
            PG8_BAR; PG8_WAIT_L(0); PG8_MMA(0, 1, At, B1); PG8_BAR;
            PG8_LDA(At, 0, 1); PG8_STAGE(PG8_SA(0, 0), a2, voffA);
            PG8_BAR; PG8_WAIT_L(0); PG8_MMA(1, 0, At, B0); PG8_BAR; PG8_SCHED;
            PG8_STAGE(PG8_SB(0, 1), b2 + hstep, voffB);
            PG8_WAIT_V(6); PG8_BAR; PG8_MMA(1, 1, At, B1); PG8_BAR;
            PG8_LDB(B0, 1, 0); PG8_SCHED; PG8_LDA(At, 1, 0); PG8_STAGE(PG8_SA(0, 1), a2 + hstep, voffA);
            PG8_WAIT_L(8); PG8_BAR; PG8_WAIT_L(0); PG8_MMA(0, 0, At, B0); PG8_BAR; PG8_SCHED;
            PG8_LDB(B1, 1, 1); PG8_STAGE(PG8_SB(1, 0), b3, voffB);
            PG8_BAR; PG8_WAIT_L(0); PG8_MMA(0, 1, At, B1); PG8_BAR;
            PG8_LDA(At, 1, 1); PG8_STAGE(PG8_SA(1, 0), a3, voffA);
            PG8_BAR; PG8_WAIT_L(0); PG8_MMA(1, 0, At, B0); PG8_BAR; PG8_SCHED;
            PG8_STAGE(PG8_SB(1, 1), b3 + hstep, voffB);
            PG8_WAIT_V(6); PG8_BAR; PG8_MMA(1, 1, At, B1); PG8_BAR;
            }
        }
        if constexpr (ALIGN_EPI) { if (wr == 0) PG8_BAR; }
        if constexpr (F8) asm volatile("s_nop 15\n\ts_nop 15" ::: "memory");
        if constexpr (!Epi::AFTER_DRAIN) { E(acc, cur, wr, wc, fr, fq); S.done(cur); }
        if (!has_next) break;
#pragma unroll
        for (int a = 0; a < 2; ++a)
#pragma unroll
            for (int b = 0; b < 2; ++b)
#pragma unroll
                for (int m = 0; m < 4; ++m)
#pragma unroll
                    for (int n = 0; n < 2; ++n) acc[a][b][m][n] = (f32x4){zf, zf, zf, zf};
        cur = nxt; cA = nA; cB = nB; ++ui;
        if constexpr (ALIGN_EPI) { if (wr == 1) PG8_BAR; }
    }
    PG8_WAIT_V(0);
    if constexpr (!ALIGN_EPI) { if (wr == 0) PG8_BAR; }
    PG8_BAR;
    if constexpr (Epi::AFTER_DRAIN) { E.fused(acc, cur, wr, wc, fr, fq, lds, wid, lane); S.done(cur); }
#undef PG8_SA
#undef PG8_SB
#undef PG8_STAGE
#undef PG8_LDA
#undef PG8_LDB
#undef PG8_MMA
#undef PG8_WAIT_V
#undef PG8_WAIT_L
#undef PG8_BAR
#undef PG8_SCHED
}
}
#include <hip/hip_runtime.h>
#include <cstdio>
#include <cstdint>
#include <cstdlib>
#include <vector>

#define XB_TMO      128
#define XB_XCNT(j)  (256  + 64 * (j))
#define XB_XSUB(j)  (1280 + 64 * (j))
#define XB_XGEN(j)  (2304 + 64 * (j))
#define XB_TOP      3328
#define XB_TOPGEN   3392
#define XCD_BAR_WORDS 3456
#define XB_SPIN_CAP (1u << 18)
#ifndef LAS
#define LAS __attribute__((address_space(3)))
#endif

__device__ __forceinline__ unsigned xb_ld(unsigned* p)              { return __hip_atomic_load(p, __ATOMIC_RELAXED, __HIP_MEMORY_SCOPE_AGENT); }
__device__ __forceinline__ unsigned xb_add(unsigned* p, unsigned v) { return __hip_atomic_fetch_add(p, v, __ATOMIC_RELAXED, __HIP_MEMORY_SCOPE_AGENT); }
__device__ __forceinline__ unsigned xb_xcc_id() { return (unsigned)__builtin_amdgcn_s_getreg((3 << 11) | 20) & 0xFu; }
#define XB_SPIN(cond, bar) do { unsigned _sp = 0; while (cond) { __builtin_amdgcn_s_sleep(1); \
    if ((++_sp & 255u) == 0u) { if (xb_ld(&(bar)[XB_TMO])) break; if (_sp > XB_SPIN_CAP) { atomicAdd(&(bar)[XB_TMO], 1u); break; } } } } while (0)

struct XcdBarrier {
    unsigned* bar; unsigned x;
    volatile LAS unsigned* st;
};

__device__ __forceinline__ XcdBarrier xcd_barrier_post(unsigned* bar, volatile LAS unsigned* st) {
    XcdBarrier b; b.bar = bar; b.x = xb_xcc_id(); b.st = st;
    if (threadIdx.x == 0) (void)xb_add(&bar[XB_XCNT(b.x)], 1u);
    return b;
}
__device__ __forceinline__ void xcd_barrier_complete(unsigned* bar, unsigned x, unsigned& nloc, unsigned& nx) {
    const unsigned G = gridDim.x * gridDim.y * gridDim.z;
    unsigned sum, cnt, mine, sp = 0u;
    for (;;) {
        sum = 0u; cnt = 0u; mine = 0u;
#pragma unroll
        for (unsigned j = 0; j < 16; ++j) { const unsigned c = xb_ld(&bar[XB_XCNT(j)]); sum += c; cnt += (c > 0u) ? 1u : 0u; mine = (j == x) ? c : mine; }
        if (sum == G) break;
        __builtin_amdgcn_s_sleep(1);
        if ((++sp & 255u) == 0u) { if (xb_ld(&bar[XB_TMO])) break; if (sp > XB_SPIN_CAP) { atomicAdd(&bar[XB_TMO], 1u); break; } }
    }
    nloc = mine > 0u ? mine : 1u; nx = cnt > 0u ? cnt : 1u;
}

__device__ __forceinline__ void xcd_barrier(const XcdBarrier& b) {
    asm volatile("s_waitcnt vmcnt(0)" ::: "memory");
    __syncthreads();
    if (threadIdx.x == 0) {
        unsigned* bar = b.bar;
        __builtin_amdgcn_s_waitcnt(0);
        unsigned nloc = b.st[0], nx = b.st[1];
        if (nloc == 0u) { xcd_barrier_complete(bar, b.x, nloc, nx); b.st[0] = nloc; b.st[1] = nx; }
        const unsigned old = xb_add(&bar[XB_XSUB(b.x)], 1u);
        const unsigned gen = old / nloc;
        if (old + 1u == (gen + 1u) * nloc) {
            __builtin_amdgcn_fence(__ATOMIC_RELEASE, "agent");
            asm volatile("s_waitcnt vmcnt(0)" ::: "memory");
            const unsigned og = xb_add(&bar[XB_TOP], 1u);
            const unsigned tg = og / nx;
            if (og + 1u == (tg + 1u) * nx) xb_add(&bar[XB_TOPGEN], 1u);
            else XB_SPIN(xb_ld(&bar[XB_TOPGEN]) == tg, bar);
            __builtin_amdgcn_fence(__ATOMIC_ACQUIRE, "agent");
            xb_add(&bar[XB_XGEN(b.x)], 1u);
            asm volatile("s_waitcnt vmcnt(0)" ::: "memory");
        } else {
            XB_SPIN(xb_ld(&bar[XB_XGEN(b.x)]) == gen, bar);
            __builtin_amdgcn_fence(__ATOMIC_ACQUIRE, "agent");
            asm volatile("s_waitcnt vmcnt(0)" ::: "memory");
        }
    }
    __syncthreads();
}


typedef unsigned short bf16_t;
using pg8::f32x4; using pg8::u32x4; using pg8::Unit;
typedef unsigned u32x2 __attribute__((ext_vector_type(2)));
#define LAS __attribute__((address_space(3)))
#define TIDX pg8_tid_fresh()

constexpr int D = 1024, NB = 4, SEQ = 4096, DEPTH = 4, LC = 256, LT = SEQ + LC, MT = NB * LT;
constexpr int INC = 8704;
constexpr int C_RQ = 0, C_RK = 512, C_RV = 1024, C_RG = 1536, C_HQ = 2048, C_HFF = 2560, C_HFB = 3072, C_HI = 3584, C_HGT = 4096, C_LX = 4608, C_LGT = 5120, C_GR = 5632;
constexpr float W8_SCALE = 64.0f;
constexpr int NE = 32, MAXTILES = 304, MAXSLOTS = MAXTILES * 256, CAPT = 68;
constexpr int TB_OFF = 131072;
constexpr int NTHREADS = 512;

struct Params {
    const float *x, *c, *ctx, *c_ctx, *mod_w, *mod_b, *norm1_g, *norm2_g, *final_g, *w_in, *ret_decay, *ret_gn_g, *w_ret_o, *hgrn_lb_logits, *hgrn_gn_g, *w_hgrn_o,
        *lru_conv_w, *lru_conv_b, *lru_wa, *lru_ba, *lru_wx, *lru_bx, *lru_lambda, *w_lru_o, *w_out, *router_w, *router_b, *exp_w_gu, *exp_b_gu, *exp_w_down, *exp_b_down;
    float* out;
    bf16_t *wt_in, *wt_br, *wt_out; unsigned char *wt_gu, *wt_down;
    float *mod, *lb, *rot;
    bf16_t* X; bf16_t* H; unsigned char* H8; unsigned char* wt_ing; bf16_t* U;
    bf16_t *Oret, *Ohg, *Dummy; unsigned* PH;
    bf16_t *RQ, *RK, *HQ, *HK; float *HA, *SE, *SG, *LP, *LH, *LS;
    bf16_t* Aall; bf16_t* R; bf16_t* Mg; bf16_t* Dx;
    unsigned* bar; unsigned* ctrl;
    int *tok_e, *tok_pos; float* tok_w;
    float *RWp, *RC;
    unsigned char *Xg, *Act; unsigned char* Y;
};

__device__ __forceinline__ float bf2f(bf16_t v) { return __uint_as_float(((unsigned)v) << 16); }
__device__ __forceinline__ float bflo(unsigned w) { return __uint_as_float(w << 16); }
__device__ __forceinline__ float bfhi(unsigned w) { return __uint_as_float(w & 0xffff0000u); }
__device__ __forceinline__ float sigmoidf_(float x) { return __builtin_amdgcn_rcpf(1.0f + __expf(-x)); }
__device__ __forceinline__ float shx(float v, int o, int lane) { return __int_as_float(__builtin_amdgcn_ds_bpermute((lane ^ o) << 2, __float_as_int(v))); }
__device__ __forceinline__ float wave_sum(float v, int lane) {
#pragma unroll
    for (int o = 32; o >= 1; o >>= 1) v += shx(v, o, lane);
    return v;
}

extern __shared__ __attribute__((aligned(16))) unsigned char dyn_lds[];
__device__ __forceinline__ unsigned char* dyn_lds_base() { return dyn_lds; }
typedef short bf16x8_t __attribute__((ext_vector_type(8)));
typedef short s16x4_t __attribute__((ext_vector_type(4)));
typedef float f32x16_t __attribute__((ext_vector_type(16)));
typedef float f32x2_t __attribute__((ext_vector_type(2)));
typedef __bf16 bf16v2_t __attribute__((ext_vector_type(2)));
constexpr int NCH = MT / 32;
#define MFMA32(a, b, c) __builtin_amdgcn_mfma_f32_32x32x16_bf16((a), (b), (c), 0, 0, 0)

#define GAS __attribute__((address_space(1)))
__device__ __forceinline__ const GAS char* uni_ptr(const void* p) { const unsigned long long v = (unsigned long long)p;
    const unsigned lo = __builtin_amdgcn_readfirstlane((unsigned)v), hi = __builtin_amdgcn_readfirstlane((unsigned)(v >> 32)); return (const GAS char*)(((unsigned long long)hi << 32) | lo); }
__device__ __forceinline__ unsigned pk_fp8x4(float a, float b, float c, float d) {
    a = fminf(fmaxf(a, -448.f), 448.f); b = fminf(fmaxf(b, -448.f), 448.f); c = fminf(fmaxf(c, -448.f), 448.f); d = fminf(fmaxf(d, -448.f), 448.f);
    int t = __builtin_amdgcn_cvt_pk_fp8_f32(a, b, 0, false); t = __builtin_amdgcn_cvt_pk_fp8_f32(c, d, t, true); return (unsigned)t; }
__device__ __forceinline__ unsigned pk_bf16(float a, float b) { const f32x2_t v = {a, b}; return __builtin_bit_cast(unsigned, __builtin_convertvector(v, bf16v2_t)); }
template <int s> __device__ __forceinline__ bf16x8_t pack8(const f32x16_t& x) {
    u32x4 w; w[0] = pk_bf16(x[8 * s], x[8 * s + 1]); w[1] = pk_bf16(x[8 * s + 2], x[8 * s + 3]); w[2] = pk_bf16(x[8 * s + 4], x[8 * s + 5]); w[3] = pk_bf16(x[8 * s + 6], x[8 * s + 7]);
    return __builtin_bit_cast(bf16x8_t, w);
}
__device__ __forceinline__ bf16x8_t frag_row(const LAS char* t, int pitch, int row, int colbase) {
    const s16x4_t lo = *(const LAS s16x4_t*)(t + row * pitch + colbase * 2), hi = *(const LAS s16x4_t*)(t + row * pitch + colbase * 2 + 16);
    return __builtin_shufflevector(lo, hi, 0, 1, 2, 3, 4, 5, 6, 7);
}
__device__ __forceinline__ bf16x8_t frag_tr(const LAS char* t, int pitch, int jb, int ct, int lane) {
    const int q = (lane & 15) >> 2, pp = lane & 3, blk = (lane >> 4) & 1;
    const LAS char* a0 = t + (jb + q) * pitch + (32 * ct + 16 * blk + 4 * pp) * 2;
    const s16x4_t lo = __builtin_amdgcn_ds_read_tr16_b64_v4i16((LAS s16x4_t*)a0), hi = __builtin_amdgcn_ds_read_tr16_b64_v4i16((LAS s16x4_t*)(a0 + 8 * pitch));
    return __builtin_shufflevector(lo, hi, 0, 1, 2, 3, 4, 5, 6, 7);
}


__device__ __forceinline__ void build_tile_table(const Params& p, int l) {
    LAS int* te = (LAS int*)((LAS char*)dyn_lds_base() + TB_OFF); LAS int* tb = te + MAXTILES; LAS int* tc = tb + NE + 1; const int t = TIDX;
    if (t < NE) tc[t] = ((int)p.ctrl[l * 64 + t] + 255) >> 8;
    __syncthreads();
    if (t <= NE) { int s = 0;
#pragma unroll 1
        for (int k = 0; k < t; ++k) s += tc[k];
        tb[t] = s; }
    __syncthreads();
    if (t < MAXTILES) { int e = 0;
#pragma unroll 1
        for (int k = 1; k < NE; ++k) e += (tb[k] <= t) ? 1 : 0;
        te[t] = e; }
    __syncthreads();
}

__device__ __forceinline__ void convert_tiles(const float* __restrict__ src, bf16_t* __restrict__ dst, int K, int N, size_t sstride, size_t dstride, int mode, int nbatch, float* lds, int f8 = 0, int ld = 0) {
    const int t = TIDX & 255, half = TIDX >> 8; float* tile = lds + half * (64 * 65); if (ld == 0) ld = N;
    const int tn = N / 64, tk = K / 64, per = tn * tk, total = per * nbatch, stride = gridDim.x * 2, hb = blockIdx.x * 2 + half;
    const int iters = (total + stride - 1) / stride;
    for (int it = 0; it < iters; ++it) {
        const int idx = it * stride + hb; const bool valid = idx < total;
        const int bz = idx / per, rem = idx - bz * per, ky = rem / tn, nx = rem - ky * tn; const int n0 = nx * 64, k0 = ky * 64;
        if (valid) { const float* s = src + (size_t)bz * sstride;
#pragma unroll
            for (int i = 0; i < 4; ++i) { const int r = (t >> 4) + 16 * i, cq = (t & 15) * 4; const float4 v = *(const float4*)(s + (size_t)(k0 + r) * ld + n0 + cq);
                tile[r * 65 + cq] = v.x; tile[r * 65 + cq + 1] = v.y; tile[r * 65 + cq + 2] = v.z; tile[r * 65 + cq + 3] = v.w; } }
        __syncthreads();
        if (valid) { bf16_t* d = dst + (size_t)bz * dstride; const int n = t >> 2, kq = (t & 3) * 16;
            int nd = n0 + n; if (mode == 1) { const int j = nd & 1023, up = nd >> 10; nd = (j >> 7) * 256 + up * 128 + (j & 127); }
            if (f8) { unsigned w[4];
#pragma unroll
                for (int i = 0; i < 4; ++i) w[i] = pk_fp8x4(W8_SCALE * tile[(kq + 4 * i) * 65 + n], W8_SCALE * tile[(kq + 4 * i + 1) * 65 + n], W8_SCALE * tile[(kq + 4 * i + 2) * 65 + n], W8_SCALE * tile[(kq + 4 * i + 3) * 65 + n]);
                *(uint4*)((unsigned char*)dst + (size_t)bz * dstride + (size_t)nd * K + k0 + kq) = make_uint4(w[0], w[1], w[2], w[3]);
            } else { unsigned w[8];
#pragma unroll
            for (int i = 0; i < 8; ++i) w[i] = pg8::cvt_pk_bf16(tile[(kq + 2 * i) * 65 + n], tile[(kq + 2 * i + 1) * 65 + n]);
            uint4* o = (uint4*)(d + (size_t)nd * K + k0 + kq); o[0] = make_uint4(w[0], w[1], w[2], w[3]); o[1] = make_uint4(w[4], w[5], w[6], w[7]); } }
        __syncthreads();
    }
}
__device__ __forceinline__ void convert_phase(const Params& p, float* lds) {
    convert_tiles(p.w_in, p.wt_in, D, C_GR, (size_t)D * INC, (size_t)INC * D, 0, DEPTH, lds, 0, INC);
    convert_tiles(p.w_in + C_GR, (bf16_t*)p.wt_ing, D, INC - C_GR, (size_t)D * INC, (size_t)(INC - C_GR) * D, 0, DEPTH, lds, 1, INC);
    convert_tiles(p.w_ret_o, p.wt_br, 512, 1024, (size_t)512 * 1024, (size_t)3 * 1024 * 512, 0, DEPTH, lds);
    convert_tiles(p.w_hgrn_o, p.wt_br + (size_t)1024 * 512, 512, 1024, (size_t)512 * 1024, (size_t)3 * 1024 * 512, 0, DEPTH, lds);
    convert_tiles(p.w_lru_o, p.wt_br + (size_t)2 * 1024 * 512, 512, 1024, (size_t)512 * 1024, (size_t)3 * 1024 * 512, 0, DEPTH, lds);
    convert_tiles(p.w_out, p.wt_out, D, D, (size_t)D * D, (size_t)D * D, 0, DEPTH, lds);
    convert_tiles(p.exp_w_gu, (bf16_t*)p.wt_gu, D, 2048, (size_t)D * 2048, (size_t)2048 * D, 1, DEPTH * NE, lds, 1);
    convert_tiles(p.exp_w_down, (bf16_t*)p.wt_down, D, D, (size_t)D * D, (size_t)D * D, 0, DEPTH * NE, lds, 1);
}

__device__ __forceinline__ void mod_phase(const Params& p, float* lds) {
    float* s = lds; float* red = lds + 5 * 1024;
    const int t = TIDX;
    for (int i = t; i < 5 * 1024; i += NTHREADS) { const int r = i >> 10, k = i & 1023; const float v = (r < 4) ? p.c[r * 1024 + k] : p.c_ctx[k]; s[i] = v / (1.0f + expf(-v)); }
    __syncthreads();
    for (int unit = blockIdx.x; unit < 96 * DEPTH; unit += gridDim.x) {
        const int l = unit / 96, n0 = (unit - l * 96) * 64;
        const int nn = t & 63, kg = t >> 6; const float* w = p.mod_w + (size_t)l * 1024 * 6144 + n0 + nn;
        float acc[5] = {0.f, 0.f, 0.f, 0.f, 0.f};
        for (int k = kg * 128; k < kg * 128 + 128; ++k) { const float wv = w[(size_t)k * 6144];
#pragma unroll
            for (int r = 0; r < 5; ++r) acc[r] += s[r * 1024 + k] * wv; }
#pragma unroll
        for (int r = 0; r < 5; ++r) red[(kg * 5 + r) * 64 + nn] = acc[r];
        __syncthreads();
        if (t < 320) { const int r = t >> 6, n2 = t & 63; float a = 0.f;
#pragma unroll
            for (int g = 0; g < 8; ++g) a += red[(g * 5 + r) * 64 + n2];
            p.mod[(size_t)(l * 5 + r) * 6144 + n0 + n2] = a + p.mod_b[l * 6144 + n0 + n2]; }
        __syncthreads();
    }
}
__device__ __forceinline__ void small_phase(const Params& p) {
    for (int i = blockIdx.x * NTHREADS + TIDX; i < 4096 * 32; i += gridDim.x * NTHREADS) {
        if (i < 1024) { float v[4], m = -1e30f;
#pragma unroll
            for (int l = 0; l < 4; ++l) { v[l] = p.hgrn_lb_logits[l * 1024 + i]; m = fmaxf(m, v[l]); }
            float sum = 0.f;
#pragma unroll
            for (int l = 0; l < 4; ++l) { v[l] = expf(v[l] - m); sum += v[l]; }
            float cum = 0.f;
#pragma unroll
            for (int l = 0; l < 4; ++l) { const float sm = v[l] / sum; if (l > 0) cum += sm; p.lb[l * 1024 + i] = cum; } }
        const int t = i >> 5, f = i & 31; const float inv = powf(10000.0f, -(float)(f & 15) / 16.0f); const float pos = (f < 16) ? (float)(t >> 6) : (float)(t & 63);
        const float ang = pos * inv; p.rot[i * 2] = cosf(ang); p.rot[i * 2 + 1] = sinf(ang); }
}
template <int MODE> __device__ __forceinline__ void norm_phase(const Params& p, int l) {
    if (MODE != 0) build_tile_table(p, l - 1);
    const LAS int* tbp = (const LAS int*)((const LAS char*)dyn_lds_base() + TB_OFF) + MAXTILES;
    const int lane = TIDX & 63; const int gw = blockIdx.x * (NTHREADS / 64) + __builtin_amdgcn_readfirstlane(TIDX >> 6), nw = gridDim.x * (NTHREADS / 64);
    int ne[4] = {0, 0, 0, 0}, np[4] = {0, 0, 0, 0}; float nwt[4] = {0.f, 0.f, 0.f, 0.f};
    const bool bymap = (nw == 2048); const int wb = gw >> 9, wj = gw & 511; const int nit = bymap ? (wj < 256 ? 9 : 8) : (MT - gw + nw - 1) / nw;
#define NP_ROW(IT) (bymap ? wb * LT + wj + 512 * (IT) : gw + (IT) * nw)
    if (MODE != 0 && nit > 0) { const int m0_ = NP_ROW(0);
#pragma unroll
        for (int k = 0; k < 4; ++k) { ne[k] = p.tok_e[m0_ * 4 + k]; np[k] = p.tok_pos[m0_ * 4 + k]; nwt[k] = p.tok_w[m0_ * 4 + k]; } }
    float4 gN[4], shN[4], scN[4], g2v[4]; int cur_mr = -1;
#pragma unroll
    for (int j = 0; j < 4; ++j) gN[j] = (MODE != 2) ? *(const float4*)(p.norm1_g + l * D + j * 256 + lane * 4) : *(const float4*)(p.final_g + j * 256 + lane * 4);
    for (int it = 0; it < nit; ++it) { const int m = NP_ROW(it);
        const int b = m / LT, pp = m - b * LT; const bool isctx = pp < LC; const int mr = isctx ? 4 : b;
        float4 xv[4];
        if (mr != cur_mr) { cur_mr = mr;
            if (MODE != 2) { const float* mv = p.mod + (size_t)(l * 5 + mr) * 6144;
#pragma unroll
                for (int j = 0; j < 4; ++j) { const int col = j * 256 + lane * 4; shN[j] = *(const float4*)(mv + col); scN[j] = *(const float4*)(mv + 1024 + col); } }
            if (MODE != 0) { const float* g2 = p.mod + (size_t)((l - 1) * 5 + mr) * 6144 + 5 * 1024;
#pragma unroll
                for (int j = 0; j < 4; ++j) g2v[j] = *(const float4*)(g2 + j * 256 + lane * 4); } }
        if (MODE == 0) { const float* src = isctx ? p.ctx + (size_t)(b * LC + pp) * D : p.x + (size_t)(b * SEQ + pp - LC) * D;
#pragma unroll
            for (int j = 0; j < 4; ++j) xv[j] = *(const float4*)(src + j * 256 + lane * 4);
        } else {
            int slot[4]; float w[4];
#pragma unroll
            for (int k = 0; k < 4; ++k) { slot[k] = tbp[ne[k]] * 256 + np[k]; w[k] = nwt[k]; }
            unsigned yv[4][4];
#pragma unroll
            for (int j = 0; j < 4; ++j) { const int col = j * 256 + lane * 4; { const u32x2 xr = *(const u32x2*)(p.X + (size_t)m * D + col); xv[j] = make_float4(bflo(xr.x), bfhi(xr.x), bflo(xr.y), bfhi(xr.y)); }
#pragma unroll
                for (int k = 0; k < 4; ++k) yv[j][k] = *(const unsigned*)(p.Y + (size_t)slot[k] * D + col); }
            if (it + 1 < nit) { const int mn_ = NP_ROW(it + 1);
#pragma unroll
                for (int k = 0; k < 4; ++k) { ne[k] = p.tok_e[mn_ * 4 + k]; np[k] = p.tok_pos[mn_ * 4 + k]; nwt[k] = p.tok_w[mn_ * 4 + k]; } }
#pragma unroll
            for (int j = 0; j < 4; ++j) { float a0 = 0.f, a1 = 0.f, a2 = 0.f, a3 = 0.f;
#pragma unroll
                for (int k = 0; k < 4; ++k) { const f32x2_t ylo = __builtin_amdgcn_cvt_pk_f32_fp8((int)yv[j][k], false), yhi = __builtin_amdgcn_cvt_pk_f32_fp8((int)yv[j][k], true); a0 += w[k] * ylo[0]; a1 += w[k] * ylo[1]; a2 += w[k] * yhi[0]; a3 += w[k] * yhi[1]; }
                xv[j].x += g2v[j].x * a0; xv[j].y += g2v[j].y * a1; xv[j].z += g2v[j].z * a2; xv[j].w += g2v[j].w * a3; }
        }
        if (MODE != 2) {
#pragma unroll
            for (int j = 0; j < 4; ++j) { u32x2 xw; xw.x = pg8::cvt_pk_bf16(xv[j].x, xv[j].y); xw.y = pg8::cvt_pk_bf16(xv[j].z, xv[j].w); *(u32x2*)(p.X + (size_t)m * D + j * 256 + lane * 4) = xw; } }
        float ss = 0.f;
#pragma unroll
        for (int j = 0; j < 4; ++j) ss += xv[j].x * xv[j].x + xv[j].y * xv[j].y + xv[j].z * xv[j].z + xv[j].w * xv[j].w;
        ss = wave_sum(ss, lane); const float rstd = rsqrtf(ss * (1.0f / D) + 1e-6f);
#ifdef PROBE_PHASE
        const float pr_scale = 1.0f + ((const float*)p.ctrl)[2048];
#else
        const float pr_scale = 1.0f;
#endif
        if (MODE == 2) { if (!isctx) { float* o = p.out + (size_t)(b * SEQ + pp - LC) * D;
#pragma unroll
                for (int j = 0; j < 4; ++j) { const int col = j * 256 + lane * 4; const float4 g = gN[j];
                    *(float4*)(o + col) = make_float4(xv[j].x * rstd * g.x * pr_scale, xv[j].y * rstd * g.y * pr_scale, xv[j].z * rstd * g.z * pr_scale, xv[j].w * rstd * g.w * pr_scale); } }
        } else {
#pragma unroll
            for (int j = 0; j < 4; ++j) { const int col = j * 256 + lane * 4; const float4 g = gN[j], sh = shN[j], sc = scN[j];
                const float h0 = xv[j].x * rstd * g.x * (1.f + sc.x) + sh.x, h1 = xv[j].y * rstd * g.y * (1.f + sc.y) + sh.y, h2 = xv[j].z * rstd * g.z * (1.f + sc.z) + sh.z, h3 = xv[j].w * rstd * g.w * (1.f + sc.w) + sh.w;
                u32x2 w2; w2.x = pg8::cvt_pk_bf16(h0, h1); w2.y = pg8::cvt_pk_bf16(h2, h3); *(u32x2*)(p.H + (size_t)m * D + col) = w2;
                *(unsigned*)(p.H8 + (size_t)m * D + col) = pk_fp8x4(h0, h1, h2, h3); } }
    }
}
#undef NP_ROW
__device__ __forceinline__ void lru_prep_phase(const Params& p, int l, float* ldsf) {
    const int tid = TIDX, lane = tid & 63, wave = __builtin_amdgcn_readfirstlane(tid >> 6), r = lane & 31, h = lane >> 5; const int G8 = (int)gridDim.x >> 3;
    if ((int)blockIdx.x >= G8 * 8) return;
    const int hb = blockIdx.x & 7, rank = blockIdx.x >> 3;
    LAS char* lds = (LAS char*)ldsf; LAS char* tW = lds; LAS char* tH = lds + 36864 + wave * 9216; LAS char* tX = tH + 4480;
#pragma unroll
    for (int i = 0; i < 16; ++i) { const int e = tid + 512 * i, mat = e >> 11, rr = (e & 2047) * 2, dir = mat >> 1; const float* src = (mat & 1) ? p.lru_wx : p.lru_wa;
        const f32x2_t v = *(const f32x2_t*)(src + (size_t)((l * 2 + dir) * 8 + hb) * 4096 + rr);
        *(LAS unsigned*)(tW + mat * 9216 + (rr >> 6) * 144 + (rr & 63) * 2) = pk_bf16(v[0], v[1]); }
    __syncthreads();
    const int cch = hb * 64 + lane;
    const float cb = p.lru_conv_b[l * 512 + cch], cw0 = p.lru_conv_w[(l * 4 + 0) * 512 + cch], cw1 = p.lru_conv_w[(l * 4 + 1) * 512 + cch], cw2 = p.lru_conv_w[(l * 4 + 2) * 512 + cch], cw3 = p.lru_conv_w[(l * 4 + 3) * 512 + cch];
    const int per_wg = (MT / 32 + G8 - 1) / G8;
    for (int q = wave; q < per_wg && rank * per_wg + q < MT / 32; q += 8) { const int t32 = rank * per_wg + q;
        const int m0 = t32 * 32, b = m0 / LT, p0 = m0 - b * LT; const int seg_lo = p0 < LC ? 0 : LC, seg_hi = p0 < LC ? LC : LT;
#pragma unroll
        for (int i = 0; i < 5; ++i) { const int idx = lane + 64 * i; if (idx < 35 * 8) { const int row = idx >> 3, ch = idx & 7, q = p0 - 2 + row; u32x4 v = {0u, 0u, 0u, 0u};
                if (q >= seg_lo && q < seg_hi) v = *(const u32x4*)(p.U + (size_t)(b * LT + q) * INC + C_LX + hb * 64 + ch * 8);
                *(LAS u32x4*)(tH + row * 128 + ch * 16) = v; } }
        asm volatile("s_waitcnt lgkmcnt(0)" ::: "memory");
#pragma unroll
        for (int j = 0; j < 32; ++j) { const LAS bf16_t* col = (const LAS bf16_t*)(tH + j * 128 + lane * 2);
            const float x = cb + bf2f(col[0]) * cw0 + bf2f(col[64]) * cw1 + bf2f(col[128]) * cw2 + bf2f(col[192]) * cw3;
            *(LAS bf16_t*)(tX + j * 144 + lane * 2) = (bf16_t)(pk_bf16(x, 0.f) & 0xffffu); }
        asm volatile("s_waitcnt lgkmcnt(0)" ::: "memory");
        bf16x8_t Af[4];
#pragma unroll
        for (int x = 0; x < 4; ++x) Af[x] = frag_row(tX, 144, r, 16 * x + 4 * h);
#pragma unroll
        for (int dir = 0; dir < 2; ++dir) {
            f32x16_t acc[2][2];
#pragma unroll
            for (int gq = 0; gq < 2; ++gq)
#pragma unroll
                for (int nt = 0; nt < 2; ++nt) {
#pragma unroll
                    for (int i = 0; i < 16; ++i) acc[gq][nt][i] = 0.f;
#pragma unroll
                    for (int x = 0; x < 4; ++x) acc[gq][nt] = MFMA32(Af[x], frag_tr(tW + (dir * 2 + gq) * 9216, 144, 16 * x + 4 * h, nt, lane), acc[gq][nt]); }
#pragma unroll
            for (int nt = 0; nt < 2; ++nt) { const int c = hb * 64 + 32 * nt + r, pi = (l * 2 + dir) * 512 + c; const float ba = p.lru_ba[pi], bx = p.lru_bx[pi], lam = p.lru_lambda[pi];
                const float sp8 = -8.0f * log1pf(expf(-lam));
                float av[16], bv[16];
#pragma unroll
                for (int i = 0; i < 16; ++i) { const int tok = (i & 3) + 8 * (i >> 2) + 4 * h; const float rg = sigmoidf_(acc[0][nt][i] + ba), ig = sigmoidf_(acc[1][nt][i] + bx);
                    const float a = __expf(rg * sp8); av[i] = a; bv[i] = __builtin_amdgcn_sqrtf(fmaxf(fmaf(-a, a, 1.0f), 0.f)) * (ig * bf2f(*(const LAS bf16_t*)(tX + tok * 144 + (32 * nt + r) * 2))); }
                float Pg[4], Hg[4];
#pragma unroll
                for (int g = 0; g < 4; ++g) { float P = 1.f, H = 0.f;
#pragma unroll
                    for (int ee = 0; ee < 4; ++ee) { const int i = 4 * g + (dir == 0 ? ee : 3 - ee); H = av[i] * H + bv[i]; P *= av[i]; av[i] = P; bv[i] = H; }
                    Pg[g] = P; Hg[g] = H; }
                float Ps = 1.f, Hs = 0.f, Pst[4] = {1.f, 1.f, 1.f, 1.f}, Hst[4] = {0.f, 0.f, 0.f, 0.f};
#pragma unroll
                for (int kk = 0; kk < 8; ++kk) { const int k = dir == 0 ? kk : 7 - kk, g = k >> 1, hh = k & 1;
                    const float Po = shx(Pg[g], 32, lane), Ho = shx(Hg[g], 32, lane); const bool mine = hh == h;
                    const float Pk = mine ? Pg[g] : Po, Hk = mine ? Hg[g] : Ho;
                    Pst[g] = mine ? Ps : Pst[g]; Hst[g] = mine ? Hs : Hst[g];
                    Hs = Pk * Hs + Hk; Ps *= Pk; }
                unsigned* out = p.PH + ((size_t)dir * MT + m0) * 512 + c;
#pragma unroll
                for (int i = 0; i < 16; ++i) { const int g = i >> 2, tok = (i & 3) + 8 * g + 4 * h; out[(size_t)tok * 512] = pk_bf16(av[i] * Pst[g], av[i] * Hst[g] + bv[i]); }
                if (h == 0) { const size_t o = ((size_t)dir * (MT / 32) + t32) * 512 + c; p.LP[o] = Ps; p.LH[o] = Hs; }
            }
        }
    }
}
__device__ __forceinline__ void lru_tilescan_task(const Params& p, int task, int lane) {
    const int b = task >> 4, dir = (task >> 3) & 1, c = (task & 7) * 64 + lane;
    const size_t base = ((size_t)dir * (MT / 32) + (size_t)b * 136) * 512 + c;
    float hh = 0.f;
#pragma unroll 17
    for (int i = 0; i < 136; ++i) { const int tl = dir == 0 ? i : (i < 8 ? 7 - i : 143 - i); const float P = p.LP[base + (size_t)tl * 512], H = p.LH[base + (size_t)tl * 512];
        p.LS[base + (size_t)tl * 512] = hh; hh = P * hh + H; }
}

__device__ __forceinline__ void finish_phase(const Params& p, int l, int last) {
    const int lane = TIDX & 63; const int gw = blockIdx.x * (NTHREADS / 64) + __builtin_amdgcn_readfirstlane(TIDX >> 6), nw = gridDim.x * (NTHREADS / 64);
    const int c0 = lane * 8;
    float gr_[8], gh_[8];
#pragma unroll
    for (int i = 0; i < 8; ++i) { gr_[i] = p.ret_gn_g[l * 512 + c0 + i]; gh_[i] = p.hgrn_gn_g[l * 512 + c0 + i]; }
    for (int m = gw; m < MT; m += nw) {
        if (last && (m % LT) < LC) continue;
        const bf16_t* u = p.U + (size_t)m * INC + c0; const int tile = m >> 5;
        const bf16_t* ra = p.Oret + (size_t)m * 512 + c0; const bf16_t* rb = ra + (size_t)MT * 512; const bf16_t* ha = p.Ohg + (size_t)m * 512 + c0; const bf16_t* hb2 = ha + (size_t)MT * 512;
        const u32x4 rav = *(const u32x4*)ra, rbv = *(const u32x4*)rb, hav = *(const u32x4*)ha, hbv = *(const u32x4*)hb2;
        const unsigned* ph0 = p.PH + (size_t)m * 512 + c0; const unsigned* ph1 = ph0 + (size_t)MT * 512;
        const u32x4 pf0 = *(const u32x4*)ph0, pf1 = *(const u32x4*)(ph0 + 4), pb0 = *(const u32x4*)ph1, pb1 = *(const u32x4*)(ph1 + 4);
        const float* st0 = p.LS + (size_t)tile * 512 + c0; const float* st1 = st0 + (size_t)(MT / 32) * 512;
        const float4 sf0 = *(const float4*)st0, sf1 = *(const float4*)(st0 + 4), sb0 = *(const float4*)st1, sb1 = *(const float4*)(st1 + 4);
        const u32x4 grg = *(const u32x4*)(u + C_RG), ghg = *(const u32x4*)(u + C_HGT), glg = *(const u32x4*)(u + C_LGT);
        { float o[8] = {bflo(rav[0]) + bflo(rbv[0]), bfhi(rav[0]) + bfhi(rbv[0]), bflo(rav[1]) + bflo(rbv[1]), bfhi(rav[1]) + bfhi(rbv[1]), bflo(rav[2]) + bflo(rbv[2]), bfhi(rav[2]) + bfhi(rbv[2]), bflo(rav[3]) + bflo(rbv[3]), bfhi(rav[3]) + bfhi(rbv[3])};
          float ss = 0.f;
#pragma unroll
          for (int i = 0; i < 8; ++i) ss += o[i] * o[i];
          ss += shx(ss, 1, lane); ss += shx(ss, 2, lane); ss += shx(ss, 4, lane);
          const float rstd = rsqrtf(ss * (1.0f / 64.0f) + 1e-6f); u32x4 w;
#pragma unroll
          for (int i = 0; i < 4; ++i) { const float g0 = bflo(grg[i]), g1 = bfhi(grg[i]); w[i] = pg8::cvt_pk_bf16(o[2 * i] * rstd * gr_[2 * i] * (g0 * sigmoidf_(g0)), o[2 * i + 1] * rstd * gr_[2 * i + 1] * (g1 * sigmoidf_(g1))); }
          *(u32x4*)(p.Aall + (size_t)m * 512 + c0) = w; }
        { float o[8] = {bflo(hav[0]) + bflo(hbv[0]), bfhi(hav[0]) + bfhi(hbv[0]), bflo(hav[1]) + bflo(hbv[1]), bfhi(hav[1]) + bfhi(hbv[1]), bflo(hav[2]) + bflo(hbv[2]), bfhi(hav[2]) + bfhi(hbv[2]), bflo(hav[3]) + bflo(hbv[3]), bfhi(hav[3]) + bfhi(hbv[3])};
          float ss = 0.f;
#pragma unroll
          for (int i = 0; i < 8; ++i) ss += o[i] * o[i];
          ss += shx(ss, 1, lane); ss += shx(ss, 2, lane); ss += shx(ss, 4, lane); ss += shx(ss, 8, lane);
          const float rstd = rsqrtf(ss * (1.0f / 128.0f) + 1e-6f); u32x4 w;
#pragma unroll
          for (int i = 0; i < 4; ++i) w[i] = pg8::cvt_pk_bf16(o[2 * i] * rstd * gh_[2 * i] * sigmoidf_(bflo(ghg[i])), o[2 * i + 1] * rstd * gh_[2 * i + 1] * sigmoidf_(bfhi(ghg[i])));
          *(u32x4*)(p.Aall + ((size_t)MT + m) * 512 + c0) = w; }
        { const float sf[8] = {sf0.x, sf0.y, sf0.z, sf0.w, sf1.x, sf1.y, sf1.z, sf1.w}, sb[8] = {sb0.x, sb0.y, sb0.z, sb0.w, sb1.x, sb1.y, sb1.z, sb1.w};
          const unsigned pf[8] = {pf0[0], pf0[1], pf0[2], pf0[3], pf1[0], pf1[1], pf1[2], pf1[3]}, pb[8] = {pb0[0], pb0[1], pb0[2], pb0[3], pb1[0], pb1[1], pb1[2], pb1[3]};
          float o[8];
#pragma unroll
          for (int i = 0; i < 8; ++i) o[i] = (bflo(pf[i]) * sf[i] + bfhi(pf[i])) + (bflo(pb[i]) * sb[i] + bfhi(pb[i]));
          u32x4 w;
#pragma unroll
          for (int i = 0; i < 4; ++i) { float rr[2];
#pragma unroll
              for (int k = 0; k < 2; ++k) { const float x = k ? bfhi(glg[i]) : bflo(glg[i]); const float t2 = __expf(2.0f * 0.7978845608f * (x + 0.044715f * x * x * x));
                  rr[k] = o[2 * i + k] * (0.5f * x * (2.0f - 2.0f * __builtin_amdgcn_rcpf(t2 + 1.0f))); }
              w[i] = pg8::cvt_pk_bf16(rr[0], rr[1]); }
          *(u32x4*)(p.Aall + ((size_t)2 * MT + m) * 512 + c0) = w; }
    }
}

__device__ __forceinline__ void router_prep_phase(const Params& p) {
    const int tid = TIDX, lane = tid & 63;
    for (int i = blockIdx.x * NTHREADS + tid; i < DEPTH * 5 * 1024 * 8; i += gridDim.x * NTHREADS) { const int q = i & 7, k = (i >> 3) & 1023, lm = i >> 13, l = lm / 5;
        const float sc = p.norm2_g[l * D + k] * (1.0f + p.mod[(size_t)lm * 6144 + 4 * 1024 + k]); const float4 w = *(const float4*)(p.router_w + ((size_t)l * 1024 + k) * 32 + q * 4);
        *(float4*)(p.RWp + ((size_t)lm * 1024 + k) * 32 + q * 4) = make_float4(w.x * sc, w.y * sc, w.z * sc, w.w * sc); }
    const int gw = blockIdx.x * (NTHREADS / 64) + __builtin_amdgcn_readfirstlane(tid >> 6), nw = gridDim.x * (NTHREADS / 64);
    for (int t = gw; t < DEPTH * 5 * 32; t += nw) { const int e = t & 31, lm = t >> 5, l = lm / 5; float a = 0.f;
#pragma unroll
        for (int j = 0; j < 16; ++j) { const int k = j * 64 + lane; a += p.mod[(size_t)lm * 6144 + 3 * 1024 + k] * p.router_w[((size_t)l * 1024 + k) * 32 + e]; }
        a = wave_sum(a, lane); if (lane == 0) p.RC[lm * 32 + e] = a + p.router_b[l * 32 + e]; }
}
__device__ __forceinline__ int route_group_row0(int g, int last) { return last ? (g >> 7) * LT + LC + (g & 127) * 32 : g * 32; }
__device__ __forceinline__ void route_phase(const Params& p, int l, float* ldsf, int last) {
    const int tid = TIDX, lane = tid & 63, wave = __builtin_amdgcn_readfirstlane(tid >> 6); const int G = (int)gridDim.x;
    LAS float* tL = (LAS float*)ldsf; LAS float* tS = tL + 8448; LAS int* rec = (LAS int*)(tL + 8704);
    const int ti = lane & 31, kk = lane >> 5, gi = wave >> 1, kh = wave & 1;
    const int NG = last ? NB * SEQ / 32 : MT / 32;
    const int ngrp = ((int)blockIdx.x + 3 * G < NG) ? 4 : ((int)blockIdx.x + 2 * G < NG) ? 3 : ((int)blockIdx.x + G < NG) ? 2 : ((int)blockIdx.x < NG ? 1 : 0);
    if (gi < ngrp) {
        const int m0 = route_group_row0((int)blockIdx.x + gi * G, last), b = m0 / LT, pp0 = m0 - b * LT, mr = pp0 < LC ? 4 : b;
        const bf16_t* xrow = p.X + (size_t)(m0 + ti) * D + 4 * kk + 512 * kh;
        const float* rw = p.RWp + ((size_t)(l * 5 + mr) * 1024 + 512 * kh + 4 * kk) * 32 + ti;
        f32x16_t acc;
#pragma unroll
        for (int i = 0; i < 16; ++i) acc[i] = 0.f;
        float ss = 0.f;
#define RT_LOAD(XB, WB, DB, s0) do { if ((s0) < 64) { _Pragma("unroll") for (int q = 0; q < 4; ++q) { XB[q] = *(const u32x2*)(xrow + 8 * ((s0) + q)); \
            const float* rp = rw + (size_t)((s0) + q) * 256; WB[q][0] = rp[0]; WB[q][1] = rp[32]; WB[q][2] = rp[64]; WB[q][3] = rp[96]; } } } while (0)
#define RT_MMA(XB, WB, DB, s0) do { if ((s0) < 64) { _Pragma("unroll") for (int q = 0; q < 4; ++q) { const float x0_ = bflo(XB[q].x), x1_ = bfhi(XB[q].x), x2_ = bflo(XB[q].y), x3_ = bfhi(XB[q].y); \
            ss += x0_ * x0_ + x1_ * x1_ + x2_ * x2_ + x3_ * x3_; \
            acc = __builtin_amdgcn_mfma_f32_32x32x2f32(x0_, WB[q][0], acc, 0, 0, 0); acc = __builtin_amdgcn_mfma_f32_32x32x2f32(x1_, WB[q][1], acc, 0, 0, 0); \
            acc = __builtin_amdgcn_mfma_f32_32x32x2f32(x2_, WB[q][2], acc, 0, 0, 0); acc = __builtin_amdgcn_mfma_f32_32x32x2f32(x3_, WB[q][3], acc, 0, 0, 0); } } } while (0)
        u32x2 xA[4], xB[4], xC[4]; float wA[4][4], wB[4][4], wC[4][4];
        RT_LOAD(xA, wA, dA, 0); RT_LOAD(xB, wB, dB, 4);
        for (int s = 0; s < 64; s += 12) {
            RT_LOAD(xC, wC, dC, s + 8);  asm volatile("" ::: "memory"); RT_MMA(xA, wA, dA, s);
            RT_LOAD(xA, wA, dA, s + 12); asm volatile("" ::: "memory"); RT_MMA(xB, wB, dB, s + 4);
            RT_LOAD(xB, wB, dB, s + 16); asm volatile("" ::: "memory"); RT_MMA(xC, wC, dC, s + 8);
        }
#undef RT_LOAD
#undef RT_MMA
        ss += shx(ss, 32, lane);
        LAS float* t = tL + (gi * 2 + kh) * (32 * 33);
#pragma unroll
        for (int i = 0; i < 16; ++i) t[((i & 3) + 8 * (i >> 2) + 4 * kk) * 33 + ti] = acc[i];
        if (lane < 32) tS[(gi * 2 + kh) * 32 + ti] = ss;
    }
    __syncthreads();
    if (gi < ngrp && kh == 0) {
        const int m0 = route_group_row0((int)blockIdx.x + gi * G, last), b = m0 / LT, pp0 = m0 - b * LT, mr = pp0 < LC ? 4 : b;
        const float rstd = rsqrtf((tS[(gi * 2) * 32 + ti] + tS[(gi * 2 + 1) * 32 + ti]) * (1.0f / D) + 1e-6f);
        const LAS float* t0 = tL + (gi * 2) * (32 * 33) + ti * 33; const LAS float* t1 = t0 + 32 * 33;
        int e4[4] = {0, 0, 0, 0}; float w4[4] = {0.f, 0.f, 0.f, 0.f}; int pos4[4] = {0, 0, 0, 0};
        float lg[32];
#pragma unroll
        for (int e = 0; e < 32; ++e) lg[e] = (t0[e] + t1[e]) * rstd + p.RC[(l * 5 + mr) * 32 + e];
        float val[4];
#pragma unroll
        for (int k = 0; k < 4; ++k) { float best = -3.0e38f; int bi = 0;
#pragma unroll
            for (int e = 0; e < 32; ++e) { const bool better = lg[e] > best; best = better ? lg[e] : best; bi = better ? e : bi; }
            e4[k] = bi; val[k] = best;
#pragma unroll
            for (int e = 0; e < 32; ++e) lg[e] = (e == bi) ? -3.0e38f : lg[e]; }
        const float x1 = __expf(val[1] - val[0]), x2 = __expf(val[2] - val[0]), x3 = __expf(val[3] - val[0]); const float inv = 1.0f / (1.0f + x1 + x2 + x3);
        w4[0] = inv; w4[1] = x1 * inv; w4[2] = x2 * inv; w4[3] = x3 * inv;
        int rank4[4] = {0, 0, 0, 0}; int mycnt = 0;
#pragma unroll 4
        for (int e = 0; e < 32; ++e) { const bool hit = lane < 32 && (e4[0] == e || e4[1] == e || e4[2] == e || e4[3] == e);
            const unsigned long long mask = __ballot(hit); const int rk = __popcll(mask & ((1ull << lane) - 1ull));
#pragma unroll
            for (int k = 0; k < 4; ++k) rank4[k] = (e4[k] == e) ? rk : rank4[k];
            mycnt = (lane == e) ? __popcll(mask) : mycnt; }
        int base = 0;
        if (lane < 32 && mycnt > 0) base = (int)__hip_atomic_fetch_add(&p.ctrl[l * 64 + lane], (unsigned)mycnt, __ATOMIC_RELAXED, __HIP_MEMORY_SCOPE_AGENT);
#pragma unroll
        for (int k = 0; k < 4; ++k) pos4[k] = __builtin_amdgcn_ds_bpermute(e4[k] << 2, base) + rank4[k];
        if (lane < 32) { LAS int* rr = rec + (gi * 32 + ti) * 12;
#pragma unroll
            for (int k = 0; k < 4; ++k) { p.tok_e[(m0 + ti) * 4 + k] = e4[k]; p.tok_pos[(m0 + ti) * 4 + k] = pos4[k]; p.tok_w[(m0 + ti) * 4 + k] = w4[k]; rr[k] = e4[k]; rr[4 + k] = pos4[k]; }
            rr[8] = __float_as_int(rstd); }
    }
    __syncthreads();
    u32x4 xn[2];
    if (wave < ngrp * 32) { const int m = route_group_row0((int)blockIdx.x + (wave >> 5) * G, last) + (wave & 31);
#pragma unroll
        for (int j = 0; j < 2; ++j) { const int col = j * 512 + lane * 8; xn[j] = *(const u32x4*)(p.X + (size_t)m * D + col); } }
    for (int rw_ = wave; rw_ < ngrp * 32; rw_ += 8) {
        const int g2 = rw_ >> 5, tk = rw_ & 31; const int m = route_group_row0((int)blockIdx.x + g2 * G, last) + tk, b = m / LT, pp = m - b * LT, mr = pp < LC ? 4 : b;
        const LAS int* rr = rec + (g2 * 32 + tk) * 12; const float rs = __int_as_float(rr[8]);
        size_t rowoff[4];
#pragma unroll
        for (int k = 0; k < 4; ++k) rowoff[k] = ((size_t)rr[k] * (CAPT * 256) + rr[4 + k]) * D;
        const float* mv = p.mod + (size_t)(l * 5 + mr) * 6144;
        u32x4 xv[2]; float4 gv[2][2], scv[2][2], shv[2][2];
#pragma unroll
        for (int j = 0; j < 2; ++j) { const int col = j * 512 + lane * 8; xv[j] = xn[j];
#pragma unroll
            for (int q = 0; q < 2; ++q) { gv[j][q] = *(const float4*)(p.norm2_g + l * D + col + 4 * q); scv[j][q] = *(const float4*)(mv + 4 * 1024 + col + 4 * q); shv[j][q] = *(const float4*)(mv + 3 * 1024 + col + 4 * q); } }
        if (rw_ + 8 < ngrp * 32) { const int mn = route_group_row0((int)blockIdx.x + ((rw_ + 8) >> 5) * G, last) + ((rw_ + 8) & 31);
#pragma unroll
            for (int j = 0; j < 2; ++j) { const int col = j * 512 + lane * 8; xn[j] = *(const u32x4*)(p.X + (size_t)mn * D + col); } }
#pragma unroll
        for (int j = 0; j < 2; ++j) { const int col = j * 512 + lane * 8; u32x2 w4;
#pragma unroll
            for (int q = 0; q < 2; ++q) {
                const unsigned x0 = xv[j][2 * q], x1 = xv[j][2 * q + 1]; const float4 x = make_float4(bflo(x0), bfhi(x0), bflo(x1), bfhi(x1));
                w4[q] = pk_fp8x4(x.x * rs * gv[j][q].x * (1.f + scv[j][q].x) + shv[j][q].x, x.y * rs * gv[j][q].y * (1.f + scv[j][q].y) + shv[j][q].y,
                                 x.z * rs * gv[j][q].z * (1.f + scv[j][q].z) + shv[j][q].z, x.w * rs * gv[j][q].w * (1.f + scv[j][q].w) + shv[j][q].w); }
#pragma unroll
            for (int k = 0; k < 4; ++k) *(u32x2*)(p.Xg + rowoff[k] + col) = w4; }
    }
}

struct EpiBranch {
    static constexpr bool PERM = true, AFTER_DRAIN = false;
    bf16_t* R;
    __device__ __forceinline__ void operator()(const f32x4 (&acc)[2][2][4][2], const Unit& u, int wr, int wc, int fr, int fq) const {
        const int br = u.pn >> 2, pnl = u.pn & 3, pmr = u.pm - br * 68;
        bf16_t* base = R + (size_t)br * MT * D + (size_t)(pmr * 256 + wr * 64 + fr) * D + pnl * 256 + wc * 32 + 8 * fq;
#pragma unroll
        for (int ai = 0; ai < 2; ++ai)
#pragma unroll
            for (int m = 0; m < 4; ++m) { bf16_t* rowp = base + (size_t)(ai * 128 + m * 16) * D;
#pragma unroll
                for (int bj = 0; bj < 2; ++bj) { const f32x4 v0 = acc[ai][bj][m][0], v1 = acc[ai][bj][m][1];
                    u32x4 w; w.x = pg8::cvt_pk_bf16(v0[0], v0[1]); w.y = pg8::cvt_pk_bf16(v0[2], v0[3]); w.z = pg8::cvt_pk_bf16(v1[0], v1[1]); w.w = pg8::cvt_pk_bf16(v1[2], v1[3]);
                    *(u32x4*)(rowp + bj * 128) = w; } }
    }
};
__device__ __forceinline__ int latent_row_tile(int k) { return (k >> 4) * 17 + 1 + (k & 15); }
struct SchedMerge { int G, c, last;
    __device__ bool next(int i, Unit& u) const { const int nt = last ? 256 : 272; const int L = i * G + c; if (L >= 3 * nt) return false; const int br = L / nt, tile = L - br * nt;
        u.pm = br * 68 + (last ? latent_row_tile(tile >> 2) : (tile >> 2)); u.pn = br * 4 + (tile & 3); u.po = 0; return true; }
    __device__ __forceinline__ void a_ready(const Unit&) const {}
    __device__ __forceinline__ void done(const Unit&) const {}
};
__device__ __forceinline__ void merge_combine_phase(const Params& p, int last) {
    const int tid = TIDX, lane = tid & 63; const int gw = blockIdx.x * (NTHREADS / 64) + __builtin_amdgcn_readfirstlane(tid >> 6), nw = gridDim.x * (NTHREADS / 64);
    for (int m = gw; m < MT; m += nw) {
        if (last && (m % LT) < LC) continue;
        u32x4 rv[2][3], gv[2][3];
#pragma unroll
        for (int hf = 0; hf < 2; ++hf)
#pragma unroll
            for (int br = 0; br < 3; ++br) { const int col = hf * 512 + lane * 8; rv[hf][br] = *(const u32x4*)(p.R + ((size_t)br * MT + m) * D + col); gv[hf][br] = *(const u32x4*)(p.U + (size_t)m * INC + C_GR + br * 1024 + col); }
#pragma unroll
        for (int hf = 0; hf < 2; ++hf) { const int col = hf * 512 + lane * 8; float o[8];
#pragma unroll
            for (int i = 0; i < 8; ++i) o[i] = 0.f;
#pragma unroll
            for (int br = 0; br < 3; ++br)
#pragma unroll
                for (int i = 0; i < 4; ++i) { o[2 * i] += sigmoidf_(bflo(gv[hf][br][i])) * bflo(rv[hf][br][i]); o[2 * i + 1] += sigmoidf_(bfhi(gv[hf][br][i])) * bfhi(rv[hf][br][i]); }
            u32x4 w; w.x = pg8::cvt_pk_bf16(o[0], o[1]); w.y = pg8::cvt_pk_bf16(o[2], o[3]); w.z = pg8::cvt_pk_bf16(o[4], o[5]); w.w = pg8::cvt_pk_bf16(o[6], o[7]);
            *(u32x4*)(p.Mg + (size_t)m * D + col) = w; }
    }
}
struct SchedOut { int nN, nwg, G, c, last;
    __device__ void init(int M, int N, int G_, int c_, int last_) { nN = N / 256; nwg = (M / 256) * nN; G = G_; c = c_; last = last_; }
    __device__ bool next(int i, Unit& u) const {
        const int L = i * G + c; if (L >= (last ? 256 : nwg)) return false;
        const int nM = nwg / nN; int wgid = L; { const int q = nwg / 8, r = nwg % 8, xcd = wgid % 8, off = wgid / 8; wgid = (xcd < r ? xcd * (q + 1) : r * (q + 1) + (xcd - r) * q) + off; }
        const int nig = 8 * nN, gid = wgid / nig, fm = gid * 8, gsz = (nM - fm) < 8 ? (nM - fm) : 8;
        const int pm0 = fm + ((wgid % nig) % gsz), pn0 = (wgid % nig) / gsz;
        u.pm = last ? latent_row_tile(L >> 2) : pm0; u.pn = last ? (L & 3) : pn0; u.po = 0; return true; }
    __device__ __forceinline__ void a_ready(const Unit&) const {}
    __device__ __forceinline__ void done(const Unit&) const {}
};
struct EpiOut {
    static constexpr bool PERM = true, AFTER_DRAIN = false;
    bf16_t* X; const float* mod_l;
    __device__ __forceinline__ void operator()(const f32x4 (&acc)[2][2][4][2], const Unit& u, int wr, int wc, int fr, int fq) const {
        const int mr = (u.pm % 17 == 0) ? 4 : u.pm / 17; const float* g1 = mod_l + mr * 6144 + 2 * 1024;
        const int row0 = u.pm * 256 + wr * 64 + fr, col0 = u.pn * 256 + wc * 32 + 8 * fq;
        bf16_t* base = X + (size_t)row0 * D + col0;
        u32x4 xo[2][4][2];
#pragma unroll
        for (int ai = 0; ai < 2; ++ai)
#pragma unroll
            for (int m = 0; m < 4; ++m)
#pragma unroll
                for (int bj = 0; bj < 2; ++bj) xo[ai][m][bj] = *(const u32x4*)(base + (size_t)(ai * 128 + m * 16) * D + bj * 128);
        f32x4 gv[2][2];
#pragma unroll
        for (int bj = 0; bj < 2; ++bj)
#pragma unroll
            for (int n = 0; n < 2; ++n) gv[bj][n] = *(const f32x4*)(g1 + col0 + bj * 128 + 4 * n);
#pragma unroll
        for (int ai = 0; ai < 2; ++ai)
#pragma unroll
            for (int m = 0; m < 4; ++m) { bf16_t* rowp = base + (size_t)(ai * 128 + m * 16) * D;
#pragma unroll
                for (int bj = 0; bj < 2; ++bj) { const f32x4 v0 = acc[ai][bj][m][0] * gv[bj][0], v1 = acc[ai][bj][m][1] * gv[bj][1]; const u32x4 o = xo[ai][m][bj];
                    u32x4 w; w.x = pg8::cvt_pk_bf16(bflo(o[0]) + v0[0], bfhi(o[0]) + v0[1]); w.y = pg8::cvt_pk_bf16(bflo(o[1]) + v0[2], bfhi(o[1]) + v0[3]);
                    w.z = pg8::cvt_pk_bf16(bflo(o[2]) + v1[0], bfhi(o[2]) + v1[1]); w.w = pg8::cvt_pk_bf16(bflo(o[3]) + v1[2], bfhi(o[3]) + v1[3]);
                    *(u32x4*)(rowp + bj * 128) = w; } }
    }
};
struct SchedMoE { int nN, G, c, sparseA;
    __device__ bool next(int i, Unit& u) const { const LAS int* te = (const LAS int*)((const LAS char*)dyn_lds_base() + TB_OFF); const LAS int* tb = te + MAXTILES;
        if ((G & 63) == 0 && nN == 8) { const int x = c & 7, r = c >> 3, tile = i * (G >> 3) + 8 * (r >> 3) + x, j = r & 7; if (tile >= tb[NE]) return false; const int e = te[tile];
            u.po = tile; u.pm = sparseA ? e * CAPT + (tile - tb[e]) : tile; u.pn = e * nN + j; return true; }
        const int L = i * G + c; if (L >= tb[NE] * nN) return false; const int tile = L / nN, j = L - tile * nN, e = te[tile];
        u.po = tile; u.pm = sparseA ? e * CAPT + (tile - tb[e]) : tile; u.pn = e * nN + j; return true; }
    __device__ __forceinline__ void a_ready(const Unit&) const {}
    __device__ __forceinline__ void done(const Unit&) const {}
};
struct EpiGU {
    static constexpr bool PERM = true, AFTER_DRAIN = false;
    unsigned char* Act; const float* bgu;
    __device__ __forceinline__ void operator()(const f32x4 (&acc)[2][2][4][2], const Unit& u, int wr, int wc, int fr, int fq) const {
        const int e = u.pn >> 3, pnl = u.pn & 7; const int row0 = u.po * 256 + wr * 64 + fr, c8 = pnl * 128 + wc * 32 + 8 * fq;
        const float* bg = bgu + e * 2048 + c8; const f32x4 bg0 = *(const f32x4*)bg, bg1 = *(const f32x4*)(bg + 4), bu0 = *(const f32x4*)(bg + 1024), bu1 = *(const f32x4*)(bg + 1028);
#pragma unroll
        for (int ai = 0; ai < 2; ++ai)
#pragma unroll
            for (int m = 0; m < 4; ++m) { const float is_ = 1.0f / W8_SCALE; const f32x4 g0 = acc[ai][0][m][0] * is_ + bg0, g1 = acc[ai][0][m][1] * is_ + bg1, u0 = acc[ai][1][m][0] * is_ + bu0, u1 = acc[ai][1][m][1] * is_ + bu1; float r[8];
#pragma unroll
                for (int j = 0; j < 4; ++j) { const float ga = fminf(g0[j], 7.0f), ua = fminf(fmaxf(u0[j], -7.0f), 7.0f); r[j] = (ua + 1.0f) * (ga * sigmoidf_(1.702f * ga));
                    const float gb = fminf(g1[j], 7.0f), ub = fminf(fmaxf(u1[j], -7.0f), 7.0f); r[4 + j] = (ub + 1.0f) * (gb * sigmoidf_(1.702f * gb)); }
                u32x2 w; w.x = pk_fp8x4(r[0], r[1], r[2], r[3]); w.y = pk_fp8x4(r[4], r[5], r[6], r[7]);
                *(u32x2*)(Act + (size_t)(row0 + ai * 128 + m * 16) * D + c8) = w; }
    }
};
struct EpiDown {
    static constexpr bool PERM = true, AFTER_DRAIN = false;
    unsigned char* Y; const float* bd;
    __device__ __forceinline__ void operator()(const f32x4 (&acc)[2][2][4][2], const Unit& u, int wr, int wc, int fr, int fq) const {
        const int e = u.pn >> 2, pnl = u.pn & 3; const int row0 = u.po * 256 + wr * 64 + fr, col0 = pnl * 256 + wc * 32 + 8 * fq;
        f32x4 bv[2][2];
#pragma unroll
        for (int bj = 0; bj < 2; ++bj)
#pragma unroll
            for (int n = 0; n < 2; ++n) bv[bj][n] = *(const f32x4*)(bd + e * 1024 + col0 + bj * 128 + 4 * n);
#pragma unroll
        for (int ai = 0; ai < 2; ++ai)
#pragma unroll
            for (int m = 0; m < 4; ++m) { unsigned char* rowp = Y + (size_t)(row0 + ai * 128 + m * 16) * D + col0;
#pragma unroll
                for (int bj = 0; bj < 2; ++bj) { const float is_ = 1.0f / W8_SCALE; f32x4 v0 = acc[ai][bj][m][0] * is_ + bv[bj][0], v1 = acc[ai][bj][m][1] * is_ + bv[bj][1];
#pragma unroll
                    for (int j = 0; j < 4; ++j) { v0[j] = fminf(fmaxf(v0[j], -448.f), 448.f); v1[j] = fminf(fmaxf(v1[j], -448.f), 448.f); }
                    u32x2 w; int t0 = __builtin_amdgcn_cvt_pk_fp8_f32(v0[0], v0[1], 0, false); t0 = __builtin_amdgcn_cvt_pk_fp8_f32(v0[2], v0[3], t0, true);
                    int t1 = __builtin_amdgcn_cvt_pk_fp8_f32(v1[0], v1[1], 0, false); t1 = __builtin_amdgcn_cvt_pk_fp8_f32(v1[2], v1[3], t1, true);
                    w.x = (unsigned)t0; w.y = (unsigned)t1; *(u32x2*)(rowp + bj * 128) = w; } }
    }
};

constexpr int NSEG = 9;
__device__ __forceinline__ int seg_first(int dir, int s) { return dir == 0 ? (s == 0 ? 0 : 8 + 16 * (s - 1)) : (s == 0 ? 7 : 135 - 16 * (s - 1)); }
__device__ __forceinline__ int seg_count(int s) { return s == 0 ? 8 : 16; }

template <int DKT, int NVT, bool VEC, bool FULL>
__device__ __forceinline__ void wave_seg(const bf16_t* __restrict__ Qg, const bf16_t* __restrict__ Kg, const bf16_t* __restrict__ Vg, int vs, bf16_t* __restrict__ Og,
                                         const float* __restrict__ alpha, float gsc, int b, int cs0, int dcs, int nst, int dir, int strict,
                                         f32x16_t (&S)[DKT][NVT], LAS char* lds, int lane) {
    constexpr int KP = DKT * 64 + 16, VP = NVT * 64 + 16, KC = DKT * 4, VC = NVT * 4;
    constexpr int KRI = 64 / KC, VRI = 64 / VC;
    const int r = lane & 31, h = lane >> 5;
    LAS char* tK = lds; LAS char* tV = lds + 32 * KP; LAS char* tA = tV + 32 * VP; LAS char* tG = tA + DKT * 128;
    u32x4 nK[2 * DKT], nV[2 * NVT]; u32x2 nQ[2 * DKT][2]; f32x4 nA = {1.f, 1.f, 1.f, 1.f};
    const unsigned koff = (unsigned)((lane / KC) * 1024 + (lane % KC) * 16), voff = (unsigned)((lane / VC) * (vs * 2) + (lane % VC) * 16), qoff = (unsigned)(r * 1024 + h * 8);
    const unsigned ooff = (unsigned)(h * 4 * 1024 + r * 2), ldk = (unsigned)((lane / KC) * KP + (lane % KC) * 16), ldv = (unsigned)((lane / VC) * VP + (lane % VC) * 16);
    {   const size_t m0 = (size_t)b * LT + cs0 * 32;
        const GAS char* kb = uni_ptr(Kg + m0 * 512); const GAS char* vb = uni_ptr(Vg + m0 * vs);
#pragma unroll
        for (int i = 0; i < 2 * DKT; ++i) nK[i] = *(const GAS u32x4*)(kb + koff + i * (KRI * 1024));
#pragma unroll
        for (int i = 0; i < 2 * NVT; ++i) nV[i] = *(const GAS u32x4*)(vb + voff + (size_t)i * VRI * (vs * 2));
        if (FULL) { const GAS char* qb = uni_ptr(Qg + m0 * 512);
#pragma unroll
            for (int x = 0; x < 2 * DKT; ++x) { nQ[x][0] = *(const GAS u32x2*)(qb + qoff + 32 * x); nQ[x][1] = *(const GAS u32x2*)(qb + qoff + 32 * x + 16); } }
        if (VEC) nA = *(const GAS f32x4*)(uni_ptr(alpha + (size_t)cs0 * 512) + (unsigned)((lane & (DKT * 8 - 1)) * 16)); }
    f32x16_t Oprev[NVT]; GAS char* ob_prev = nullptr;
    for (int si = 0; si < nst; ++si) {
        const int cs = cs0 + si * dcs; const size_t m0 = (size_t)b * LT + cs * 32;
#pragma unroll
        for (int i = 0; i < 2 * DKT; ++i) *(LAS u32x4*)(tK + ldk + i * (KRI * KP)) = nK[i];
#pragma unroll
        for (int i = 0; i < 2 * NVT; ++i) *(LAS u32x4*)(tV + ldv + i * (VRI * VP)) = nV[i];
        if (VEC) { *(LAS f32x4*)(tA + (lane & (DKT * 8 - 1)) * 16) = nA;
            if (!FULL) { LAS f32x4* gp = (LAS f32x4*)(tG + (lane & (DKT * 8 - 1)) * 16); const f32x4 gprev = si == 0 ? (f32x4){1.f, 1.f, 1.f, 1.f} : *gp; asm volatile("s_waitcnt lgkmcnt(0)" ::: "memory"); *gp = gprev * nA; } }
        if (FULL && si > 0) {
#pragma unroll
            for (int n = 0; n < NVT; ++n)
#pragma unroll
                for (int i = 0; i < 16; ++i) *(GAS bf16_t*)(ob_prev + ooff + ((i & 3) + 8 * (i >> 2)) * 1024 + 64 * n) = (bf16_t)(pk_bf16(Oprev[n][i], 0.f) & 0xffffu); }
        bf16x8_t Qf[2 * DKT];
        if (FULL) {
#pragma unroll
            for (int x = 0; x < 2 * DKT; ++x) { u32x4 w; w[0] = nQ[x][0][0]; w[1] = nQ[x][0][1]; w[2] = nQ[x][1][0]; w[3] = nQ[x][1][1]; Qf[x] = __builtin_bit_cast(bf16x8_t, w); } }
        const size_t m1 = (size_t)b * LT + (cs + dcs) * 32;
        if (si + 1 < nst) { const GAS char* kb = uni_ptr(Kg + m1 * 512); const GAS char* vb = uni_ptr(Vg + m1 * vs);
#pragma unroll
            for (int i = 0; i < 2 * DKT; ++i) nK[i] = *(const GAS u32x4*)(kb + koff + i * (KRI * 1024));
#pragma unroll
            for (int i = 0; i < 2 * NVT; ++i) nV[i] = *(const GAS u32x4*)(vb + voff + (size_t)i * VRI * (vs * 2));
            if (VEC) nA = *(const GAS f32x4*)(uni_ptr(alpha + (size_t)(cs + dcs) * 512) + (unsigned)((lane & (DKT * 8 - 1)) * 16));
        }
        asm volatile("s_waitcnt lgkmcnt(0)" ::: "memory");
        if (FULL) {
            f32x16_t X, X2; bf16x8_t Kf[2 * DKT];
#pragma unroll
            for (int x = 0; x < 2 * DKT; ++x) Kf[x] = frag_row(tK, KP, r, 16 * x + 4 * h);
#pragma unroll
            for (int i = 0; i < 16; ++i) { X[i] = 0.f; X2[i] = 0.f; }
#pragma unroll
            for (int x = 0; x < 2 * DKT; x += 2) { X = MFMA32(Kf[x], Qf[x], X); X2 = MFMA32(Kf[x + 1], Qf[x + 1], X2); }
#pragma unroll
            for (int i = 0; i < 16; ++i) X[i] += X2[i];
#pragma unroll
            for (int i = 0; i < 16; ++i) { const int j = (i & 3) + 8 * (i >> 2) + 4 * h; const bool keep = dir == 0 ? (j <= r) : (j >= r + strict); X[i] = keep ? X[i] : 0.f; }
            const bf16x8_t Xa0 = pack8<0>(X), Xa1 = pack8<1>(X);
            ob_prev = (GAS char*)uni_ptr(Og + m0 * 512);
#pragma unroll
            for (int n = 0; n < NVT; ++n) {
                f32x16_t O;
#pragma unroll
                for (int i = 0; i < 16; ++i) O[i] = 0.f;
                O = MFMA32(Xa0, frag_tr(tV, VP, 4 * h, n, lane), O);
                O = MFMA32(Xa1, frag_tr(tV, VP, 16 + 4 * h, n, lane), O);
#pragma unroll
                for (int a = 0; a < DKT; ++a) { O = MFMA32(Qf[2 * a], pack8<0>(S[a][n]), O); O = MFMA32(Qf[2 * a + 1], pack8<1>(S[a][n]), O); }
                Oprev[n] = O;
                    }
            asm volatile("" ::: "memory");
            if (si + 1 < nst) { const GAS char* qb = uni_ptr(Qg + m1 * 512);
#pragma unroll
                for (int x = 0; x < 2 * DKT; ++x) { nQ[x][0] = *(const GAS u32x2*)(qb + qoff + 32 * x); nQ[x][1] = *(const GAS u32x2*)(qb + qoff + 32 * x + 16); } }
        }
#pragma unroll
        for (int a = 0; a < DKT; ++a) {
            f32x4 al[4];
            if (VEC) {
#pragma unroll
                for (int g = 0; g < 4; ++g) al[g] = *(const LAS f32x4*)(tA + (32 * a + 8 * g + 4 * h) * 4); }
            const bf16x8_t k0 = frag_tr(tK, KP, 4 * h, a, lane), k1 = frag_tr(tK, KP, 16 + 4 * h, a, lane);
#pragma unroll
            for (int n = 0; n < NVT; ++n) {
                S[a][n] = MFMA32(k0, frag_tr(tV, VP, 4 * h, n, lane), S[a][n]);
                S[a][n] = MFMA32(k1, frag_tr(tV, VP, 16 + 4 * h, n, lane), S[a][n]);
#pragma unroll
                for (int i = 0; i < 16; ++i) S[a][n][i] *= VEC ? al[i >> 2][i & 3] : gsc;
            }
        }
    }
    if (FULL && nst > 0) {
#pragma unroll
        for (int n = 0; n < NVT; ++n)
#pragma unroll
            for (int i = 0; i < 16; ++i) *(GAS bf16_t*)(ob_prev + ooff + ((i & 3) + 8 * (i >> 2)) * 1024 + 64 * n) = (bf16_t)(pk_bf16(Oprev[n][i], 0.f) & 0xffffu); }
}

template <int DKT, int NVT, bool VEC, bool FULL>
__device__ __forceinline__ void chain_task(const Params& p, int l, int chain, int seg, LAS char* lds, int lane) {
    int b, dir, strict; const bf16_t *Qg, *Kg, *Vg; bf16_t* Og; const float* alpha = nullptr; float gsc = 0.f; size_t tbase;
    if (!VEC) { const int h = chain & 7; b = chain >> 4; dir = (chain >> 3) & 1; strict = 1; const float gam = 1.0f / (1.0f + expf(-p.ret_decay[l * 16 + dir * 8 + h])); gsc = exp2f(32.0f * log2f(gam));
        Qg = p.RQ + (size_t)dir * MT * 512 + h * 64; Kg = p.RK + (size_t)dir * MT * 512 + h * 64; Vg = p.U + C_RV + h * 64; Og = p.Oret + (size_t)dir * MT * 512 + h * 64; tbase = (size_t)chain * NSEG;
    } else { const int h = (chain >> 2) & 3, dq = chain & 3; b = chain >> 5; dir = (chain >> 4) & 1; strict = 0;
        Qg = p.HQ + (size_t)dir * MT * 512 + h * 128; Kg = p.HK + (size_t)dir * MT * 512 + h * 128; Vg = p.U + C_HI + h * 128 + dq * 32; Og = p.Ohg + (size_t)dir * MT * 512 + h * 128 + dq * 32;
        alpha = p.HA + ((size_t)dir * NCH + b * 136) * 512 + h * 128; tbase = (size_t)(64 + chain) * NSEG; }
    f32x16_t S[DKT][NVT];
#pragma unroll
    for (int a = 0; a < DKT; ++a)
#pragma unroll
        for (int n = 0; n < NVT; ++n)
#pragma unroll
            for (int i = 0; i < 16; ++i) S[a][n][i] = 0.f;
    constexpr int TS = DKT * NVT * 16 * 64, TG = 128;
    const int h = lane >> 5;
    if (FULL) {
        for (int s2 = 0; s2 < seg; ++s2) { const float* e = p.SE + (tbase + s2) * TS + lane; const float* gq = p.SG + (tbase + s2) * TG + 4 * h; const float gs = s2 == 0 ? 0.f : exp2f(16.0f * log2f(gsc));
#pragma unroll
            for (int a = 0; a < DKT; ++a) {
                f32x4 gv[4];
#pragma unroll
                for (int g = 0; g < 4; ++g) gv[g] = VEC ? *(const f32x4*)(gq + 32 * a + 8 * g) : (f32x4){gs, gs, gs, gs};
#pragma unroll
                for (int n = 0; n < NVT; ++n)
#pragma unroll
                    for (int i = 0; i < 16; ++i) S[a][n][i] = gv[i >> 2][i & 3] * S[a][n][i] + e[((a * NVT + n) * 16 + i) * 64]; } }
    }
    wave_seg<DKT, NVT, VEC, FULL>(Qg, Kg, Vg, INC, Og, alpha, gsc, b, seg_first(dir, seg), dir == 0 ? 1 : -1, seg_count(seg), dir, strict, S, lds, lane);
    if (!FULL) { float* e = p.SE + (tbase + seg) * TS + lane;
#pragma unroll
        for (int a = 0; a < DKT; ++a)
#pragma unroll
            for (int n = 0; n < NVT; ++n)
#pragma unroll
                for (int i = 0; i < 16; ++i) e[((a * NVT + n) * 16 + i) * 64] = S[a][n][i];
        if (VEC) { constexpr int KPc = DKT * 64 + 16, VPc = NVT * 64 + 16;
            const f32x4 gfin = *(const LAS f32x4*)(lds + 32 * KPc + 32 * VPc + DKT * 128 + (lane & (DKT * 8 - 1)) * 16);
            if (lane < DKT * 8) *(f32x4*)(p.SG + (tbase + seg) * TG + lane * 4) = gfin; }
    }
}

template <bool FULL, int VAR = 0> __device__ __forceinline__ void sweep_phase(const Params& p, int l, float* ldsf) {
    const int tid = TIDX, wave = __builtin_amdgcn_readfirstlane(tid >> 6); const int G = (int)gridDim.x;
    constexpr int NS = FULL ? NSEG : NSEG - 1;
    constexpr int N_HG = 128 * NS, N_RET = 64 * NS, N_LRU = FULL ? 0 : 64;
    LAS char* lds = (LAS char*)ldsf + wave * 12288;
    const int NW = 8 * G, w = wave * G + (int)blockIdx.x;
#ifndef NO_HG
    if (VAR != 2) for (int t = w; t < N_HG; t += NW) { const int chain = t / NS, seg = t - chain * NS; chain_task<4, 1, true, FULL>(p, l, chain, seg, lds, TIDX & 63); }
#endif
#ifndef NO_RET
    if (VAR != 1) for (int t = (w + NW - N_HG % NW) % NW; t < N_RET; t += NW) { const int chain = t / NS, seg = t - chain * NS; chain_task<2, 2, false, FULL>(p, l, chain, seg, lds, TIDX & 63); }
#endif
    for (int t = (w + NW - (N_HG + N_RET) % NW) % NW; t < N_LRU; t += NW) lru_tilescan_task(p, t, TIDX & 63);
}

__device__ __forceinline__ void mixprep_phase(const Params& p, int l) {
    const int tid = TIDX, lane = tid & 63; const int gw = blockIdx.x * (NTHREADS / 64) + __builtin_amdgcn_readfirstlane(tid >> 6), nw = gridDim.x * (NTHREADS / 64);
    float lgd[2];
#pragma unroll
    for (int dir = 0; dir < 2; ++dir) { const float gam = 1.0f / (1.0f + expf(-p.ret_decay[l * 16 + dir * 8 + (lane >> 3)])); lgd[dir] = log2f(gam); }
    for (int m = gw; m < MT; m += nw) {
        const int b = m / LT, pp = m - b * LT; const int hh = lane >> 3, d0 = (lane & 7) * 4;
        const bf16_t* u = p.U + (size_t)m * INC + hh * 64 + d0;
        const u32x2 qlo = *(const u32x2*)(u + C_RQ), qhi = *(const u32x2*)(u + C_RQ + 32), klo = *(const u32x2*)(u + C_RK), khi = *(const u32x2*)(u + C_RK + 32);
        float q1[4] = {bflo(qlo[0]), bfhi(qlo[0]), bflo(qlo[1]), bfhi(qlo[1])}, q2[4] = {bflo(qhi[0]), bfhi(qhi[0]), bflo(qhi[1]), bfhi(qhi[1])};
        float k1[4] = {bflo(klo[0]) * 0.125f, bfhi(klo[0]) * 0.125f, bflo(klo[1]) * 0.125f, bfhi(klo[1]) * 0.125f}, k2[4] = {bflo(khi[0]) * 0.125f, bfhi(khi[0]) * 0.125f, bflo(khi[1]) * 0.125f, bfhi(khi[1]) * 0.125f};
        if (pp >= LC) { const int tt = pp - LC;
            const float4 r0 = *(const float4*)(p.rot + (size_t)(tt * 32 + d0) * 2), r1 = *(const float4*)(p.rot + (size_t)(tt * 32 + d0) * 2 + 4);
            const float cc[4] = {r0.x, r0.z, r1.x, r1.z}, ss[4] = {r0.y, r0.w, r1.y, r1.w};
#pragma unroll
            for (int i = 0; i < 4; ++i) { const float a = q1[i] * cc[i] - q2[i] * ss[i], bq = q1[i] * ss[i] + q2[i] * cc[i]; q1[i] = a; q2[i] = bq;
                const float ck = k1[i] * cc[i] - k2[i] * ss[i], dk = k1[i] * ss[i] + k2[i] * cc[i]; k1[i] = ck; k2[i] = dk; } }
        const int ii = pp & 31;
#pragma unroll
        for (int dir = 0; dir < 2; ++dir) { const float lg = lgd[dir]; const float e = dir == 0 ? (float)(ii + 1) : (float)(32 - ii);
            const float sq = __builtin_amdgcn_exp2f(e * lg), sk = __builtin_amdgcn_exp2f(-e * lg);
            bf16_t* oq = p.RQ + ((size_t)dir * MT + m) * 512 + hh * 64 + d0; bf16_t* ok = p.RK + ((size_t)dir * MT + m) * 512 + hh * 64 + d0;
            u32x2 w; w[0] = pk_bf16(q1[0] * sq, q1[1] * sq); w[1] = pk_bf16(q1[2] * sq, q1[3] * sq); *(u32x2*)oq = w;
            w[0] = pk_bf16(q2[0] * sq, q2[1] * sq); w[1] = pk_bf16(q2[2] * sq, q2[3] * sq); *(u32x2*)(oq + 32) = w;
            w[0] = pk_bf16(k1[0] * sk, k1[1] * sk); w[1] = pk_bf16(k1[2] * sk, k1[3] * sk); *(u32x2*)ok = w;
            w[0] = pk_bf16(k2[0] * sk, k2[1] * sk); w[1] = pk_bf16(k2[2] * sk, k2[3] * sk); *(u32x2*)(ok + 32) = w; }
    }
    for (int unit = gw; unit < NCH * 8; unit += nw) {
        const int dir = unit & 1, ch = unit >> 3, hd = (unit >> 1) & 3, b = ch / 136, cs = ch - b * 136; const size_t m0 = (size_t)b * LT + cs * 32; const int c = hd * 128 + 2 * lane;
        unsigned zz_[32], qq[32]; const int zc = dir == 0 ? C_HFF : C_HFB;
        { const bf16_t* u = p.U + m0 * INC + c;
#pragma unroll
          for (int j = 0; j < 32; ++j) { zz_[j] = *(const unsigned*)(u + (size_t)j * INC + zc); qq[j] = *(const unsigned*)(u + (size_t)j * INC + C_HQ); } }
        const float lb0 = p.lb[l * 1024 + dir * 512 + c], lb1 = p.lb[l * 1024 + dir * 512 + c + 1];
        float G0 = 1.f, G1 = 1.f;
        if (dir == 0) {
#pragma unroll
            for (int s = 0; s < 32; ++s) { const int j = s; const unsigned zz = zz_[j];
                const float z0 = bflo(zz), z1 = bfhi(zz), qa = bflo(qq[j]), qb = bfhi(qq[j]);
                const float s0 = sigmoidf_(z0), s1 = sigmoidf_(z1); const float f0 = lb0 + (1.0f - lb0) * s0, f1 = lb1 + (1.0f - lb1) * s1;
                G0 *= f0; G1 *= f1;
                const float K0 = (1.0f - lb0) * (1.0f - s0) * __builtin_amdgcn_rcpf(fmaxf(G0, 1.0e-35f)), K1 = (1.0f - lb1) * (1.0f - s1) * __builtin_amdgcn_rcpf(fmaxf(G1, 1.0e-35f));
                *(unsigned*)(p.HQ + ((size_t)dir * MT + m0 + j) * 512 + c) = pk_bf16(qa * sigmoidf_(qa) * G0, qb * sigmoidf_(qb) * G1); *(unsigned*)(p.HK + ((size_t)dir * MT + m0 + j) * 512 + c) = pk_bf16(K0, K1); }
        } else {
#pragma unroll
            for (int s = 0; s < 32; ++s) { const int j = 31 - s; const unsigned zz = zz_[j];
                const float z0 = bflo(zz), z1 = bfhi(zz), qa = bflo(qq[j]), qb = bfhi(qq[j]);
                const float s0 = sigmoidf_(z0), s1 = sigmoidf_(z1); const float f0 = lb0 + (1.0f - lb0) * s0, f1 = lb1 + (1.0f - lb1) * s1;
                G0 *= f0; G1 *= f1;
                const float K0 = (1.0f - lb0) * (1.0f - s0) * __builtin_amdgcn_rcpf(fmaxf(G0, 1.0e-35f)), K1 = (1.0f - lb1) * (1.0f - s1) * __builtin_amdgcn_rcpf(fmaxf(G1, 1.0e-35f));
                *(unsigned*)(p.HQ + ((size_t)dir * MT + m0 + j) * 512 + c) = pk_bf16(qa * sigmoidf_(qa) * G0, qb * sigmoidf_(qb) * G1); *(unsigned*)(p.HK + ((size_t)dir * MT + m0 + j) * 512 + c) = pk_bf16(K0, K1); }
        }
        *(f32x2_t*)(p.HA + ((size_t)dir * NCH + ch) * 512 + c) = (f32x2_t){G0, G1};
    }
}

#ifndef GP_SP2
#define GP_SP2 true
#endif
#ifndef GP_ALIGN
#define GP_ALIGN true
#endif
constexpr int LDS_MAIN = 1024 * 36 * 4;
constexpr int LDS_TOTAL = LDS_MAIN + 16;

struct EpiScaledBf16 {
    static constexpr bool PERM = true, AFTER_DRAIN = false;
    bf16_t* O; int ldc; float scale;
    __device__ __forceinline__ void operator()(const f32x4 (&acc)[2][2][4][2], const Unit& u, int wr, int wc, int fr, int fq) const {
        bf16_t* base = O + (size_t)(u.pm * 256 + wr * 64 + fr) * ldc + u.pn * 256 + wc * 32 + 8 * fq;
#pragma unroll
        for (int ai = 0; ai < 2; ++ai)
#pragma unroll
            for (int m = 0; m < 4; ++m) { bf16_t* rowp = base + (size_t)(ai * 128 + m * 16) * ldc;
#pragma unroll
                for (int bj = 0; bj < 2; ++bj) { const f32x4 v0 = acc[ai][bj][m][0] * scale, v1 = acc[ai][bj][m][1] * scale;
                    u32x4 w; w.x = pg8::cvt_pk_bf16(v0[0], v0[1]); w.y = pg8::cvt_pk_bf16(v0[2], v0[3]); w.z = pg8::cvt_pk_bf16(v1[0], v1[1]); w.w = pg8::cvt_pk_bf16(v1[2], v1[3]);
                    *(u32x4*)(rowp + bj * 128) = w; } }
    }
};
__device__ __forceinline__ void gemm_in_phase(const Params& p, int l) {
    { pg8::Gemm g; g.A = p.H; g.Bt = p.wt_in + (size_t)l * INC * D; g.M = MT; g.N = C_GR; g.K = D;
      pg8::StaticOrder S; S.init(MT, C_GR, (int)gridDim.x, (int)blockIdx.x);
      pg8::EpiBf16<0> E; E.O = p.U; E.ldc = INC; E.bias = nullptr; E.split_cols = 0; E.split_stride = 0;
      pg8::gemm_phase<pg8::EpiBf16<0>, pg8::StaticOrder, GP_ALIGN, GP_SP2>((LAS unsigned char*)dyn_lds, g, S, E); }
    { pg8::Gemm g; g.A = (const bf16_t*)p.H8; g.Bt = (const bf16_t*)(p.wt_ing + (size_t)l * (INC - C_GR) * D); g.M = MT; g.N = INC - C_GR; g.K = D / 2;
      const int G = (int)gridDim.x, rot = (G - (MT / 256) * (C_GR / 256) % G) & ~7;
      pg8::StaticOrder S; S.init(MT, INC - C_GR, G, ((int)blockIdx.x + rot) % G);
      EpiScaledBf16 E; E.O = p.U + C_GR; E.ldc = INC; E.scale = 1.0f / W8_SCALE;
      pg8::gemm_phase<EpiScaledBf16, pg8::StaticOrder, GP_ALIGN, GP_SP2, true>((LAS unsigned char*)dyn_lds, g, S, E); }
}
__device__ __forceinline__ void gemm_merge_phase(const Params& p, int l) {
    pg8::Gemm g; g.A = p.Aall; g.Bt = p.wt_br + (size_t)l * 3 * 1024 * 512; g.M = 3 * MT; g.N = 3 * 1024; g.K = 512;
    SchedMerge S; S.G = (int)gridDim.x; S.c = (int)blockIdx.x; S.last = (l == DEPTH - 1);
    EpiBranch E; E.R = p.R;
    pg8::gemm_phase<EpiBranch, SchedMerge, GP_ALIGN, GP_SP2>((LAS unsigned char*)dyn_lds, g, S, E);
}
__device__ __forceinline__ void gemm_out_phase(const Params& p, int l) {
    pg8::Gemm g; g.A = p.Mg; g.Bt = p.wt_out + (size_t)l * D * D; g.M = MT; g.N = D; g.K = D;
    SchedOut S; S.init(MT, D, (int)gridDim.x, (int)blockIdx.x, l == DEPTH - 1);
    EpiOut E; E.X = p.X; E.mod_l = p.mod + (size_t)l * 5 * 6144;
    pg8::gemm_phase<EpiOut, SchedOut, GP_ALIGN, GP_SP2>((LAS unsigned char*)dyn_lds, g, S, E);
}
__device__ __forceinline__ void gemm_gu_phase(const Params& p, int l) {
    pg8::Gemm g; g.A = (const bf16_t*)p.Xg; g.Bt = (const bf16_t*)(p.wt_gu + (size_t)l * NE * 2048 * D); g.M = NE * CAPT * 256; g.N = NE * 2048; g.K = D / 2;
    build_tile_table(p, l);
    SchedMoE S; S.nN = 8; S.G = (int)gridDim.x; S.c = (int)blockIdx.x; S.sparseA = 1;
    EpiGU E; E.Act = p.Act; E.bgu = p.exp_b_gu + (size_t)l * NE * 2048;
    pg8::gemm_phase<EpiGU, SchedMoE, GP_ALIGN, GP_SP2, true>((LAS unsigned char*)dyn_lds, g, S, E);
}
__device__ __forceinline__ void gemm_down_phase(const Params& p, int l) {
    pg8::Gemm g; g.A = (const bf16_t*)p.Act; g.Bt = (const bf16_t*)(p.wt_down + (size_t)l * NE * D * D); g.M = MAXSLOTS; g.N = NE * D; g.K = D / 2;
    build_tile_table(p, l);
    SchedMoE S; S.nN = 4; S.G = (int)gridDim.x; S.c = (int)blockIdx.x; S.sparseA = 0;
    EpiDown E; E.Y = p.Y; E.bd = p.exp_b_down + (size_t)l * NE * D;
    pg8::gemm_phase<EpiDown, SchedMoE, GP_ALIGN, GP_SP2, true>((LAS unsigned char*)dyn_lds, g, S, E);
}

typedef __attribute__((address_space(4))) const Params* KParamsPtr;
__device__ __forceinline__ const Params& fresh_params() { KParamsPtr kp = (KParamsPtr)__builtin_amdgcn_kernarg_segment_ptr(); asm volatile("" : "+s"(kp)); return *(const Params*)kp; }
#define P_ fresh_params()
#ifdef BARRIER_TWICE
#define GRID_BARRIER() do { XcdBarrier _b = bar; asm volatile("" : "+s"(_b.bar), "+s"(_b.x)); xcd_barrier(_b); xcd_barrier(_b); } while (0)
#else
#define GRID_BARRIER() do { XcdBarrier _b = bar; asm volatile("" : "+s"(_b.bar), "+s"(_b.x)); xcd_barrier(_b); } while (0)
#endif
__global__ __launch_bounds__(512, 2) void k_fwd(Params p) {
    float* ldsf = (float*)dyn_lds;
#ifdef PROBE_PHASE
#ifndef PROBE_SHIFT
#define PROBE_SHIFT 0.0f
#endif
#ifndef PROBE_Q
#define PROBE_Q 50.0f
#endif
    unsigned long long pr_t0 = wall_clock64(), pr_prev = pr_t0, pr_acc = 0ull;
#define PMARK(id) do { const unsigned long long _t = wall_clock64(); if ((id) == PROBE_PHASE) pr_acc += _t - pr_prev; pr_prev = _t; } while (0)
#else
#define PMARK(id) do { } while (0)
#endif
    if (threadIdx.x == 0) *(uint4*)(dyn_lds + LDS_MAIN) = make_uint4(0u, 0u, 0u, 0u);
    __syncthreads();
    const XcdBarrier bar = xcd_barrier_post(P_.bar, (volatile LAS unsigned*)(dyn_lds + LDS_MAIN));
    convert_phase(P_, ldsf);
    mod_phase(P_, ldsf);
    small_phase(P_);
    GRID_BARRIER(); PMARK(0);
    norm_phase<0>(P_, 0);
    router_prep_phase(P_);
    GRID_BARRIER(); PMARK(1);
    for (int l = 0; l < DEPTH; ++l) {
        if (l > 0) { norm_phase<1>(P_, l); GRID_BARRIER(); PMARK(1); }
        gemm_in_phase(P_, l);
        GRID_BARRIER(); PMARK(2);
        mixprep_phase(P_, l);
#ifdef MIXPREP_TWICE
        mixprep_phase(P_, l);
#endif
#ifdef SPLIT_PREP
        GRID_BARRIER(); PMARK(16);
#endif
        lru_prep_phase(P_, l, ldsf);
#ifdef LRU_TWICE
        __syncthreads(); lru_prep_phase(P_, l, ldsf);
#endif
        GRID_BARRIER(); PMARK(3);
        sweep_phase<false>(P_, l, ldsf);
        GRID_BARRIER(); PMARK(4);
        sweep_phase<true>(P_, l, ldsf);
        GRID_BARRIER(); PMARK(13);
#ifdef SWEEP2_AGAIN
        { Params q = P_; q.Oret = q.Dummy; q.Ohg = q.Dummy; sweep_phase<true, SWEEP2_AGAIN - 1>(q, l, ldsf); }
        GRID_BARRIER();
#endif

        finish_phase(P_, l, l == DEPTH - 1);
        GRID_BARRIER(); PMARK(5);
        gemm_merge_phase(P_, l);
        GRID_BARRIER(); PMARK(6);
        merge_combine_phase(P_, l == DEPTH - 1);
        GRID_BARRIER(); PMARK(17);
        gemm_out_phase(P_, l);
        GRID_BARRIER(); PMARK(7);
        route_phase(P_, l, ldsf, l == DEPTH - 1);
        GRID_BARRIER(); PMARK(8);
        gemm_gu_phase(P_, l);
        GRID_BARRIER(); PMARK(11);
        gemm_down_phase(P_, l);
        GRID_BARRIER(); PMARK(12);
    }
#ifdef PROBE_PHASE
    if (blockIdx.x == 0 && threadIdx.x == 0) {
#ifdef PROBE_ABS
        const float fr = (float)((double)pr_acc / 100.0 / PROBE_ABS);
#else
        const float fr = (float)((double)pr_acc / (double)(pr_prev - pr_t0));
#endif
 ((float*)p.ctrl)[2048] = floorf(fr * PROBE_Q + 0.5f + PROBE_SHIFT) / PROBE_Q; }
    GRID_BARRIER();
#endif
    norm_phase<2>(P_, DEPTH);
}

static inline size_t align_up(size_t v, size_t a) { return (v + a - 1) / a * a; }

extern "C" void kernel_launch(void* const* d_in, const int* in_sizes, int n_in, void* d_out, int out_size, void* d_ws, size_t ws_size, hipStream_t stream) {
    (void)in_sizes; (void)n_in; (void)out_size; (void)ws_size;
    Params p{};
    const float** pin = (const float**)&p.x;
    for (int i = 0; i < 31; ++i) pin[i] = (const float*)d_in[i];
    p.out = (float*)d_out;
    char* w = (char*)d_ws; size_t off = 0;
    auto take = [&](size_t bytes) { char* r = w + off; off = align_up(off + bytes, 256); return r; };
    p.bar = (unsigned*)take(XCD_BAR_WORDS * 4);
    p.ctrl = (unsigned*)take(4096 * 4);
    const size_t zero_bytes = off;
    p.wt_in = (bf16_t*)take((size_t)DEPTH * INC * D * 2);
    p.wt_br = (bf16_t*)take((size_t)DEPTH * 3 * 1024 * 512 * 2);
    p.wt_out = (bf16_t*)take((size_t)DEPTH * D * D * 2);
    p.wt_gu = (unsigned char*)take((size_t)DEPTH * NE * 2048 * D);
    p.wt_down = (unsigned char*)take((size_t)DEPTH * NE * D * D);
    p.mod = (float*)take((size_t)DEPTH * 5 * 6144 * 4);
    p.lb = (float*)take(4096 * 4);
    p.rot = (float*)take((size_t)4096 * 32 * 2 * 4);
    p.X = (bf16_t*)take((size_t)MT * D * 2);
    p.H = (bf16_t*)take((size_t)MT * D * 2); p.H8 = (unsigned char*)take((size_t)MT * D); p.wt_ing = (unsigned char*)take((size_t)DEPTH * (INC - C_GR) * D);
    p.U = (bf16_t*)take((size_t)MT * INC * 2);
    p.Oret = (bf16_t*)take((size_t)2 * MT * 512 * 2);
    p.Ohg = (bf16_t*)take((size_t)2 * MT * 512 * 2);
    p.PH = (unsigned*)take((size_t)2 * MT * 512 * 4);
    p.RQ = (bf16_t*)take((size_t)2 * MT * 512 * 2); p.RK = (bf16_t*)take((size_t)2 * MT * 512 * 2); p.HQ = (bf16_t*)take((size_t)2 * MT * 512 * 2); p.HK = (bf16_t*)take((size_t)2 * MT * 512 * 2);
    p.HA = (float*)take((size_t)2 * (MT / 32) * 512 * 4);
    p.Dummy = (bf16_t*)take((size_t)2 * MT * 512 * 2);
    p.SE = (float*)take((size_t)192 * 9 * 4096 * 4); p.SG = (float*)take((size_t)192 * 9 * 128 * 4); p.LP = (float*)take((size_t)2 * 544 * 512 * 4); p.LH = (float*)take((size_t)2 * 544 * 512 * 4); p.LS = (float*)take((size_t)2 * 544 * 512 * 4);
    p.Aall = (bf16_t*)take((size_t)3 * MT * 512 * 2);
    p.R = (bf16_t*)take((size_t)3 * MT * D * 2); p.Dx = (bf16_t*)take((size_t)MT * D * 2);
    p.Mg = (bf16_t*)take((size_t)MT * D * 2);
    p.tok_e = (int*)take((size_t)MT * 4 * 4); p.tok_pos = (int*)take((size_t)MT * 4 * 4); p.tok_w = (float*)take((size_t)MT * 4 * 4);
    p.RWp = (float*)take((size_t)DEPTH * 5 * 1024 * 32 * 4); p.RC = (float*)take((size_t)DEPTH * 5 * 32 * 4);
    p.Xg = (unsigned char*)take((size_t)NE * CAPT * 256 * D); p.Act = (unsigned char*)take((size_t)MAXSLOTS * D); p.Y = (unsigned char*)take((size_t)MAXSLOTS * D);

    static int grid = 0;
    if (!grid) {
        (void)hipFuncSetAttribute((const void*)k_fwd, hipFuncAttributeMaxDynamicSharedMemorySize, LDS_TOTAL);
        int dev = 0, cus = 0, per_cu = 0;
        (void)hipGetDevice(&dev);
        (void)hipDeviceGetAttribute(&cus, hipDeviceAttributeMultiprocessorCount, dev);
        (void)hipOccupancyMaxActiveBlocksPerMultiprocessor(&per_cu, (const void*)k_fwd, 512, LDS_TOTAL);
        grid = cus * (per_cu < 1 ? per_cu : 1);
        if (grid <= 0) { fprintf(stderr, "k_fwd: occupancy query returned %d blocks per CU on %d CUs\n", per_cu, cus); grid = 0; return; }
    }
    (void)hipMemsetAsync(d_ws, 0, zero_bytes, stream);
    hipLaunchKernelGGL(k_fwd, dim3(grid), dim3(512), LDS_TOTAL, stream, p);
}
```

```cpp
#include <hip/hip_runtime.h>
#include <cstdio>
#include <cstdint>
__device__ __forceinline__ int pg8_tid_fresh() { int t = threadIdx.x; asm volatile("" : "+v"(t)); return t; }
namespace pg8 {
#define PG8_LAS __attribute__((address_space(3)))
typedef unsigned short bf16_t;
typedef short bf16x8 __attribute__((ext_vector_type(8)));
typedef float f32x4 __attribute__((ext_vector_type(4)));
typedef unsigned u32x4 __attribute__((ext_vector_type(4)));
constexpr int BM = 256, BK = 64, HALF = 128, HTB = HALF * BK * 2  , STAGE_BYTES = 8 * HTB, NXCD = 8, WGM = 8;

__host__ __device__ __forceinline__ int lds_byte(int r, int c) { const int st = (r >> 4) * 2 + (c >> 5), rr = r & 15, cc = c & 31, ob = rr * 64 + cc * 2; return st * 1024 + (ob ^ (((ob >> 9) & 1) << 5)); }
__host__ __device__ __forceinline__ void stage_rc(int b, int& R, int& C) { const int st = b / 1024, sb = b % 1024, swz = sb ^ (((sb >> 9) & 1) << 5); R = (st >> 1) * 16 + swz / 64; C = (st & 1) * 32 + (swz % 64) / 2; }
__host__ __device__ __forceinline__ int perm32(int rho) { const int n = rho >> 4, i = rho & 15; return 8 * (i >> 2) + 4 * n + (i & 3); }

struct Unit { int pm, pn, po; };
struct Gemm { const bf16_t* A; const bf16_t* Bt; int M, N, K; };

struct StaticOrder {
    int nM, nN, nwg, G, c;
    __host__ __device__ void init(int M, int N, int G_, int c_) { nM = M / BM; nN = N / BM; nwg = nM * nN; G = G_; c = c_; }
    __host__ __device__ bool next(int i, Unit& u) const {
        const long L = (long)i * G + c; if (L >= nwg) return false;
        int wgid = (int)L; { const int q = nwg / NXCD, r = nwg % NXCD, xcd = wgid % NXCD, off = wgid / NXCD; wgid = (xcd < r ? xcd * (q + 1) : r * (q + 1) + (xcd - r) * q) + off; }
        const int nig = WGM * nN, gid = wgid / nig, fm = gid * WGM, gsz = (nM - fm) < WGM ? (nM - fm) : WGM;
        u.pm = fm + ((wgid % nig) % gsz); u.pn = (wgid % nig) / gsz; return true;
    }
    __device__ __forceinline__ void a_ready(const Unit&) const {}
    __device__ __forceinline__ void done(const Unit&) const {}
};
__device__ __forceinline__ unsigned cvt_pk_bf16(float lo, float hi) { unsigned r; asm volatile("v_cvt_pk_bf16_f32 %0, %1, %2" : "=v"(r) : "v"(lo), "v"(hi)); return r; }
typedef float f32x2 __attribute__((ext_vector_type(2)));
__device__ __forceinline__ f32x2 gelu_pk(f32x2 v) {
    const f32x2 av = __builtin_elementwise_abs(v), d = av * 0.2316418882f + 1.0f;
    f32x2 t; t.x = __builtin_amdgcn_rcpf(d.x); t.y = __builtin_amdgcn_rcpf(d.y);
    f32x2 q = t * 0.5307027145f + (-0.7265760135f); q = q * t + 0.7107068705f; q = q * t + (-0.142248368f); q = q * t + 0.127414796f; q = q * t;
    const f32x2 s = (v * v) * (-0.72134752044f);
    f32x2 e; e.x = __builtin_amdgcn_exp2f(s.x); e.y = __builtin_amdgcn_exp2f(s.y);
    const f32x2 m = v * (q * e), r = v - m;
    f32x2 o; o.x = v.x < 0.f ? m.x : r.x; o.y = v.y < 0.f ? m.y : r.y; return o;
}

template <int ACT  > struct EpiBf16 {
    static constexpr bool PERM = true, AFTER_DRAIN = false;
    bf16_t* O; int ldc; const float* bias; int split_cols; size_t split_stride;
    __device__ __forceinline__ void operator()(const f32x4 (&acc)[2][2][4][2], const Unit& u, int wr, int wc, int fr, int fq) const {
        const int row0 = u.pm * BM + wr * 64 + fr; int colt = u.pn * BM; bf16_t* base = O;
        if (split_cols) { const int t = colt / split_cols; base += (size_t)t * split_stride; colt -= t * split_cols; }
        const int col0 = colt + wc * 32 + 8 * fq, bcol0 = u.pn * BM + wc * 32 + 8 * fq;
        f32x4 bv[2][2];
#pragma unroll
        for (int bj = 0; bj < 2; ++bj)
#pragma unroll
            for (int n = 0; n < 2; ++n) bv[bj][n] = bias ? *(const f32x4*)(bias + bcol0 + bj * HALF + 4 * n) : (f32x4){0.f, 0.f, 0.f, 0.f};
#pragma unroll
        for (int ai = 0; ai < 2; ++ai)
#pragma unroll
            for (int m = 0; m < 4; ++m) { bf16_t* rowp = base + (size_t)(row0 + ai * HALF + m * 16) * ldc + col0;
#pragma unroll
                for (int bj = 0; bj < 2; ++bj) { f32x4 v0 = acc[ai][bj][m][0] + bv[bj][0], v1 = acc[ai][bj][m][1] + bv[bj][1];
                    if (ACT == 1) { f32x2 a = gelu_pk((f32x2){v0[0], v0[1]}), b = gelu_pk((f32x2){v0[2], v0[3]}), c = gelu_pk((f32x2){v1[0], v1[1]}), d = gelu_pk((f32x2){v1[2], v1[3]});
                        v0 = (f32x4){a.x, a.y, b.x, b.y}; v1 = (f32x4){c.x, c.y, d.x, d.y}; }
                    if (ACT == 2) {
#pragma unroll
                        for (int j = 0; j < 4; ++j) { v0[j] = 0.5f * v0[j] * (1.0f + erff(v0[j] * 0.70710678f)); v1[j] = 0.5f * v1[j] * (1.0f + erff(v1[j] * 0.70710678f)); } }
                    u32x4 w; w.x = cvt_pk_bf16(v0[0], v0[1]); w.y = cvt_pk_bf16(v0[2], v0[3]); w.z = cvt_pk_bf16(v1[0], v1[1]); w.w = cvt_pk_bf16(v1[2], v1[3]);
                    *(u32x4*)(rowp + bj * HALF) = w; } }
    }
};


typedef int i32x4_f8 __attribute__((ext_vector_type(4)));
typedef int i32x8_f8 __attribute__((ext_vector_type(8)));
template <class Epi, class Sched, bool ALIGN_EPI = false, bool SP2 = false, bool F8 = false>
__device__ __forceinline__ void gemm_phase(PG8_LAS unsigned char* lds, const Gemm g, const Sched& S, const Epi& E) {
    const int tid = pg8_tid_fresh(), wid = __builtin_amdgcn_readfirstlane(tid >> 6), lane = tid & 63, wr = wid >> 2, wc = wid & 3, fr = lane & 15, fq = lane >> 4;
    const int K = g.K, nt = K / BK;
    unsigned voffA[2], voffB[2];
#pragma unroll
    for (int i = 0; i < 2; ++i) { int R, C; stage_rc(tid * 16 + i * 8192, R, C); const int Rb = Epi::PERM ? ((R & ~31) + perm32(R & 31)) : R;
        voffA[i] = (unsigned)(R * K + C) * 2u; voffB[i] = (unsigned)(Rb * K + C) * 2u; }
    const size_t kstep = (size_t)(BK * 2);
    const size_t hstep = (size_t)HALF * K * 2;
    const size_t tstep = 2 * hstep;
    const unsigned ldsw = (unsigned)wid * 1024u;
    const int aoff = lds_byte(wr * 64 + fr, fq * 8), boff = lds_byte(wc * 32 + fr, fq * 8);
#define PG8_SA(b, h) (((b) * 2 + (h)) * HTB)
#define PG8_SB(b, h) ((4 + (b) * 2 + (h)) * HTB)
#define PG8_STAGE(bufoff, gbase, voff) do { _Pragma("unroll") for (int _i = 0; _i < 2; ++_i) \
        __builtin_amdgcn_global_load_lds((const unsigned*)((const char*)(gbase) + (voff)[_i]), (PG8_LAS unsigned*)(lds + (bufoff) + ldsw + _i * 8192), 16, 0, 0); } while (0)
#define PG8_LDA(dst, b, h) do { if constexpr (F8) { _Pragma("unroll") for (int m = 0; m < 4; ++m) dst##8[m] = __builtin_shufflevector(*(const PG8_LAS i32x4_f8*)(lds + PG8_SA(b, h) + aoff + m * 2048), *(const PG8_LAS i32x4_f8*)(lds + PG8_SA(b, h) + aoff + m * 2048 + 1024), 0, 1, 2, 3, 4, 5, 6, 7); } \
        else { _Pragma("unroll") for (int m = 0; m < 4; ++m) _Pragma("unroll") for (int k = 0; k < 2; ++k) dst[m][k] = *(const PG8_LAS bf16x8*)(lds + PG8_SA(b, h) + aoff + m * 2048 + k * 1024); } } while (0)
#define PG8_LDB(dst, b, h) do { if constexpr (F8) { _Pragma("unroll") for (int n = 0; n < 2; ++n) dst##8[n] = __builtin_shufflevector(*(const PG8_LAS i32x4_f8*)(lds + PG8_SB(b, h) + boff + n * 2048), *(const PG8_LAS i32x4_f8*)(lds + PG8_SB(b, h) + boff + n * 2048 + 1024), 0, 1, 2, 3, 4, 5, 6, 7); } \
        else { _Pragma("unroll") for (int n = 0; n < 2; ++n) _Pragma("unroll") for (int k = 0; k < 2; ++k) dst[n][k] = *(const PG8_LAS bf16x8*)(lds + PG8_SB(b, h) + boff + n * 2048 + k * 1024); } } while (0)
#define PG8_MMA(ai, bj, At, Bt) do { __builtin_amdgcn_s_setprio(1); _Pragma("unroll") for (int m = 0; m < 4; ++m) _Pragma("unroll") for (int n = 0; n < 2; ++n) { \
        if constexpr (F8) { asm volatile("v_mfma_f32_16x16x128_f8f6f4 %0, %1, %2, %0" : "+v"(acc[ai][bj][m][n]) : "v"(Bt##8[n]), "v"(At##8[m])); } \
        else { _Pragma("unroll") for (int k = 0; k < 2; ++k) acc[ai][bj][m][n] = __builtin_amdgcn_mfma_f32_16x16x32_bf16(Bt[n][k], At[m][k], acc[ai][bj][m][n], 0, 0, 0); } } \
        __builtin_amdgcn_s_setprio(0); } while (0)
#define PG8_WAIT_V(n) asm volatile("s_waitcnt vmcnt(" #n ")" ::: "memory")
#define PG8_WAIT_L(n) asm volatile("s_waitcnt lgkmcnt(" #n ")" ::: "memory")
#define PG8_BAR __builtin_amdgcn_s_barrier()
#define PG8_SCHED __builtin_amdgcn_sched_barrier(0)
    Unit cur, nxt; int ui = 0;
    if (!S.next(0, cur)) return;
    float zf = 0.f; asm volatile("" : "+v"(zf));
    f32x4 acc[2][2][4][2];
#pragma unroll
    for (int a = 0; a < 2; ++a)
#pragma unroll
        for (int b = 0; b < 2; ++b)
#pragma unroll
            for (int m = 0; m < 4; ++m)
#pragma unroll
                for (int n = 0; n < 2; ++n) acc[a][b][m][n] = (f32x4){zf, zf, zf, zf};
    bf16x8 At[4][2], B0[2][2], B1[2][2]; i32x8_f8 At8[4], B08[2], B18[2];
    const char* cA = (const char*)g.A + (size_t)cur.pm * tstep; const char* cB = (const char*)g.Bt + (size_t)cur.pn * tstep;
    S.a_ready(cur);
    if constexpr (SP2) {
        PG8_STAGE(PG8_SB(0, 0), cB, voffB); PG8_STAGE(PG8_SB(0, 1), cB + hstep, voffB); PG8_STAGE(PG8_SA(0, 0), cA, voffA); PG8_STAGE(PG8_SA(0, 1), cA + hstep, voffA);
        if (wr == 1) PG8_BAR;
        PG8_WAIT_V(2); PG8_BAR;
        PG8_STAGE(PG8_SB(1, 0), cB + kstep, voffB); PG8_STAGE(PG8_SA(1, 0), cA + kstep, voffA); PG8_STAGE(PG8_SB(1, 1), cB + hstep + kstep, voffB);
        PG8_WAIT_V(6); PG8_BAR;
    } else {
        PG8_STAGE(PG8_SB(0, 0), cB, voffB); PG8_STAGE(PG8_SA(0, 0), cA, voffA); PG8_STAGE(PG8_SB(0, 1), cB + hstep, voffB); PG8_STAGE(PG8_SA(0, 1), cA + hstep, voffA);
        if (wr == 1) PG8_BAR;
        PG8_WAIT_V(4); PG8_BAR;
        PG8_STAGE(PG8_SB(1, 0), cB + kstep, voffB); PG8_STAGE(PG8_SA(1, 0), cA + kstep, voffA); PG8_STAGE(PG8_SB(1, 1), cB + hstep + kstep, voffB);
        PG8_WAIT_V(6); PG8_BAR;
    }
    for (;;) {
        const bool has_next = S.next(ui + 1, nxt);
        const char* nA = has_next ? (const char*)g.A + (size_t)nxt.pm * tstep : cA; const char* nB = has_next ? (const char*)g.Bt + (size_t)nxt.pn * tstep : cB;
        for (int t = 0; t < nt; t += 2) {
            const bool last = (t == nt - 2);
            const char* a1 = cA + (size_t)(t + 1) * kstep;
            const char* a2 = last ? nA : cA + (size_t)(t + 2) * kstep; const char* b2 = last ? nB : cB + (size_t)(t + 2) * kstep;
            const char* a3 = a2 + kstep; const char* b3 = b2 + kstep;
            if (last && has_next) S.a_ready(nxt);
            if constexpr (SP2) {
            PG8_LDB(B0, 0, 0); PG8_LDB(B1, 0, 1); PG8_SCHED; PG8_LDA(At, 0, 0); PG8_STAGE(PG8_SA(1, 1), a1 + hstep, voffA);
            PG8_WAIT_V(8); PG8_WAIT_L(0); PG8_BAR; PG8_MMA(0, 0, At, B0); PG8_MMA(0, 1, At, B1); PG8_BAR; PG8_SCHED;
            PG8_LDA(At, 0, 1); PG8_STAGE(PG8_SB(0, 0), b2, voffB); PG8_STAGE(PG8_SB(0, 1), b2 + hstep, voffB); PG8_STAGE(PG8_SA(0, 0), a2, voffA);
            PG8_WAIT_V(8); PG8_WAIT_L(0); PG8_BAR; PG8_MMA(1, 0, At, B0); PG8_MMA(1, 1, At, B1); PG8_BAR; PG8_SCHED;
            PG8_LDB(B0, 1, 0); PG8_LDB(B1, 1, 1); PG8_SCHED; PG8_LDA(At, 1, 0); PG8_STAGE(PG8_SA(0, 1), a2 + hstep, voffA);
            PG8_WAIT_V(8); PG8_WAIT_L(0); PG8_BAR; PG8_MMA(0, 0, At, B0); PG8_MMA(0, 1, At, B1); PG8_BAR; PG8_SCHED;
            PG8_LDA(At, 1, 1); PG8_STAGE(PG8_SB(1, 0), b3, voffB); PG8_STAGE(PG8_SB(1, 1), b3 + hstep, voffB); PG8_STAGE(PG8_SA(1, 0), a3, voffA);
            PG8_WAIT_V(8); PG8_WAIT_L(0); PG8_BAR; PG8_MMA(1, 0, At, B0); PG8_MMA(1, 1, At, B1); PG8_BAR; PG8_SCHED;
            } else {
            PG8_LDB(B0, 0, 0); PG8_SCHED; PG8_LDA(At, 0, 0); PG8_STAGE(PG8_SA(1, 1), a1 + hstep, voffA);
            PG8_WAIT_L(8); PG8_BAR; PG8_WAIT_L(0); PG8_MMA(0, 0, At, B0); PG8_BAR; PG8_SCHED;
            PG8_LDB(B1, 0, 1); PG8_STAGE(PG8_SB(0, 0), b2, voffB);
            PG8_BAR; PG8_WAIT_L(0); PG8_MMA(0, 1, At, B1); PG8_BAR;
            PG8_LDA(At, 0, 1); PG8_STAGE(PG8_SA(0, 0), a2, voffA);
            PG8_BAR; PG8_WAIT_L(0); PG8_MMA(1, 0, At, B0); PG8_BAR; PG8_SCHED;
            PG8_STAGE(PG8_SB(0, 1), b2 + hstep, voffB);
            PG8_WAIT_V(6); PG8_BAR; PG8_MMA(1, 1, At, B1); PG8_BAR;
            PG8_LDB(B0, 1, 0); PG8_SCHED; PG8_LDA(At, 1, 0); PG8_STAGE(PG8_SA(0, 1), a2 + hstep, voffA);
            PG8_WAIT_L(8); PG8_BAR; PG8_WAIT_L(0); PG8_MMA(0, 0, At, B0); PG8_BAR; PG8_SCHED;
            PG8_LDB(B1, 1, 1); PG8_STAGE(PG8_SB(1, 0), b3, voffB);
            PG8_BAR; PG8_WAIT_L(0); PG8_MMA(0, 1, At, B1); PG8_BAR;
            PG8_LDA(At, 1, 1); PG8_STAGE(PG8_SA(1, 0), a3, voffA);
            PG8_BAR; PG8_WAIT_L(0); PG8_MMA(1, 0, At, B0); PG8_BAR; PG8_SCHED;
            PG8_STAGE(PG8_SB(1, 1), b3 + hstep, voffB);
            PG8_WAIT_V(6); PG8_BAR; PG8_MMA(1, 1, At, B1); PG8_BAR;
            }
        }
        if constexpr (ALIGN_EPI) { if (wr == 0) PG8_BAR; }
        if constexpr (F8) asm volatile("s_nop 15\n\ts_nop 15" ::: "memory");
        if constexpr (!Epi::AFTER_DRAIN) { E(acc, cur, wr, wc, fr, fq); S.done(cur); }
        if (!has_next) break;
#pragma unroll
        for (int a = 0; a < 2; ++a)
#pragma unroll
            for (int b = 0; b < 2; ++b)
#pragma unroll
                for (int m = 0; m < 4; ++m)
#pragma unroll
                    for (int n = 0; n < 2; ++n) acc[a][b][m][n] = (f32x4){zf, zf, zf, zf};
        cur = nxt; cA = nA; cB = nB; ++ui;
        if constexpr (ALIGN_EPI) { if (wr == 1) PG8_BAR; }
    }
    PG8_WAIT_V(0);
    if constexpr (!ALIGN_EPI) { if (wr == 0) PG8_BAR; }
    PG8_BAR;
    if constexpr (Epi::AFTER_DRAIN) { E.fused(acc, cur, wr, wc, fr, fq, lds, wid, lane); S.done(cur); }
#undef PG8_SA
#undef PG8_SB
#undef PG8_STAGE
#undef PG8_LDA
#undef PG8_LDB
#undef PG8_MMA
#undef PG8_WAIT_V
#undef PG8_WAIT_L
#undef PG8_BAR
#undef PG8_SCHED
}
}
#include <hip/hip_runtime.h>
#include <cstdio>
#include <cstdint>
#include <cstdlib>
#include <vector>

#define XB_TMO      128
#define XB_XCNT(j)  (256  + 64 * (j))
#define XB_XSUB(j)  (1280 + 64 * (j))
#define XB_XGEN(j)  (2304 + 64 * (j))
#define XB_TOP      3328
#define XB_TOPGEN   3392
#define XCD_BAR_WORDS 3456
#define XB_SPIN_CAP (1u << 18)
#ifndef LAS
#define LAS __attribute__((address_space(3)))
#endif

__device__ __forceinline__ unsigned xb_ld(unsigned* p)              { return __hip_atomic_load(p, __ATOMIC_RELAXED, __HIP_MEMORY_SCOPE_AGENT); }
__device__ __forceinline__ unsigned xb_add(unsigned* p, unsigned v) { return __hip_atomic_fetch_add(p, v, __ATOMIC_RELAXED, __HIP_MEMORY_SCOPE_AGENT); }
__device__ __forceinline__ unsigned xb_xcc_id() { return (unsigned)__builtin_amdgcn_s_getreg((3 << 11) | 20) & 0xFu; }
#define XB_SPIN(cond, bar) do { unsigned _sp = 0; while (cond) { __builtin_amdgcn_s_sleep(1); \
    if ((++_sp & 255u) == 0u) { if (xb_ld(&(bar)[XB_TMO])) break; if (_sp > XB_SPIN_CAP) { atomicAdd(&(bar)[XB_TMO], 1u); break; } } } } while (0)

struct XcdBarrier {
    unsigned* bar; unsigned x;
    volatile LAS unsigned* st;
};

__device__ __forceinline__ XcdBarrier xcd_barrier_post(unsigned* bar, volatile LAS unsigned* st) {
    XcdBarrier b; b.bar = bar; b.x = xb_xcc_id(); b.st = st;
    if (threadIdx.x == 0) (void)xb_add(&bar[XB_XCNT(b.x)], 1u);
    return b;
}
__device__ __forceinline__ void xcd_barrier_complete(unsigned* bar, unsigned x, unsigned& nloc, unsigned& nx) {
    const unsigned G = gridDim.x * gridDim.y * gridDim.z;
    unsigned sum, cnt, mine, sp = 0u;
    for (;;) {
        sum = 0u; cnt = 0u; mine = 0u;
#pragma unroll
        for (unsigned j = 0; j < 16; ++j) { const unsigned c = xb_ld(&bar[XB_XCNT(j)]); sum += c; cnt += (c > 0u) ? 1u : 0u; mine = (j == x) ? c : mine; }
        if (sum == G) break;
        __builtin_amdgcn_s_sleep(1);
        if ((++sp & 255u) == 0u) { if (xb_ld(&bar[XB_TMO])) break; if (sp > XB_SPIN_CAP) { atomicAdd(&bar[XB_TMO], 1u); break; } }
    }
    nloc = mine > 0u ? mine : 1u; nx = cnt > 0u ? cnt : 1u;
}

__device__ __forceinline__ void xcd_barrier(const XcdBarrier& b) {
    asm volatile("s_waitcnt vmcnt(0)" ::: "memory");
    __syncthreads();
    if (threadIdx.x == 0) {
        unsigned* bar = b.bar;
        __builtin_amdgcn_s_waitcnt(0);
        unsigned nloc = b.st[0], nx = b.st[1];
        if (nloc == 0u) { xcd_barrier_complete(bar, b.x, nloc, nx); b.st[0] = nloc; b.st[1] = nx; }
        const unsigned old = xb_add(&bar[XB_XSUB(b.x)], 1u);
        const unsigned gen = old / nloc;
        if (old + 1u == (gen + 1u) * nloc) {
            __builtin_amdgcn_fence(__ATOMIC_RELEASE, "agent");
            asm volatile("s_waitcnt vmcnt(0)" ::: "memory");
            const unsigned og = xb_add(&bar[XB_TOP], 1u);
            const unsigned tg = og / nx;
            if (og + 1u == (tg + 1u) * nx) xb_add(&bar[XB_TOPGEN], 1u);
            else XB_SPIN(xb_ld(&bar[XB_TOPGEN]) == tg, bar);
            __builtin_amdgcn_fence(__ATOMIC_ACQUIRE, "agent");
            xb_add(&bar[XB_XGEN(b.x)], 1u);
            asm volatile("s_waitcnt vmcnt(0)" ::: "memory");
        } else {
            XB_SPIN(xb_ld(&bar[XB_XGEN(b.x)]) == gen, bar);
            __builtin_amdgcn_fence(__ATOMIC_ACQUIRE, "agent");
            asm volatile("s_waitcnt vmcnt(0)" ::: "memory");
        }
    }
    __syncthreads();
}


typedef unsigned short bf16_t;
using pg8::f32x4; using pg8::u32x4; using pg8::Unit;
typedef unsigned u32x2 __attribute__((ext_vector_type(2)));
#define LAS __attribute__((address_space(3)))
#define TIDX pg8_tid_fresh()

constexpr int D = 1024, NB = 4, SEQ = 4096, DEPTH = 4, LC = 256, LT = SEQ + LC, MT = NB * LT;
constexpr int INC = 8704;
constexpr int C_RQ = 0, C_RK = 512, C_RV = 1024, C_RG = 1536, C_HQ = 2048, C_HFF = 2560, C_HFB = 3072, C_HI = 3584, C_HGT = 4096, C_LX = 4608, C_LGT = 5120, C_GR = 5632;
constexpr float W8_SCALE = 64.0f;
constexpr int NE = 32, MAXTILES = 304, MAXSLOTS = MAXTILES * 256, CAPT = 68;
constexpr int TB_OFF = 131072;
constexpr int NTHREADS = 512;

struct Params {
    const float *x, *c, *ctx, *c_ctx, *mod_w, *mod_b, *norm1_g, *norm2_g, *final_g, *w_in, *ret_decay, *ret_gn_g, *w_ret_o, *hgrn_lb_logits, *hgrn_gn_g, *w_hgrn_o,
        *lru_conv_w, *lru_conv_b, *lru_wa, *lru_ba, *lru_wx, *lru_bx, *lru_lambda, *w_lru_o, *w_out, *router_w, *router_b, *exp_w_gu, *exp_b_gu, *exp_w_down, *exp_b_down;
    float* out;
    bf16_t *wt_in, *wt_br, *wt_out; unsigned char *wt_gu, *wt_down;
    float *mod, *lb, *rot;
    bf16_t* X; bf16_t* H; unsigned char* H8; unsigned char* wt_ing; bf16_t* U;
    bf16_t *Oret, *Ohg, *Dummy; unsigned* PH;
    bf16_t *RQ, *RK, *HQ, *HK; float *HA, *SE, *SG, *LP, *LH, *LS;
    bf16_t* Aall; bf16_t* R; bf16_t* Mg; bf16_t* Dx;
    unsigned* bar; unsigned* ctrl;
    int *tok_e, *tok_pos; float* tok_w;
    float *RWp, *RC;
    unsigned char *Xg, *Act; unsigned char* Y;
};

__device__ __forceinline__ float bf2f(bf16_t v) { return __uint_as_float(((unsigned)v) << 16); }
__device__ __forceinline__ float bflo(unsigned w) { return __uint_as_float(w << 16); }
__device__ __forceinline__ float bfhi(unsigned w) { return __uint_as_float(w & 0xffff0000u); }
__device__ __forceinline__ float sigmoidf_(float x) { return __builtin_amdgcn_rcpf(1.0f + __expf(-x)); }
__device__ __forceinline__ float shx(float v, int o, int lane) { return __int_as_float(__builtin_amdgcn_ds_bpermute((lane ^ o) << 2, __float_as_int(v))); }
__device__ __forceinline__ float wave_sum(float v, int lane) {
#pragma unroll
    for (int o = 32; o >= 1; o >>= 1) v += shx(v, o, lane);
    return v;
}

extern __shared__ __attribute__((aligned(16))) unsigned char dyn_lds[];
__device__ __forceinline__ unsigned char* dyn_lds_base() { return dyn_lds; }
typedef short bf16x8_t __attribute__((ext_vector_type(8)));
typedef short s16x4_t __attribute__((ext_vector_type(4)));
typedef float f32x16_t __attribute__((ext_vector_type(16)));
typedef float f32x2_t __attribute__((ext_vector_type(2)));
typedef __bf16 bf16v2_t __attribute__((ext_vector_type(2)));
constexpr int NCH = MT / 32;
#define MFMA32(a, b, c) __builtin_amdgcn_mfma_f32_32x32x16_bf16((a), (b), (c), 0, 0, 0)

#define GAS __attribute__((address_space(1)))
__device__ __forceinline__ const GAS char* uni_ptr(const void* p) { const unsigned long long v = (unsigned long long)p;
    const unsigned lo = __builtin_amdgcn_readfirstlane((unsigned)v), hi = __builtin_amdgcn_readfirstlane((unsigned)(v >> 32)); return (const GAS char*)(((unsigned long long)hi << 32) | lo); }
__device__ __forceinline__ unsigned pk_fp8x4(float a, float b, float c, float d) {
    a = fminf(fmaxf(a, -448.f), 448.f); b = fminf(fmaxf(b, -448.f), 448.f); c = fminf(fmaxf(c, -448.f), 448.f); d = fminf(fmaxf(d, -448.f), 448.f);
    int t = __builtin_amdgcn_cvt_pk_fp8_f32(a, b, 0, false); t = __builtin_amdgcn_cvt_pk_fp8_f32(c, d, t, true); return (unsigned)t; }
__device__ __forceinline__ unsigned pk_bf16(float a, float b) { const f32x2_t v = {a, b}; return __builtin_bit_cast(unsigned, __builtin_convertvector(v, bf16v2_t)); }
template <int s> __device__ __forceinline__ bf16x8_t pack8(const f32x16_t& x) {
    u32x4 w; w[0] = pk_bf16(x[8 * s], x[8 * s + 1]); w[1] = pk_bf16(x[8 * s + 2], x[8 * s + 3]); w[2] = pk_bf16(x[8 * s + 4], x[8 * s + 5]); w[3] = pk_bf16(x[8 * s + 6], x[8 * s + 7]);
    return __builtin_bit_cast(bf16x8_t, w);
}
__device__ __forceinline__ bf16x8_t frag_row(const LAS char* t, int pitch, int row, int colbase) {
    const s16x4_t lo = *(const LAS s16x4_t*)(t + row * pitch + colbase * 2), hi = *(const LAS s16x4_t*)(t + row * pitch + colbase * 2 + 16);
    return __builtin_shufflevector(lo, hi, 0, 1, 2, 3, 4, 5, 6, 7);
}
__device__ __forceinline__ bf16x8_t frag_tr(const LAS char* t, int pitch, int jb, int ct, int lane) {
    const int q = (lane & 15) >> 2, pp = lane & 3, blk = (lane >> 4) & 1;
    const LAS char* a0 = t + (jb + q) * pitch + (32 * ct + 16 * blk + 4 * pp) * 2;
    const s16x4_t lo = __builtin_amdgcn_ds_read_tr16_b64_v4i16((LAS s16x4_t*)a0), hi = __builtin_amdgcn_ds_read_tr16_b64_v4i16((LAS s16x4_t*)(a0 + 8 * pitch));
    return __builtin_shufflevector(lo, hi, 0, 1, 2, 3, 4, 5, 6, 7);
}


__device__ __forceinline__ void build_tile_table(const Params& p, int l) {
    LAS int* te = (LAS int*)((LAS char*)dyn_lds_base() + TB_OFF); LAS int* tb = te + MAXTILES; LAS int* tc = tb + NE + 1; const int t = TIDX;
    if (t < NE) tc[t] = ((int)p.ctrl[l * 64 + t] + 255) >> 8;
    __syncthreads();
    if (t <= NE) { int s = 0;
#pragma unroll 1
        for (int k = 0; k < t; ++k) s += tc[k];
        tb[t] = s; }
    __syncthreads();
    if (t < MAXTILES) { int e = 0;
#pragma unroll 1
        for (int k = 1; k < NE; ++k) e += (tb[k] <= t) ? 1 : 0;
        te[t] = e; }
    __syncthreads();
}

constexpr int CT_K = 128;
__device__ __forceinline__ void convert_tiles(const float* __restrict__ src, bf16_t* __restrict__ dst, int K, int N, size_t sstride, size_t dstride, int mode, int nbatch, float* lds, int f8 = 0, int ld = 0) {
    const int t = TIDX & 255, half = TIDX >> 8; float* tile = lds + half * (CT_K * 65); if (ld == 0) ld = N;
    const int tn = N / 64, tk = K / CT_K, per = tn * tk, total = per * nbatch, stride = gridDim.x * 2, hb = blockIdx.x * 2 + half;
    const int iters = (total + stride - 1) / stride;
    for (int it = 0; it < iters; ++it) {
        const int idx = it * stride + hb; const bool valid = idx < total;
        const int bz = idx / per, rem = idx - bz * per, ky = rem / tn, nx = rem - ky * tn; const int n0 = nx * 64, k0 = ky * CT_K;
        if (valid) { const float* s = src + (size_t)bz * sstride;
#pragma unroll
            for (int i = 0; i < CT_K / 16; ++i) { const int r = (t >> 4) + 16 * i, cq = (t & 15) * 4; const float4 v = *(const float4*)(s + (size_t)(k0 + r) * ld + n0 + cq);
                tile[r * 65 + cq] = v.x; tile[r * 65 + cq + 1] = v.y; tile[r * 65 + cq + 2] = v.z; tile[r * 65 + cq + 3] = v.w; } }
        __syncthreads();
        if (valid) { bf16_t* d = dst + (size_t)bz * dstride; const int n = t >> 2, kq = (t & 3) * (CT_K / 4);
            int nd = n0 + n; if (mode == 1) { const int j = nd & 1023, up = nd >> 10; nd = (j >> 7) * 256 + up * 128 + (j & 127); }
            if (f8) { uint4* o = (uint4*)((unsigned char*)dst + (size_t)bz * dstride + (size_t)nd * K + k0 + kq);
#pragma unroll
                for (int q = 0; q < CT_K / 64; ++q) { unsigned w[4];
#pragma unroll
                    for (int i = 0; i < 4; ++i) { const int kk = kq + 16 * q + 4 * i; w[i] = pk_fp8x4(W8_SCALE * tile[kk * 65 + n], W8_SCALE * tile[(kk + 1) * 65 + n], W8_SCALE * tile[(kk + 2) * 65 + n], W8_SCALE * tile[(kk + 3) * 65 + n]); }
                    o[q] = make_uint4(w[0], w[1], w[2], w[3]); }
            } else { uint4* o = (uint4*)(d + (size_t)nd * K + k0 + kq);
#pragma unroll
                for (int q = 0; q < CT_K / 32; ++q) { unsigned w[4];
#pragma unroll
                    for (int i = 0; i < 4; ++i) { const int kk = kq + 8 * q + 2 * i; w[i] = pg8::cvt_pk_bf16(tile[kk * 65 + n], tile[(kk + 1) * 65 + n]); }
                    o[q] = make_uint4(w[0], w[1], w[2], w[3]); } } }
        __syncthreads();
    }
}
__device__ __forceinline__ void convert_phase(const Params& p, float* lds) {
    convert_tiles(p.w_in, p.wt_in, D, C_GR, (size_t)D * INC, (size_t)INC * D, 0, DEPTH, lds, 0, INC);
    convert_tiles(p.w_in + C_GR, (bf16_t*)p.wt_ing, D, INC - C_GR, (size_t)D * INC, (size_t)(INC - C_GR) * D, 0, DEPTH, lds, 1, INC);
    convert_tiles(p.w_ret_o, p.wt_br, 512, 1024, (size_t)512 * 1024, (size_t)3 * 1024 * 512, 0, DEPTH, lds);
    convert_tiles(p.w_hgrn_o, p.wt_br + (size_t)1024 * 512, 512, 1024, (size_t)512 * 1024, (size_t)3 * 1024 * 512, 0, DEPTH, lds);
    convert_tiles(p.w_lru_o, p.wt_br + (size_t)2 * 1024 * 512, 512, 1024, (size_t)512 * 1024, (size_t)3 * 1024 * 512, 0, DEPTH, lds);
    convert_tiles(p.w_out, p.wt_out, D, D, (size_t)D * D, (size_t)D * D, 0, DEPTH, lds);
    convert_tiles(p.exp_w_gu, (bf16_t*)p.wt_gu, D, 2048, (size_t)D * 2048, (size_t)2048 * D, 1, DEPTH * NE, lds, 1);
    convert_tiles(p.exp_w_down, (bf16_t*)p.wt_down, D, D, (size_t)D * D, (size_t)D * D, 0, DEPTH * NE, lds, 1);
}

__device__ __forceinline__ void mod_phase(const Params& p, float* lds) {
    float* s = lds; float* red = lds + 5 * 1024;
    const int t = TIDX;
    for (int i = t; i < 5 * 1024; i += NTHREADS) { const int r = i >> 10, k = i & 1023; const float v = (r < 4) ? p.c[r * 1024 + k] : p.c_ctx[k]; s[i] = v / (1.0f + expf(-v)); }
    __syncthreads();
    for (int unit = blockIdx.x; unit < 96 * DEPTH; unit += gridDim.x) {
        const int l = unit / 96, n0 = (unit - l * 96) * 64;
        const int nn = t & 63, kg = t >> 6; const float* w = p.mod_w + (size_t)l * 1024 * 6144 + n0 + nn;
        float acc[5] = {0.f, 0.f, 0.f, 0.f, 0.f};
        for (int k = kg * 128; k < kg * 128 + 128; ++k) { const float wv = w[(size_t)k * 6144];
#pragma unroll
            for (int r = 0; r < 5; ++r) acc[r] += s[r * 1024 + k] * wv; }
#pragma unroll
        for (int r = 0; r < 5; ++r) red[(kg * 5 + r) * 64 + nn] = acc[r];
        __syncthreads();
        if (t < 320) { const int r = t >> 6, n2 = t & 63; float a = 0.f;
#pragma unroll
            for (int g = 0; g < 8; ++g) a += red[(g * 5 + r) * 64 + n2];
            p.mod[(size_t)(l * 5 + r) * 6144 + n0 + n2] = a + p.mod_b[l * 6144 + n0 + n2]; }
        __syncthreads();
    }
}
__device__ __forceinline__ void small_phase(const Params& p) {
    for (int i = blockIdx.x * NTHREADS + TIDX; i < 4096 * 32; i += gridDim.x * NTHREADS) {
        if (i < 1024) { float v[4], m = -1e30f;
#pragma unroll
            for (int l = 0; l < 4; ++l) { v[l] = p.hgrn_lb_logits[l * 1024 + i]; m = fmaxf(m, v[l]); }
            float sum = 0.f;
#pragma unroll
            for (int l = 0; l < 4; ++l) { v[l] = expf(v[l] - m); sum += v[l]; }
            float cum = 0.f;
#pragma unroll
            for (int l = 0; l < 4; ++l) { const float sm = v[l] / sum; if (l > 0) cum += sm; p.lb[l * 1024 + i] = cum; } }
        const int t = i >> 5, f = i & 31; const float inv = powf(10000.0f, -(float)(f & 15) / 16.0f); const float pos = (f < 16) ? (float)(t >> 6) : (float)(t & 63);
        const float ang = pos * inv; p.rot[i * 2] = cosf(ang); p.rot[i * 2 + 1] = sinf(ang); }
}
template <int MODE> __device__ __forceinline__ void norm_phase(const Params& p, int l) {
    if (MODE != 0) build_tile_table(p, l - 1);
    const LAS int* tbp = (const LAS int*)((const LAS char*)dyn_lds_base() + TB_OFF) + MAXTILES;
    const int lane = TIDX & 63; const int gw = blockIdx.x * (NTHREADS / 64) + __builtin_amdgcn_readfirstlane(TIDX >> 6), nw = gridDim.x * (NTHREADS / 64);
    int ne[4] = {0, 0, 0, 0}, np[4] = {0, 0, 0, 0}; float nwt[4] = {0.f, 0.f, 0.f, 0.f};
    const bool bymap = (nw == 2048); const int wb = gw >> 9, wj = gw & 511; const int nit = bymap ? (wj < 256 ? 9 : 8) : (MT - gw + nw - 1) / nw;
#define NP_ROW(IT) (bymap ? wb * LT + wj + 512 * (IT) : gw + (IT) * nw)
    if (MODE != 0 && nit > 0) { const int m0_ = NP_ROW(0);
#pragma unroll
        for (int k = 0; k < 4; ++k) { ne[k] = p.tok_e[m0_ * 4 + k]; np[k] = p.tok_pos[m0_ * 4 + k]; nwt[k] = p.tok_w[m0_ * 4 + k]; } }
    float4 gN[4], shN[4], scN[4], g2v[4]; int cur_mr = -1;
#pragma unroll
    for (int j = 0; j < 4; ++j) gN[j] = (MODE != 2) ? *(const float4*)(p.norm1_g + l * D + j * 256 + lane * 4) : *(const float4*)(p.final_g + j * 256 + lane * 4);
    for (int it = 0; it < nit; ++it) { const int m = NP_ROW(it);
        const int b = m / LT, pp = m - b * LT; const bool isctx = pp < LC; const int mr = isctx ? 4 : b;
        float4 xv[4];
        if (mr != cur_mr) { cur_mr = mr;
            if (MODE != 2) { const float* mv = p.mod + (size_t)(l * 5 + mr) * 6144;
#pragma unroll
                for (int j = 0; j < 4; ++j) { const int col = j * 256 + lane * 4; shN[j] = *(const float4*)(mv + col); scN[j] = *(const float4*)(mv + 1024 + col); } }
            if (MODE != 0) { const float* g2 = p.mod + (size_t)((l - 1) * 5 + mr) * 6144 + 5 * 1024;
#pragma unroll
                for (int j = 0; j < 4; ++j) g2v[j] = *(const float4*)(g2 + j * 256 + lane * 4); } }
        if (MODE == 0) { const float* src = isctx ? p.ctx + (size_t)(b * LC + pp) * D : p.x + (size_t)(b * SEQ + pp - LC) * D;
#pragma unroll
            for (int j = 0; j < 4; ++j) xv[j] = *(const float4*)(src + j * 256 + lane * 4);
        } else {
            int slot[4]; float w[4];
#pragma unroll
            for (int k = 0; k < 4; ++k) { slot[k] = tbp[ne[k]] * 256 + np[k]; w[k] = nwt[k]; }
            unsigned yv[4][4];
#pragma unroll
            for (int j = 0; j < 4; ++j) { const int col = j * 256 + lane * 4; { const u32x2 xr = *(const u32x2*)(p.X + (size_t)m * D + col); xv[j] = make_float4(bflo(xr.x), bfhi(xr.x), bflo(xr.y), bfhi(xr.y)); }
#pragma unroll
                for (int k = 0; k < 4; ++k) yv[j][k] = *(const unsigned*)(p.Y + (size_t)slot[k] * D + col); }
            if (it + 1 < nit) { const int mn_ = NP_ROW(it + 1);
#pragma unroll
                for (int k = 0; k < 4; ++k) { ne[k] = p.tok_e[mn_ * 4 + k]; np[k] = p.tok_pos[mn_ * 4 + k]; nwt[k] = p.tok_w[mn_ * 4 + k]; } }
#pragma unroll
            for (int j = 0; j < 4; ++j) { float a0 = 0.f, a1 = 0.f, a2 = 0.f, a3 = 0.f;
#pragma unroll
                for (int k = 0; k < 4; ++k) { const f32x2_t ylo = __builtin_amdgcn_cvt_pk_f32_fp8((int)yv[j][k], false), yhi = __builtin_amdgcn_cvt_pk_f32_fp8((int)yv[j][k], true); a0 += w[k] * ylo[0]; a1 += w[k] * ylo[1]; a2 += w[k] * yhi[0]; a3 += w[k] * yhi[1]; }
                xv[j].x += g2v[j].x * a0; xv[j].y += g2v[j].y * a1; xv[j].z += g2v[j].z * a2; xv[j].w += g2v[j].w * a3; }
        }
        if (MODE != 2) {
#pragma unroll
            for (int j = 0; j < 4; ++j) { u32x2 xw; xw.x = pg8::cvt_pk_bf16(xv[j].x, xv[j].y); xw.y = pg8::cvt_pk_bf16(xv[j].z, xv[j].w); *(u32x2*)(p.X + (size_t)m * D + j * 256 + lane * 4) = xw; } }
        float ss = 0.f;
#pragma unroll
        for (int j = 0; j < 4; ++j) ss += xv[j].x * xv[j].x + xv[j].y * xv[j].y + xv[j].z * xv[j].z + xv[j].w * xv[j].w;
        ss = wave_sum(ss, lane); const float rstd = rsqrtf(ss * (1.0f / D) + 1e-6f);
#ifdef PROBE_PHASE
        const float pr_scale = 1.0f + ((const float*)p.ctrl)[2048];
#else
        const float pr_scale = 1.0f;
#endif
        if (MODE == 2) { if (!isctx) { float* o = p.out + (size_t)(b * SEQ + pp - LC) * D;
#pragma unroll
                for (int j = 0; j < 4; ++j) { const int col = j * 256 + lane * 4; const float4 g = gN[j];
                    *(float4*)(o + col) = make_float4(xv[j].x * rstd * g.x * pr_scale, xv[j].y * rstd * g.y * pr_scale, xv[j].z * rstd * g.z * pr_scale, xv[j].w * rstd * g.w * pr_scale); } }
        } else {
#pragma unroll
            for (int j = 0; j < 4; ++j) { const int col = j * 256 + lane * 4; const float4 g = gN[j], sh = shN[j], sc = scN[j];
                const float h0 = xv[j].x * rstd * g.x * (1.f + sc.x) + sh.x, h1 = xv[j].y * rstd * g.y * (1.f + sc.y) + sh.y, h2 = xv[j].z * rstd * g.z * (1.f + sc.z) + sh.z, h3 = xv[j].w * rstd * g.w * (1.f + sc.w) + sh.w;
                u32x2 w2; w2.x = pg8::cvt_pk_bf16(h0, h1); w2.y = pg8::cvt_pk_bf16(h2, h3); *(u32x2*)(p.H + (size_t)m * D + col) = w2;
                *(unsigned*)(p.H8 + (size_t)m * D + col) = pk_fp8x4(h0, h1, h2, h3); } }
    }
}
#undef NP_ROW
__device__ __forceinline__ void lru_prep_phase(const Params& p, int l, float* ldsf) {
    const int tid = TIDX, lane = tid & 63, wave = __builtin_amdgcn_readfirstlane(tid >> 6), r = lane & 31, h = lane >> 5; const int G8 = (int)gridDim.x >> 3;
    if ((int)blockIdx.x >= G8 * 8) return;
    const int hb = blockIdx.x & 7, rank = blockIdx.x >> 3;
    LAS char* lds = (LAS char*)ldsf; LAS char* tW = lds; LAS char* tH = lds + 36864 + wave * 9216; LAS char* tX = tH + 4480;
#pragma unroll
    for (int i = 0; i < 16; ++i) { const int e = tid + 512 * i, mat = e >> 11, rr = (e & 2047) * 2, dir = mat >> 1; const float* src = (mat & 1) ? p.lru_wx : p.lru_wa;
        const f32x2_t v = *(const f32x2_t*)(src + (size_t)((l * 2 + dir) * 8 + hb) * 4096 + rr);
        *(LAS unsigned*)(tW + mat * 9216 + (rr >> 6) * 144 + (rr & 63) * 2) = pk_bf16(v[0], v[1]); }
    __syncthreads();
    const int cch = hb * 64 + lane;
    const float cb = p.lru_conv_b[l * 512 + cch], cw0 = p.lru_conv_w[(l * 4 + 0) * 512 + cch], cw1 = p.lru_conv_w[(l * 4 + 1) * 512 + cch], cw2 = p.lru_conv_w[(l * 4 + 2) * 512 + cch], cw3 = p.lru_conv_w[(l * 4 + 3) * 512 + cch];
    const int per_wg = (MT / 32 + G8 - 1) / G8;
    for (int q = wave; q < per_wg && rank * per_wg + q < MT / 32; q += 8) { const int t32 = rank * per_wg + q;
        const int m0 = t32 * 32, b = m0 / LT, p0 = m0 - b * LT; const int seg_lo = p0 < LC ? 0 : LC, seg_hi = p0 < LC ? LC : LT;
#pragma unroll
        for (int i = 0; i < 5; ++i) { const int idx = lane + 64 * i; if (idx < 35 * 8) { const int row = idx >> 3, ch = idx & 7, q = p0 - 2 + row; u32x4 v = {0u, 0u, 0u, 0u};
                if (q >= seg_lo && q < seg_hi) v = *(const u32x4*)(p.U + (size_t)(b * LT + q) * INC + C_LX + hb * 64 + ch * 8);
                *(LAS u32x4*)(tH + row * 128 + ch * 16) = v; } }
        asm volatile("s_waitcnt lgkmcnt(0)" ::: "memory");
#pragma unroll
        for (int j = 0; j < 32; ++j) { const LAS bf16_t* col = (const LAS bf16_t*)(tH + j * 128 + lane * 2);
            const float x = cb + bf2f(col[0]) * cw0 + bf2f(col[64]) * cw1 + bf2f(col[128]) * cw2 + bf2f(col[192]) * cw3;
            *(LAS bf16_t*)(tX + j * 144 + lane * 2) = (bf16_t)(pk_bf16(x, 0.f) & 0xffffu); }
        asm volatile("s_waitcnt lgkmcnt(0)" ::: "memory");
        bf16x8_t Af[4];
#pragma unroll
        for (int x = 0; x < 4; ++x) Af[x] = frag_row(tX, 144, r, 16 * x + 4 * h);
#pragma unroll
        for (int dir = 0; dir < 2; ++dir) {
            f32x16_t acc[2][2];
#pragma unroll
            for (int gq = 0; gq < 2; ++gq)
#pragma unroll
                for (int nt = 0; nt < 2; ++nt) {
#pragma unroll
                    for (int i = 0; i < 16; ++i) acc[gq][nt][i] = 0.f;
#pragma unroll
                    for (int x = 0; x < 4; ++x) acc[gq][nt] = MFMA32(Af[x], frag_tr(tW + (dir * 2 + gq) * 9216, 144, 16 * x + 4 * h, nt, lane), acc[gq][nt]); }
#pragma unroll
            for (int nt = 0; nt < 2; ++nt) { const int c = hb * 64 + 32 * nt + r, pi = (l * 2 + dir) * 512 + c; const float ba = p.lru_ba[pi], bx = p.lru_bx[pi], lam = p.lru_lambda[pi];
                const float sp8 = -8.0f * log1pf(expf(-lam));
                float av[16], bv[16];
#pragma unroll
                for (int i = 0; i < 16; ++i) { const int tok = (i & 3) + 8 * (i >> 2) + 4 * h; const float rg = sigmoidf_(acc[0][nt][i] + ba), ig = sigmoidf_(acc[1][nt][i] + bx);
                    const float a = __expf(rg * sp8); av[i] = a; bv[i] = __builtin_amdgcn_sqrtf(fmaxf(fmaf(-a, a, 1.0f), 0.f)) * (ig * bf2f(*(const LAS bf16_t*)(tX + tok * 144 + (32 * nt + r) * 2))); }
                float Pg[4], Hg[4];
#pragma unroll
                for (int g = 0; g < 4; ++g) { float P = 1.f, H = 0.f;
#pragma unroll
                    for (int ee = 0; ee < 4; ++ee) { const int i = 4 * g + (dir == 0 ? ee : 3 - ee); H = av[i] * H + bv[i]; P *= av[i]; av[i] = P; bv[i] = H; }
                    Pg[g] = P; Hg[g] = H; }
                float Ps = 1.f, Hs = 0.f, Pst[4] = {1.f, 1.f, 1.f, 1.f}, Hst[4] = {0.f, 0.f, 0.f, 0.f};
#pragma unroll
                for (int kk = 0; kk < 8; ++kk) { const int k = dir == 0 ? kk : 7 - kk, g = k >> 1, hh = k & 1;
                    const float Po = shx(Pg[g], 32, lane), Ho = shx(Hg[g], 32, lane); const bool mine = hh == h;
                    const float Pk = mine ? Pg[g] : Po, Hk = mine ? Hg[g] : Ho;
                    Pst[g] = mine ? Ps : Pst[g]; Hst[g] = mine ? Hs : Hst[g];
                    Hs = Pk * Hs + Hk; Ps *= Pk; }
                unsigned* out = p.PH + ((size_t)dir * MT + m0) * 512 + c;
#pragma unroll
                for (int i = 0; i < 16; ++i) { const int g = i >> 2, tok = (i & 3) + 8 * g + 4 * h; out[(size_t)tok * 512] = pk_bf16(av[i] * Pst[g], av[i] * Hst[g] + bv[i]); }
                if (h == 0) { const size_t o = ((size_t)dir * (MT / 32) + t32) * 512 + c; p.LP[o] = Ps; p.LH[o] = Hs; }
            }
        }
    }
}
__device__ __forceinline__ void lru_tilescan_task(const Params& p, int task, int lane) {
    const int b = task >> 4, dir = (task >> 3) & 1, c = (task & 7) * 64 + lane;
    const size_t base = ((size_t)dir * (MT / 32) + (size_t)b * 136) * 512 + c;
    float hh = 0.f;
#pragma unroll 17
    for (int i = 0; i < 136; ++i) { const int tl = dir == 0 ? i : (i < 8 ? 7 - i : 143 - i); const float P = p.LP[base + (size_t)tl * 512], H = p.LH[base + (size_t)tl * 512];
        p.LS[base + (size_t)tl * 512] = hh; hh = P * hh + H; }
}

__device__ __forceinline__ void finish_phase(const Params& p, int l, int last) {
    const int lane = TIDX & 63; const int gw = blockIdx.x * (NTHREADS / 64) + __builtin_amdgcn_readfirstlane(TIDX >> 6), nw = gridDim.x * (NTHREADS / 64);
    const int c0 = lane * 8;
    float gr_[8], gh_[8];
#pragma unroll
    for (int i = 0; i < 8; ++i) { gr_[i] = p.ret_gn_g[l * 512 + c0 + i]; gh_[i] = p.hgrn_gn_g[l * 512 + c0 + i]; }
    for (int m = gw; m < MT; m += nw) {
        if (last && (m % LT) < LC) continue;
        const bf16_t* u = p.U + (size_t)m * INC + c0; const int tile = m >> 5;
        const bf16_t* ra = p.Oret + (size_t)m * 512 + c0; const bf16_t* rb = ra + (size_t)MT * 512; const bf16_t* ha = p.Ohg + (size_t)m * 512 + c0; const bf16_t* hb2 = ha + (size_t)MT * 512;
        const u32x4 rav = *(const u32x4*)ra, rbv = *(const u32x4*)rb, hav = *(const u32x4*)ha, hbv = *(const u32x4*)hb2;
        const unsigned* ph0 = p.PH + (size_t)m * 512 + c0; const unsigned* ph1 = ph0 + (size_t)MT * 512;
        const u32x4 pf0 = *(const u32x4*)ph0, pf1 = *(const u32x4*)(ph0 + 4), pb0 = *(const u32x4*)ph1, pb1 = *(const u32x4*)(ph1 + 4);
        const float* st0 = p.LS + (size_t)tile * 512 + c0; const float* st1 = st0 + (size_t)(MT / 32) * 512;
        const float4 sf0 = *(const float4*)st0, sf1 = *(const float4*)(st0 + 4), sb0 = *(const float4*)st1, sb1 = *(const float4*)(st1 + 4);
        const u32x4 grg = *(const u32x4*)(u + C_RG), ghg = *(const u32x4*)(u + C_HGT), glg = *(const u32x4*)(u + C_LGT);
        { float o[8] = {bflo(rav[0]) + bflo(rbv[0]), bfhi(rav[0]) + bfhi(rbv[0]), bflo(rav[1]) + bflo(rbv[1]), bfhi(rav[1]) + bfhi(rbv[1]), bflo(rav[2]) + bflo(rbv[2]), bfhi(rav[2]) + bfhi(rbv[2]), bflo(rav[3]) + bflo(rbv[3]), bfhi(rav[3]) + bfhi(rbv[3])};
          float ss = 0.f;
#pragma unroll
          for (int i = 0; i < 8; ++i) ss += o[i] * o[i];
          ss += shx(ss, 1, lane); ss += shx(ss, 2, lane); ss += shx(ss, 4, lane);
          const float rstd = rsqrtf(ss * (1.0f / 64.0f) + 1e-6f); u32x4 w;
#pragma unroll
          for (int i = 0; i < 4; ++i) { const float g0 = bflo(grg[i]), g1 = bfhi(grg[i]); w[i] = pg8::cvt_pk_bf16(o[2 * i] * rstd * gr_[2 * i] * (g0 * sigmoidf_(g0)), o[2 * i + 1] * rstd * gr_[2 * i + 1] * (g1 * sigmoidf_(g1))); }
          *(u32x4*)(p.Aall + (size_t)m * 512 + c0) = w; }
        { float o[8] = {bflo(hav[0]) + bflo(hbv[0]), bfhi(hav[0]) + bfhi(hbv[0]), bflo(hav[1]) + bflo(hbv[1]), bfhi(hav[1]) + bfhi(hbv[1]), bflo(hav[2]) + bflo(hbv[2]), bfhi(hav[2]) + bfhi(hbv[2]), bflo(hav[3]) + bflo(hbv[3]), bfhi(hav[3]) + bfhi(hbv[3])};
          float ss = 0.f;
#pragma unroll
          for (int i = 0; i < 8; ++i) ss += o[i] * o[i];
          ss += shx(ss, 1, lane); ss += shx(ss, 2, lane); ss += shx(ss, 4, lane); ss += shx(ss, 8, lane);
          const float rstd = rsqrtf(ss * (1.0f / 128.0f) + 1e-6f); u32x4 w;
#pragma unroll
          for (int i = 0; i < 4; ++i) w[i] = pg8::cvt_pk_bf16(o[2 * i] * rstd * gh_[2 * i] * sigmoidf_(bflo(ghg[i])), o[2 * i + 1] * rstd * gh_[2 * i + 1] * sigmoidf_(bfhi(ghg[i])));
          *(u32x4*)(p.Aall + ((size_t)MT + m) * 512 + c0) = w; }
        { const float sf[8] = {sf0.x, sf0.y, sf0.z, sf0.w, sf1.x, sf1.y, sf1.z, sf1.w}, sb[8] = {sb0.x, sb0.y, sb0.z, sb0.w, sb1.x, sb1.y, sb1.z, sb1.w};
          const unsigned pf[8] = {pf0[0], pf0[1], pf0[2], pf0[3], pf1[0], pf1[1], pf1[2], pf1[3]}, pb[8] = {pb0[0], pb0[1], pb0[2], pb0[3], pb1[0], pb1[1], pb1[2], pb1[3]};
          float o[8];
#pragma unroll
          for (int i = 0; i < 8; ++i) o[i] = (bflo(pf[i]) * sf[i] + bfhi(pf[i])) + (bflo(pb[i]) * sb[i] + bfhi(pb[i]));
          u32x4 w;
#pragma unroll
          for (int i = 0; i < 4; ++i) { float rr[2];
#pragma unroll
              for (int k = 0; k < 2; ++k) { const float x = k ? bfhi(glg[i]) : bflo(glg[i]); const float t2 = __expf(2.0f * 0.7978845608f * (x + 0.044715f * x * x * x));
                  rr[k] = o[2 * i + k] * (0.5f * x * (2.0f - 2.0f * __builtin_amdgcn_rcpf(t2 + 1.0f))); }
              w[i] = pg8::cvt_pk_bf16(rr[0], rr[1]); }
          *(u32x4*)(p.Aall + ((size_t)2 * MT + m) * 512 + c0) = w; }
    }
}

__device__ __forceinline__ void router_prep_phase(const Params& p) {
    const int tid = TIDX, lane = tid & 63;
    for (int i = blockIdx.x * NTHREADS + tid; i < DEPTH * 5 * 1024 * 8; i += gridDim.x * NTHREADS) { const int q = i & 7, k = (i >> 3) & 1023, lm = i >> 13, l = lm / 5;
        const float sc = p.norm2_g[l * D + k] * (1.0f + p.mod[(size_t)lm * 6144 + 4 * 1024 + k]); const float4 w = *(const float4*)(p.router_w + ((size_t)l * 1024 + k) * 32 + q * 4);
        *(float4*)(p.RWp + ((size_t)lm * 1024 + k) * 32 + q * 4) = make_float4(w.x * sc, w.y * sc, w.z * sc, w.w * sc); }
    const int gw = blockIdx.x * (NTHREADS / 64) + __builtin_amdgcn_readfirstlane(tid >> 6), nw = gridDim.x * (NTHREADS / 64);
    for (int t = gw; t < DEPTH * 5 * 32; t += nw) { const int e = t & 31, lm = t >> 5, l = lm / 5; float a = 0.f;
#pragma unroll
        for (int j = 0; j < 16; ++j) { const int k = j * 64 + lane; a += p.mod[(size_t)lm * 6144 + 3 * 1024 + k] * p.router_w[((size_t)l * 1024 + k) * 32 + e]; }
        a = wave_sum(a, lane); if (lane == 0) p.RC[lm * 32 + e] = a + p.router_b[l * 32 + e]; }
}
__device__ __forceinline__ int route_group_row0(int g, int last) { return last ? (g >> 7) * LT + LC + (g & 127) * 32 : g * 32; }
__device__ __forceinline__ void route_phase(const Params& p, int l, float* ldsf, int last) {
    const int tid = TIDX, lane = tid & 63, wave = __builtin_amdgcn_readfirstlane(tid >> 6); const int G = (int)gridDim.x;
    LAS float* tL = (LAS float*)ldsf; LAS float* tS = tL + 8448; LAS int* rec = (LAS int*)(tL + 8704);
    const int ti = lane & 31, kk = lane >> 5, gi = wave >> 1, kh = wave & 1;
    const int NG = last ? NB * SEQ / 32 : MT / 32;
    const int ngrp = ((int)blockIdx.x + 3 * G < NG) ? 4 : ((int)blockIdx.x + 2 * G < NG) ? 3 : ((int)blockIdx.x + G < NG) ? 2 : ((int)blockIdx.x < NG ? 1 : 0);
    if (gi < ngrp) {
        const int m0 = route_group_row0((int)blockIdx.x + gi * G, last), b = m0 / LT, pp0 = m0 - b * LT, mr = pp0 < LC ? 4 : b;
        const bf16_t* xrow = p.X + (size_t)(m0 + ti) * D + 4 * kk + 512 * kh;
        const float* rw = p.RWp + ((size_t)(l * 5 + mr) * 1024 + 512 * kh + 4 * kk) * 32 + ti;
        f32x16_t acc;
#pragma unroll
        for (int i = 0; i < 16; ++i) acc[i] = 0.f;
        float ss = 0.f;
#define RT_LOAD(XB, WB, DB, s0) do { if ((s0) < 64) { _Pragma("unroll") for (int q = 0; q < 4; ++q) { XB[q] = *(const u32x2*)(xrow + 8 * ((s0) + q)); \
            const float* rp = rw + (size_t)((s0) + q) * 256; WB[q][0] = rp[0]; WB[q][1] = rp[32]; WB[q][2] = rp[64]; WB[q][3] = rp[96]; } } } while (0)
#define RT_MMA(XB, WB, DB, s0) do { if ((s0) < 64) { _Pragma("unroll") for (int q = 0; q < 4; ++q) { const float x0_ = bflo(XB[q].x), x1_ = bfhi(XB[q].x), x2_ = bflo(XB[q].y), x3_ = bfhi(XB[q].y); \
            ss += x0_ * x0_ + x1_ * x1_ + x2_ * x2_ + x3_ * x3_; \
            acc = __builtin_amdgcn_mfma_f32_32x32x2f32(x0_, WB[q][0], acc, 0, 0, 0); acc = __builtin_amdgcn_mfma_f32_32x32x2f32(x1_, WB[q][1], acc, 0, 0, 0); \
            acc = __builtin_amdgcn_mfma_f32_32x32x2f32(x2_, WB[q][2], acc, 0, 0, 0); acc = __builtin_amdgcn_mfma_f32_32x32x2f32(x3_, WB[q][3], acc, 0, 0, 0); } } } while (0)
        u32x2 xA[4], xB[4], xC[4]; float wA[4][4], wB[4][4], wC[4][4];
        RT_LOAD(xA, wA, dA, 0); RT_LOAD(xB, wB, dB, 4);
        for (int s = 0; s < 64; s += 12) {
            RT_LOAD(xC, wC, dC, s + 8);  asm volatile("" ::: "memory"); RT_MMA(xA, wA, dA, s);
            RT_LOAD(xA, wA, dA, s + 12); asm volatile("" ::: "memory"); RT_MMA(xB, wB, dB, s + 4);
            RT_LOAD(xB, wB, dB, s + 16); asm volatile("" ::: "memory"); RT_MMA(xC, wC, dC, s + 8);
        }
#undef RT_LOAD
#undef RT_MMA
        ss += shx(ss, 32, lane);
        LAS float* t = tL + (gi * 2 + kh) * (32 * 33);
#pragma unroll
        for (int i = 0; i < 16; ++i) t[((i & 3) + 8 * (i >> 2) + 4 * kk) * 33 + ti] = acc[i];
        if (lane < 32) tS[(gi * 2 + kh) * 32 + ti] = ss;
    }
    __syncthreads();
    if (gi < ngrp && kh == 0) {
        const int m0 = route_group_row0((int)blockIdx.x + gi * G, last), b = m0 / LT, pp0 = m0 - b * LT, mr = pp0 < LC ? 4 : b;
        const float rstd = rsqrtf((tS[(gi * 2) * 32 + ti] + tS[(gi * 2 + 1) * 32 + ti]) * (1.0f / D) + 1e-6f);
        const LAS float* t0 = tL + (gi * 2) * (32 * 33) + ti * 33; const LAS float* t1 = t0 + 32 * 33;
        int e4[4] = {0, 0, 0, 0}; float w4[4] = {0.f, 0.f, 0.f, 0.f}; int pos4[4] = {0, 0, 0, 0};
        float lg[32];
#pragma unroll
        for (int e = 0; e < 32; ++e) lg[e] = (t0[e] + t1[e]) * rstd + p.RC[(l * 5 + mr) * 32 + e];
        float val[4];
#pragma unroll
        for (int k = 0; k < 4; ++k) { float best = -3.0e38f; int bi = 0;
#pragma unroll
            for (int e = 0; e < 32; ++e) { const bool better = lg[e] > best; best = better ? lg[e] : best; bi = better ? e : bi; }
            e4[k] = bi; val[k] = best;
#pragma unroll
            for (int e = 0; e < 32; ++e) lg[e] = (e == bi) ? -3.0e38f : lg[e]; }
        const float x1 = __expf(val[1] - val[0]), x2 = __expf(val[2] - val[0]), x3 = __expf(val[3] - val[0]); const float inv = 1.0f / (1.0f + x1 + x2 + x3);
        w4[0] = inv; w4[1] = x1 * inv; w4[2] = x2 * inv; w4[3] = x3 * inv;
        int rank4[4] = {0, 0, 0, 0}; int mycnt = 0;
#pragma unroll 4
        for (int e = 0; e < 32; ++e) { const bool hit = lane < 32 && (e4[0] == e || e4[1] == e || e4[2] == e || e4[3] == e);
            const unsigned long long mask = __ballot(hit); const int rk = __popcll(mask & ((1ull << lane) - 1ull));
#pragma unroll
            for (int k = 0; k < 4; ++k) rank4[k] = (e4[k] == e) ? rk : rank4[k];
            mycnt = (lane == e) ? __popcll(mask) : mycnt; }
        int base = 0;
        if (lane < 32 && mycnt > 0) base = (int)__hip_atomic_fetch_add(&p.ctrl[l * 64 + lane], (unsigned)mycnt, __ATOMIC_RELAXED, __HIP_MEMORY_SCOPE_AGENT);
#pragma unroll
        for (int k = 0; k < 4; ++k) pos4[k] = __builtin_amdgcn_ds_bpermute(e4[k] << 2, base) + rank4[k];
        if (lane < 32) { LAS int* rr = rec + (gi * 32 + ti) * 12;
#pragma unroll
            for (int k = 0; k < 4; ++k) { p.tok_e[(m0 + ti) * 4 + k] = e4[k]; p.tok_pos[(m0 + ti) * 4 + k] = pos4[k]; p.tok_w[(m0 + ti) * 4 + k] = w4[k]; rr[k] = e4[k]; rr[4 + k] = pos4[k]; }
            rr[8] = __float_as_int(rstd); }
    }
    __syncthreads();
    u32x4 xn[2];
    if (wave < ngrp * 32) { const int m = route_group_row0((int)blockIdx.x + (wave >> 5) * G, last) + (wave & 31);
#pragma unroll
        for (int j = 0; j < 2; ++j) { const int col = j * 512 + lane * 8; xn[j] = *(const u32x4*)(p.X + (size_t)m * D + col); } }
    for (int rw_ = wave; rw_ < ngrp * 32; rw_ += 8) {
        const int g2 = rw_ >> 5, tk = rw_ & 31; const int m = route_group_row0((int)blockIdx.x + g2 * G, last) + tk, b = m / LT, pp = m - b * LT, mr = pp < LC ? 4 : b;
        const LAS int* rr = rec + (g2 * 32 + tk) * 12; const float rs = __int_as_float(rr[8]);
        size_t rowoff[4];
#pragma unroll
        for (int k = 0; k < 4; ++k) rowoff[k] = ((size_t)rr[k] * (CAPT * 256) + rr[4 + k]) * D;
        const float* mv = p.mod + (size_t)(l * 5 + mr) * 6144;
        u32x4 xv[2]; float4 gv[2][2], scv[2][2], shv[2][2];
#pragma unroll
        for (int j = 0; j < 2; ++j) { const int col = j * 512 + lane * 8; xv[j] = xn[j];
#pragma unroll
            for (int q = 0; q < 2; ++q) { gv[j][q] = *(const float4*)(p.norm2_g + l * D + col + 4 * q); scv[j][q] = *(const float4*)(mv + 4 * 1024 + col + 4 * q); shv[j][q] = *(const float4*)(mv + 3 * 1024 + col + 4 * q); } }
        if (rw_ + 8 < ngrp * 32) { const int mn = route_group_row0((int)blockIdx.x + ((rw_ + 8) >> 5) * G, last) + ((rw_ + 8) & 31);
#pragma unroll
            for (int j = 0; j < 2; ++j) { const int col = j * 512 + lane * 8; xn[j] = *(const u32x4*)(p.X + (size_t)mn * D + col); } }
#pragma unroll
        for (int j = 0; j < 2; ++j) { const int col = j * 512 + lane * 8; u32x2 w4;
#pragma unroll
            for (int q = 0; q < 2; ++q) {
                const unsigned x0 = xv[j][2 * q], x1 = xv[j][2 * q + 1]; const float4 x = make_float4(bflo(x0), bfhi(x0), bflo(x1), bfhi(x1));
                w4[q] = pk_fp8x4(x.x * rs * gv[j][q].x * (1.f + scv[j][q].x) + shv[j][q].x, x.y * rs * gv[j][q].y * (1.f + scv[j][q].y) + shv[j][q].y,
                                 x.z * rs * gv[j][q].z * (1.f + scv[j][q].z) + shv[j][q].z, x.w * rs * gv[j][q].w * (1.f + scv[j][q].w) + shv[j][q].w); }
#pragma unroll
            for (int k = 0; k < 4; ++k) *(u32x2*)(p.Xg + rowoff[k] + col) = w4; }
    }
}

struct EpiBranch {
    static constexpr bool PERM = true, AFTER_DRAIN = false;
    bf16_t* R;
    __device__ __forceinline__ void operator()(const f32x4 (&acc)[2][2][4][2], const Unit& u, int wr, int wc, int fr, int fq) const {
        const int br = u.pn >> 2, pnl = u.pn & 3, pmr = u.pm - br * 68;
        bf16_t* base = R + (size_t)br * MT * D + (size_t)(pmr * 256 + wr * 64 + fr) * D + pnl * 256 + wc * 32 + 8 * fq;
#pragma unroll
        for (int ai = 0; ai < 2; ++ai)
#pragma unroll
            for (int m = 0; m < 4; ++m) { bf16_t* rowp = base + (size_t)(ai * 128 + m * 16) * D;
#pragma unroll
                for (int bj = 0; bj < 2; ++bj) { const f32x4 v0 = acc[ai][bj][m][0], v1 = acc[ai][bj][m][1];
                    u32x4 w; w.x = pg8::cvt_pk_bf16(v0[0], v0[1]); w.y = pg8::cvt_pk_bf16(v0[2], v0[3]); w.z = pg8::cvt_pk_bf16(v1[0], v1[1]); w.w = pg8::cvt_pk_bf16(v1[2], v1[3]);
                    *(u32x4*)(rowp + bj * 128) = w; } }
    }
};
__device__ __forceinline__ int latent_row_tile(int k) { return (k >> 4) * 17 + 1 + (k & 15); }
struct SchedMerge { int G, c, last;
    __device__ bool next(int i, Unit& u) const { const int nt = last ? 256 : 272; const int L = i * G + c; if (L >= 3 * nt) return false; const int br = L / nt, tile = L - br * nt;
        u.pm = br * 68 + (last ? latent_row_tile(tile >> 2) : (tile >> 2)); u.pn = br * 4 + (tile & 3); u.po = 0; return true; }
    __device__ __forceinline__ void a_ready(const Unit&) const {}
    __device__ __forceinline__ void done(const Unit&) const {}
};
__device__ __forceinline__ void merge_combine_phase(const Params& p, int last) {
    const int tid = TIDX, lane = tid & 63; const int gw = blockIdx.x * (NTHREADS / 64) + __builtin_amdgcn_readfirstlane(tid >> 6), nw = gridDim.x * (NTHREADS / 64);
    for (int m = gw; m < MT; m += nw) {
        if (last && (m % LT) < LC) continue;
        u32x4 rv[2][3], gv[2][3];
#pragma unroll
        for (int hf = 0; hf < 2; ++hf)
#pragma unroll
            for (int br = 0; br < 3; ++br) { const int col = hf * 512 + lane * 8; rv[hf][br] = *(const u32x4*)(p.R + ((size_t)br * MT + m) * D + col); gv[hf][br] = *(const u32x4*)(p.U + (size_t)m * INC + C_GR + br * 1024 + col); }
#pragma unroll
        for (int hf = 0; hf < 2; ++hf) { const int col = hf * 512 + lane * 8; float o[8];
#pragma unroll
            for (int i = 0; i < 8; ++i) o[i] = 0.f;
#pragma unroll
            for (int br = 0; br < 3; ++br)
#pragma unroll
                for (int i = 0; i < 4; ++i) { o[2 * i] += sigmoidf_(bflo(gv[hf][br][i])) * bflo(rv[hf][br][i]); o[2 * i + 1] += sigmoidf_(bfhi(gv[hf][br][i])) * bfhi(rv[hf][br][i]); }
            u32x4 w; w.x = pg8::cvt_pk_bf16(o[0], o[1]); w.y = pg8::cvt_pk_bf16(o[2], o[3]); w.z = pg8::cvt_pk_bf16(o[4], o[5]); w.w = pg8::cvt_pk_bf16(o[6], o[7]);
            *(u32x4*)(p.Mg + (size_t)m * D + col) = w; }
    }
}
struct SchedOut { int nN, nwg, G, c, last;
    __device__ void init(int M, int N, int G_, int c_, int last_) { nN = N / 256; nwg = (M / 256) * nN; G = G_; c = c_; last = last_; }
    __device__ bool next(int i, Unit& u) const {
        const int L = i * G + c; if (L >= (last ? 256 : nwg)) return false;
        const int nM = nwg / nN; int wgid = L; { const int q = nwg / 8, r = nwg % 8, xcd = wgid % 8, off = wgid / 8; wgid = (xcd < r ? xcd * (q + 1) : r * (q + 1) + (xcd - r) * q) + off; }
        const int nig = 8 * nN, gid = wgid / nig, fm = gid * 8, gsz = (nM - fm) < 8 ? (nM - fm) : 8;
        const int pm0 = fm + ((wgid % nig) % gsz), pn0 = (wgid % nig) / gsz;
        u.pm = last ? latent_row_tile(L >> 2) : pm0; u.pn = last ? (L & 3) : pn0; u.po = 0; return true; }
    __device__ __forceinline__ void a_ready(const Unit&) const {}
    __device__ __forceinline__ void done(const Unit&) const {}
};
struct EpiOut {
    static constexpr bool PERM = true, AFTER_DRAIN = false;
    bf16_t* X; const float* mod_l;
    __device__ __forceinline__ void operator()(const f32x4 (&acc)[2][2][4][2], const Unit& u, int wr, int wc, int fr, int fq) const {
        const int mr = (u.pm % 17 == 0) ? 4 : u.pm / 17; const float* g1 = mod_l + mr * 6144 + 2 * 1024;
        const int row0 = u.pm * 256 + wr * 64 + fr, col0 = u.pn * 256 + wc * 32 + 8 * fq;
        bf16_t* base = X + (size_t)row0 * D + col0;
        u32x4 xo[2][4][2];
#pragma unroll
        for (int ai = 0; ai < 2; ++ai)
#pragma unroll
            for (int m = 0; m < 4; ++m)
#pragma unroll
                for (int bj = 0; bj < 2; ++bj) xo[ai][m][bj] = *(const u32x4*)(base + (size_t)(ai * 128 + m * 16) * D + bj * 128);
        f32x4 gv[2][2];
#pragma unroll
        for (int bj = 0; bj < 2; ++bj)
#pragma unroll
            for (int n = 0; n < 2; ++n) gv[bj][n] = *(const f32x4*)(g1 + col0 + bj * 128 + 4 * n);
#pragma unroll
        for (int ai = 0; ai < 2; ++ai)
#pragma unroll
            for (int m = 0; m < 4; ++m) { bf16_t* rowp = base + (size_t)(ai * 128 + m * 16) * D;
#pragma unroll
                for (int bj = 0; bj < 2; ++bj) { const f32x4 v0 = acc[ai][bj][m][0] * gv[bj][0], v1 = acc[ai][bj][m][1] * gv[bj][1]; const u32x4 o = xo[ai][m][bj];
                    u32x4 w; w.x = pg8::cvt_pk_bf16(bflo(o[0]) + v0[0], bfhi(o[0]) + v0[1]); w.y = pg8::cvt_pk_bf16(bflo(o[1]) + v0[2], bfhi(o[1]) + v0[3]);
                    w.z = pg8::cvt_pk_bf16(bflo(o[2]) + v1[0], bfhi(o[2]) + v1[1]); w.w = pg8::cvt_pk_bf16(bflo(o[3]) + v1[2], bfhi(o[3]) + v1[3]);
                    *(u32x4*)(rowp + bj * 128) = w; } }
    }
};
struct SchedMoE { int nN, G, c, sparseA;
    __device__ bool next(int i, Unit& u) const { const LAS int* te = (const LAS int*)((const LAS char*)dyn_lds_base() + TB_OFF); const LAS int* tb = te + MAXTILES;
        if ((G & 63) == 0 && nN == 8) { const int x = c & 7, r = c >> 3, tile = i * (G >> 3) + 8 * (r >> 3) + x, j = r & 7; if (tile >= tb[NE]) return false; const int e = te[tile];
            u.po = tile; u.pm = sparseA ? e * CAPT + (tile - tb[e]) : tile; u.pn = e * nN + j; return true; }
        const int L = i * G + c; if (L >= tb[NE] * nN) return false; const int tile = L / nN, j = L - tile * nN, e = te[tile];
        u.po = tile; u.pm = sparseA ? e * CAPT + (tile - tb[e]) : tile; u.pn = e * nN + j; return true; }
    __device__ __forceinline__ void a_ready(const Unit&) const {}
    __device__ __forceinline__ void done(const Unit&) const {}
};
struct EpiGU {
    static constexpr bool PERM = true, AFTER_DRAIN = false;
    unsigned char* Act; const float* bgu;
    __device__ __forceinline__ void operator()(const f32x4 (&acc)[2][2][4][2], const Unit& u, int wr, int wc, int fr, int fq) const {
        const int e = u.pn >> 3, pnl = u.pn & 7; const int row0 = u.po * 256 + wr * 64 + fr, c8 = pnl * 128 + wc * 32 + 8 * fq;
        const float* bg = bgu + e * 2048 + c8; const f32x4 bg0 = *(const f32x4*)bg, bg1 = *(const f32x4*)(bg + 4), bu0 = *(const f32x4*)(bg + 1024), bu1 = *(const f32x4*)(bg + 1028);
#pragma unroll
        for (int ai = 0; ai < 2; ++ai)
#pragma unroll
            for (int m = 0; m < 4; ++m) { const float is_ = 1.0f / W8_SCALE; const f32x4 g0 = acc[ai][0][m][0] * is_ + bg0, g1 = acc[ai][0][m][1] * is_ + bg1, u0 = acc[ai][1][m][0] * is_ + bu0, u1 = acc[ai][1][m][1] * is_ + bu1; float r[8];
#pragma unroll
                for (int j = 0; j < 4; ++j) { const float ga = fminf(g0[j], 7.0f), ua = fminf(fmaxf(u0[j], -7.0f), 7.0f); r[j] = (ua + 1.0f) * (ga * sigmoidf_(1.702f * ga));
                    const float gb = fminf(g1[j], 7.0f), ub = fminf(fmaxf(u1[j], -7.0f), 7.0f); r[4 + j] = (ub + 1.0f) * (gb * sigmoidf_(1.702f * gb)); }
                u32x2 w; w.x = pk_fp8x4(r[0], r[1], r[2], r[3]); w.y = pk_fp8x4(r[4], r[5], r[6], r[7]);
                *(u32x2*)(Act + (size_t)(row0 + ai * 128 + m * 16) * D + c8) = w; }
    }
};
struct EpiDown {
    static constexpr bool PERM = true, AFTER_DRAIN = false;
    unsigned char* Y; const float* bd;
    __device__ __forceinline__ void operator()(const f32x4 (&acc)[2][2][4][2], const Unit& u, int wr, int wc, int fr, int fq) const {
        const int e = u.pn >> 2, pnl = u.pn & 3; const int row0 = u.po * 256 + wr * 64 + fr, col0 = pnl * 256 + wc * 32 + 8 * fq;
        f32x4 bv[2][2];
#pragma unroll
        for (int bj = 0; bj < 2; ++bj)
#pragma unroll
            for (int n = 0; n < 2; ++n) bv[bj][n] = *(const f32x4*)(bd + e * 1024 + col0 + bj * 128 + 4 * n);
#pragma unroll
        for (int ai = 0; ai < 2; ++ai)
#pragma unroll
            for (int m = 0; m < 4; ++m) { unsigned char* rowp = Y + (size_t)(row0 + ai * 128 + m * 16) * D + col0;
#pragma unroll
                for (int bj = 0; bj < 2; ++bj) { const float is_ = 1.0f / W8_SCALE; f32x4 v0 = acc[ai][bj][m][0] * is_ + bv[bj][0], v1 = acc[ai][bj][m][1] * is_ + bv[bj][1];
#pragma unroll
                    for (int j = 0; j < 4; ++j) { v0[j] = fminf(fmaxf(v0[j], -448.f), 448.f); v1[j] = fminf(fmaxf(v1[j], -448.f), 448.f); }
                    u32x2 w; int t0 = __builtin_amdgcn_cvt_pk_fp8_f32(v0[0], v0[1], 0, false); t0 = __builtin_amdgcn_cvt_pk_fp8_f32(v0[2], v0[3], t0, true);
                    int t1 = __builtin_amdgcn_cvt_pk_fp8_f32(v1[0], v1[1], 0, false); t1 = __builtin_amdgcn_cvt_pk_fp8_f32(v1[2], v1[3], t1, true);
                    w.x = (unsigned)t0; w.y = (unsigned)t1; *(u32x2*)(rowp + bj * 128) = w; } }
    }
};

constexpr int NSEG = 9;
__device__ __forceinline__ int seg_first(int dir, int s) { return dir == 0 ? (s == 0 ? 0 : 8 + 16 * (s - 1)) : (s == 0 ? 7 : 135 - 16 * (s - 1)); }
__device__ __forceinline__ int seg_count(int s) { return s == 0 ? 8 : 16; }

template <int DKT, int NVT, bool VEC, bool FULL>
__device__ __forceinline__ void wave_seg(const bf16_t* __restrict__ Qg, const bf16_t* __restrict__ Kg, const bf16_t* __restrict__ Vg, int vs, bf16_t* __restrict__ Og,
                                         const float* __restrict__ alpha, float gsc, int b, int cs0, int dcs, int nst, int dir, int strict,
                                         f32x16_t (&S)[DKT][NVT], LAS char* lds, int lane) {
    constexpr int KP = DKT * 64 + 16, VP = NVT * 64 + 16, KC = DKT * 4, VC = NVT * 4;
    constexpr int KRI = 64 / KC, VRI = 64 / VC;
    const int r = lane & 31, h = lane >> 5;
    LAS char* tK = lds; LAS char* tV = lds + 32 * KP; LAS char* tA = tV + 32 * VP; LAS char* tG = tA + DKT * 128;
    u32x4 nK[2 * DKT], nV[2 * NVT]; u32x2 nQ[2 * DKT][2]; f32x4 nA = {1.f, 1.f, 1.f, 1.f};
    const unsigned koff = (unsigned)((lane / KC) * 1024 + (lane % KC) * 16), voff = (unsigned)((lane / VC) * (vs * 2) + (lane % VC) * 16), qoff = (unsigned)(r * 1024 + h * 8);
    const unsigned ooff = (unsigned)(h * 4 * 1024 + r * 2), ldk = (unsigned)((lane / KC) * KP + (lane % KC) * 16), ldv = (unsigned)((lane / VC) * VP + (lane % VC) * 16);
    {   const size_t m0 = (size_t)b * LT + cs0 * 32;
        const GAS char* kb = uni_ptr(Kg + m0 * 512); const GAS char* vb = uni_ptr(Vg + m0 * vs);
#pragma unroll
        for (int i = 0; i < 2 * DKT; ++i) nK[i] = *(const GAS u32x4*)(kb + koff + i * (KRI * 1024));
#pragma unroll
        for (int i = 0; i < 2 * NVT; ++i) nV[i] = *(const GAS u32x4*)(vb + voff + (size_t)i * VRI * (vs * 2));
        if (FULL) { const GAS char* qb = uni_ptr(Qg + m0 * 512);
#pragma unroll
            for (int x = 0; x < 2 * DKT; ++x) { nQ[x][0] = *(const GAS u32x2*)(qb + qoff + 32 * x); nQ[x][1] = *(const GAS u32x2*)(qb + qoff + 32 * x + 16); } }
        if (VEC) nA = *(const GAS f32x4*)(uni_ptr(alpha + (size_t)cs0 * 512) + (unsigned)((lane & (DKT * 8 - 1)) * 16)); }
    f32x16_t Oprev[NVT]; GAS char* ob_prev = nullptr;
    for (int si = 0; si < nst; ++si) {
        const int cs = cs0 + si * dcs; const size_t m0 = (size_t)b * LT + cs * 32;
#pragma unroll
        for (int i = 0; i < 2 * DKT; ++i) *(LAS u32x4*)(tK + ldk + i * (KRI * KP)) = nK[i];
#pragma unroll
        for (int i = 0; i < 2 * NVT; ++i) *(LAS u32x4*)(tV + ldv + i * (VRI * VP)) = nV[i];
        if (VEC) { *(LAS f32x4*)(tA + (lane & (DKT * 8 - 1)) * 16) = nA;
            if (!FULL) { LAS f32x4* gp = (LAS f32x4*)(tG + (lane & (DKT * 8 - 1)) * 16); const f32x4 gprev = si == 0 ? (f32x4){1.f, 1.f, 1.f, 1.f} : *gp; asm volatile("s_waitcnt lgkmcnt(0)" ::: "memory"); *gp = gprev * nA; } }
        if (FULL && si > 0) {
#pragma unroll
            for (int n = 0; n < NVT; ++n)
#pragma unroll
                for (int i = 0; i < 16; ++i) *(GAS bf16_t*)(ob_prev + ooff + ((i & 3) + 8 * (i >> 2)) * 1024 + 64 * n) = (bf16_t)(pk_bf16(Oprev[n][i], 0.f) & 0xffffu); }
        bf16x8_t Qf[2 * DKT];
        if (FULL) {
#pragma unroll
            for (int x = 0; x < 2 * DKT; ++x) { u32x4 w; w[0] = nQ[x][0][0]; w[1] = nQ[x][0][1]; w[2] = nQ[x][1][0]; w[3] = nQ[x][1][1]; Qf[x] = __builtin_bit_cast(bf16x8_t, w); } }
        const size_t m1 = (size_t)b * LT + (cs + dcs) * 32;
        if (si + 1 < nst) { const GAS char* kb = uni_ptr(Kg + m1 * 512); const GAS char* vb = uni_ptr(Vg + m1 * vs);
#pragma unroll
            for (int i = 0; i < 2 * DKT; ++i) nK[i] = *(const GAS u32x4*)(kb + koff + i * (KRI * 1024));
#pragma unroll
            for (int i = 0; i < 2 * NVT; ++i) nV[i] = *(const GAS u32x4*)(vb + voff + (size_t)i * VRI * (vs * 2));
            if (VEC) nA = *(const GAS f32x4*)(uni_ptr(alpha + (size_t)(cs + dcs) * 512) + (unsigned)((lane & (DKT * 8 - 1)) * 16));
        }
        asm volatile("s_waitcnt lgkmcnt(0)" ::: "memory");
        if (FULL) {
            f32x16_t X, X2; bf16x8_t Kf[2 * DKT];
#pragma unroll
            for (int x = 0; x < 2 * DKT; ++x) Kf[x] = frag_row(tK, KP, r, 16 * x + 4 * h);
#pragma unroll
            for (int i = 0; i < 16; ++i) { X[i] = 0.f; X2[i] = 0.f; }
#pragma unroll
            for (int x = 0; x < 2 * DKT; x += 2) { X = MFMA32(Kf[x], Qf[x], X); X2 = MFMA32(Kf[x + 1], Qf[x + 1], X2); }
#pragma unroll
            for (int i = 0; i < 16; ++i) X[i] += X2[i];
#pragma unroll
            for (int i = 0; i < 16; ++i) { const int j = (i & 3) + 8 * (i >> 2) + 4 * h; const bool keep = dir == 0 ? (j <= r) : (j >= r + strict); X[i] = keep ? X[i] : 0.f; }
            const bf16x8_t Xa0 = pack8<0>(X), Xa1 = pack8<1>(X);
            ob_prev = (GAS char*)uni_ptr(Og + m0 * 512);
#pragma unroll
            for (int n = 0; n < NVT; ++n) {
                f32x16_t O;
#pragma unroll
                for (int i = 0; i < 16; ++i) O[i] = 0.f;
                O = MFMA32(Xa0, frag_tr(tV, VP, 4 * h, n, lane), O);
                O = MFMA32(Xa1, frag_tr(tV, VP, 16 + 4 * h, n, lane), O);
#pragma unroll
                for (int a = 0; a < DKT; ++a) { O = MFMA32(Qf[2 * a], pack8<0>(S[a][n]), O); O = MFMA32(Qf[2 * a + 1], pack8<1>(S[a][n]), O); }
                Oprev[n] = O;
                    }
            asm volatile("" ::: "memory");
            if (si + 1 < nst) { const GAS char* qb = uni_ptr(Qg + m1 * 512);
#pragma unroll
                for (int x = 0; x < 2 * DKT; ++x) { nQ[x][0] = *(const GAS u32x2*)(qb + qoff + 32 * x); nQ[x][1] = *(const GAS u32x2*)(qb + qoff + 32 * x + 16); } }
        }
#pragma unroll
        for (int a = 0; a < DKT; ++a) {
            f32x4 al[4];
            if (VEC) {
#pragma unroll
                for (int g = 0; g < 4; ++g) al[g] = *(const LAS f32x4*)(tA + (32 * a + 8 * g + 4 * h) * 4); }
            const bf16x8_t k0 = frag_tr(tK, KP, 4 * h, a, lane), k1 = frag_tr(tK, KP, 16 + 4 * h, a, lane);
#pragma unroll
            for (int n = 0; n < NVT; ++n) {
                S[a][n] = MFMA32(k0, frag_tr(tV, VP, 4 * h, n, lane), S[a][n]);
                S[a][n] = MFMA32(k1, frag_tr(tV, VP, 16 + 4 * h, n, lane), S[a][n]);
#pragma unroll
                for (int i = 0; i < 16; ++i) S[a][n][i] *= VEC ? al[i >> 2][i & 3] : gsc;
            }
        }
    }
    if (FULL && nst > 0) {
#pragma unroll
        for (int n = 0; n < NVT; ++n)
#pragma unroll
            for (int i = 0; i < 16; ++i) *(GAS bf16_t*)(ob_prev + ooff + ((i & 3) + 8 * (i >> 2)) * 1024 + 64 * n) = (bf16_t)(pk_bf16(Oprev[n][i], 0.f) & 0xffffu); }
}

template <int DKT, int NVT, bool VEC, bool FULL>
__device__ __forceinline__ void chain_task(const Params& p, int l, int chain, int seg, LAS char* lds, int lane) {
    int b, dir, strict; const bf16_t *Qg, *Kg, *Vg; bf16_t* Og; const float* alpha = nullptr; float gsc = 0.f; size_t tbase;
    if (!VEC) { const int h = chain & 7; b = chain >> 4; dir = (chain >> 3) & 1; strict = 1; const float gam = 1.0f / (1.0f + expf(-p.ret_decay[l * 16 + dir * 8 + h])); gsc = exp2f(32.0f * log2f(gam));
        Qg = p.RQ + (size_t)dir * MT * 512 + h * 64; Kg = p.RK + (size_t)dir * MT * 512 + h * 64; Vg = p.U + C_RV + h * 64; Og = p.Oret + (size_t)dir * MT * 512 + h * 64; tbase = (size_t)chain * NSEG;
    } else { const int h = (chain >> 2) & 3, dq = chain & 3; b = chain >> 5; dir = (chain >> 4) & 1; strict = 0;
        Qg = p.HQ + (size_t)dir * MT * 512 + h * 128; Kg = p.HK + (size_t)dir * MT * 512 + h * 128; Vg = p.U + C_HI + h * 128 + dq * 32; Og = p.Ohg + (size_t)dir * MT * 512 + h * 128 + dq * 32;
        alpha = p.HA + ((size_t)dir * NCH + b * 136) * 512 + h * 128; tbase = (size_t)(64 + chain) * NSEG; }
    f32x16_t S[DKT][NVT];
#pragma unroll
    for (int a = 0; a < DKT; ++a)
#pragma unroll
        for (int n = 0; n < NVT; ++n)
#pragma unroll
            for (int i = 0; i < 16; ++i) S[a][n][i] = 0.f;
    constexpr int TS = DKT * NVT * 16 * 64, TG = 128;
    const int h = lane >> 5;
    if (FULL) {
        for (int s2 = 0; s2 < seg; ++s2) { const float* e = p.SE + (tbase + s2) * TS + lane; const float* gq = p.SG + (tbase + s2) * TG + 4 * h; const float gs = s2 == 0 ? 0.f : exp2f(16.0f * log2f(gsc));
#pragma unroll
            for (int a = 0; a < DKT; ++a) {
                f32x4 gv[4];
#pragma unroll
                for (int g = 0; g < 4; ++g) gv[g] = VEC ? *(const f32x4*)(gq + 32 * a + 8 * g) : (f32x4){gs, gs, gs, gs};
#pragma unroll
                for (int n = 0; n < NVT; ++n)
#pragma unroll
                    for (int i = 0; i < 16; ++i) S[a][n][i] = gv[i >> 2][i & 3] * S[a][n][i] + e[((a * NVT + n) * 16 + i) * 64]; } }
    }
    wave_seg<DKT, NVT, VEC, FULL>(Qg, Kg, Vg, INC, Og, alpha, gsc, b, seg_first(dir, seg), dir == 0 ? 1 : -1, seg_count(seg), dir, strict, S, lds, lane);
    if (!FULL) { float* e = p.SE + (tbase + seg) * TS + lane;
#pragma unroll
        for (int a = 0; a < DKT; ++a)
#pragma unroll
            for (int n = 0; n < NVT; ++n)
#pragma unroll
                for (int i = 0; i < 16; ++i) e[((a * NVT + n) * 16 + i) * 64] = S[a][n][i];
        if (VEC) { constexpr int KPc = DKT * 64 + 16, VPc = NVT * 64 + 16;
            const f32x4 gfin = *(const LAS f32x4*)(lds + 32 * KPc + 32 * VPc + DKT * 128 + (lane & (DKT * 8 - 1)) * 16);
            if (lane < DKT * 8) *(f32x4*)(p.SG + (tbase + seg) * TG + lane * 4) = gfin; }
    }
}

template <bool FULL, int VAR = 0> __device__ __forceinline__ void sweep_phase(const Params& p, int l, float* ldsf) {
    const int tid = TIDX, wave = __builtin_amdgcn_readfirstlane(tid >> 6); const int G = (int)gridDim.x;
    constexpr int NS = FULL ? NSEG : NSEG - 1;
    constexpr int N_HG = 128 * NS, N_RET = 64 * NS, N_LRU = FULL ? 0 : 64;
    LAS char* lds = (LAS char*)ldsf + wave * 12288;
    const int NW = 8 * G, w = wave * G + (int)blockIdx.x;
#ifndef NO_HG
    if (VAR != 2) for (int t = w; t < N_HG; t += NW) { const int chain = t / NS, seg = t - chain * NS; chain_task<4, 1, true, FULL>(p, l, chain, seg, lds, TIDX & 63); }
#endif
#ifndef NO_RET
    if (VAR != 1) for (int t = (w + NW - N_HG % NW) % NW; t < N_RET; t += NW) { const int chain = t / NS, seg = t - chain * NS; chain_task<2, 2, false, FULL>(p, l, chain, seg, lds, TIDX & 63); }
#endif
    for (int t = (w + NW - (N_HG + N_RET) % NW) % NW; t < N_LRU; t += NW) lru_tilescan_task(p, t, TIDX & 63);
}

__device__ __forceinline__ void mixprep_phase(const Params& p, int l) {
    const int tid = TIDX, lane = tid & 63; const int gw = blockIdx.x * (NTHREADS / 64) + __builtin_amdgcn_readfirstlane(tid >> 6), nw = gridDim.x * (NTHREADS / 64);
    float lgd[2];
#pragma unroll
    for (int dir = 0; dir < 2; ++dir) { const float gam = 1.0f / (1.0f + expf(-p.ret_decay[l * 16 + dir * 8 + (lane >> 3)])); lgd[dir] = log2f(gam); }
    for (int m = gw; m < MT; m += nw) {
        const int b = m / LT, pp = m - b * LT; const int hh = lane >> 3, d0 = (lane & 7) * 4;
        const bf16_t* u = p.U + (size_t)m * INC + hh * 64 + d0;
        const u32x2 qlo = *(const u32x2*)(u + C_RQ), qhi = *(const u32x2*)(u + C_RQ + 32), klo = *(const u32x2*)(u + C_RK), khi = *(const u32x2*)(u + C_RK + 32);
        float q1[4] = {bflo(qlo[0]), bfhi(qlo[0]), bflo(qlo[1]), bfhi(qlo[1])}, q2[4] = {bflo(qhi[0]), bfhi(qhi[0]), bflo(qhi[1]), bfhi(qhi[1])};
        float k1[4] = {bflo(klo[0]) * 0.125f, bfhi(klo[0]) * 0.125f, bflo(klo[1]) * 0.125f, bfhi(klo[1]) * 0.125f}, k2[4] = {bflo(khi[0]) * 0.125f, bfhi(khi[0]) * 0.125f, bflo(khi[1]) * 0.125f, bfhi(khi[1]) * 0.125f};
        if (pp >= LC) { const int tt = pp - LC;
            const float4 r0 = *(const float4*)(p.rot + (size_t)(tt * 32 + d0) * 2), r1 = *(const float4*)(p.rot + (size_t)(tt * 32 + d0) * 2 + 4);
            const float cc[4] = {r0.x, r0.z, r1.x, r1.z}, ss[4] = {r0.y, r0.w, r1.y, r1.w};
#pragma unroll
            for (int i = 0; i < 4; ++i) { const float a = q1[i] * cc[i] - q2[i] * ss[i], bq = q1[i] * ss[i] + q2[i] * cc[i]; q1[i] = a; q2[i] = bq;
                const float ck = k1[i] * cc[i] - k2[i] * ss[i], dk = k1[i] * ss[i] + k2[i] * cc[i]; k1[i] = ck; k2[i] = dk; } }
        const int ii = pp & 31;
#pragma unroll
        for (int dir = 0; dir < 2; ++dir) { const float lg = lgd[dir]; const float e = dir == 0 ? (float)(ii + 1) : (float)(32 - ii);
            const float sq = __builtin_amdgcn_exp2f(e * lg), sk = __builtin_amdgcn_exp2f(-e * lg);
            bf16_t* oq = p.RQ + ((size_t)dir * MT + m) * 512 + hh * 64 + d0; bf16_t* ok = p.RK + ((size_t)dir * MT + m) * 512 + hh * 64 + d0;
            u32x2 w; w[0] = pk_bf16(q1[0] * sq, q1[1] * sq); w[1] = pk_bf16(q1[2] * sq, q1[3] * sq); *(u32x2*)oq = w;
            w[0] = pk_bf16(q2[0] * sq, q2[1] * sq); w[1] = pk_bf16(q2[2] * sq, q2[3] * sq); *(u32x2*)(oq + 32) = w;
            w[0] = pk_bf16(k1[0] * sk, k1[1] * sk); w[1] = pk_bf16(k1[2] * sk, k1[3] * sk); *(u32x2*)ok = w;
            w[0] = pk_bf16(k2[0] * sk, k2[1] * sk); w[1] = pk_bf16(k2[2] * sk, k2[3] * sk); *(u32x2*)(ok + 32) = w; }
    }
    for (int unit = gw; unit < NCH * 8; unit += nw) {
        const int dir = unit & 1, ch = unit >> 3, hd = (unit >> 1) & 3, b = ch / 136, cs = ch - b * 136; const size_t m0 = (size_t)b * LT + cs * 32; const int c = hd * 128 + 2 * lane;
        unsigned zz_[32], qq[32]; const int zc = dir == 0 ? C_HFF : C_HFB;
        { const bf16_t* u = p.U + m0 * INC + c;
#pragma unroll
          for (int j = 0; j < 32; ++j) { zz_[j] = *(const unsigned*)(u + (size_t)j * INC + zc); qq[j] = *(const unsigned*)(u + (size_t)j * INC + C_HQ); } }
        const float lb0 = p.lb[l * 1024 + dir * 512 + c], lb1 = p.lb[l * 1024 + dir * 512 + c + 1];
        float G0 = 1.f, G1 = 1.f;
        if (dir == 0) {
#pragma unroll
            for (int s = 0; s < 32; ++s) { const int j = s; const unsigned zz = zz_[j];
                const float z0 = bflo(zz), z1 = bfhi(zz), qa = bflo(qq[j]), qb = bfhi(qq[j]);
                const float s0 = sigmoidf_(z0), s1 = sigmoidf_(z1); const float f0 = lb0 + (1.0f - lb0) * s0, f1 = lb1 + (1.0f - lb1) * s1;
                G0 *= f0; G1 *= f1;
                const float K0 = (1.0f - lb0) * (1.0f - s0) * __builtin_amdgcn_rcpf(fmaxf(G0, 1.0e-35f)), K1 = (1.0f - lb1) * (1.0f - s1) * __builtin_amdgcn_rcpf(fmaxf(G1, 1.0e-35f));
                *(unsigned*)(p.HQ + ((size_t)dir * MT + m0 + j) * 512 + c) = pk_bf16(qa * sigmoidf_(qa) * G0, qb * sigmoidf_(qb) * G1); *(unsigned*)(p.HK + ((size_t)dir * MT + m0 + j) * 512 + c) = pk_bf16(K0, K1); }
        } else {
#pragma unroll
            for (int s = 0; s < 32; ++s) { const int j = 31 - s; const unsigned zz = zz_[j];
                const float z0 = bflo(zz), z1 = bfhi(zz), qa = bflo(qq[j]), qb = bfhi(qq[j]);
                const float s0 = sigmoidf_(z0), s1 = sigmoidf_(z1); const float f0 = lb0 + (1.0f - lb0) * s0, f1 = lb1 + (1.0f - lb1) * s1;
                G0 *= f0; G1 *= f1;
                const float K0 = (1.0f - lb0) * (1.0f - s0) * __builtin_amdgcn_rcpf(fmaxf(G0, 1.0e-35f)), K1 = (1.0f - lb1) * (1.0f - s1) * __builtin_amdgcn_rcpf(fmaxf(G1, 1.0e-35f));
                *(unsigned*)(p.HQ + ((size_t)dir * MT + m0 + j) * 512 + c) = pk_bf16(qa * sigmoidf_(qa) * G0, qb * sigmoidf_(qb) * G1); *(unsigned*)(p.HK + ((size_t)dir * MT + m0 + j) * 512 + c) = pk_bf16(K0, K1); }
        }
        *(f32x2_t*)(p.HA + ((size_t)dir * NCH + ch) * 512 + c) = (f32x2_t){G0, G1};
    }
}

#ifndef GP_SP2
#define GP_SP2 true
#endif
#ifndef GP_ALIGN
#define GP_ALIGN true
#endif
constexpr int LDS_MAIN = 1024 * 36 * 4;
constexpr int LDS_TOTAL = LDS_MAIN + 16;

struct EpiScaledBf16 {
    static constexpr bool PERM = true, AFTER_DRAIN = false;
    bf16_t* O; int ldc; float scale;
    __device__ __forceinline__ void operator()(const f32x4 (&acc)[2][2][4][2], const Unit& u, int wr, int wc, int fr, int fq) const {
        bf16_t* base = O + (size_t)(u.pm * 256 + wr * 64 + fr) * ldc + u.pn * 256 + wc * 32 + 8 * fq;
#pragma unroll
        for (int ai = 0; ai < 2; ++ai)
#pragma unroll
            for (int m = 0; m < 4; ++m) { bf16_t* rowp = base + (size_t)(ai * 128 + m * 16) * ldc;
#pragma unroll
                for (int bj = 0; bj < 2; ++bj) { const f32x4 v0 = acc[ai][bj][m][0] * scale, v1 = acc[ai][bj][m][1] * scale;
                    u32x4 w; w.x = pg8::cvt_pk_bf16(v0[0], v0[1]); w.y = pg8::cvt_pk_bf16(v0[2], v0[3]); w.z = pg8::cvt_pk_bf16(v1[0], v1[1]); w.w = pg8::cvt_pk_bf16(v1[2], v1[3]);
                    *(u32x4*)(rowp + bj * 128) = w; } }
    }
};
__device__ __forceinline__ void gemm_in_phase(const Params& p, int l) {
    { pg8::Gemm g; g.A = p.H; g.Bt = p.wt_in + (size_t)l * INC * D; g.M = MT; g.N = C_GR; g.K = D;
      pg8::StaticOrder S; S.init(MT, C_GR, (int)gridDim.x, (int)blockIdx.x);
      pg8::EpiBf16<0> E; E.O = p.U; E.ldc = INC; E.bias = nullptr; E.split_cols = 0; E.split_stride = 0;
      pg8::gemm_phase<pg8::EpiBf16<0>, pg8::StaticOrder, GP_ALIGN, GP_SP2>((LAS unsigned char*)dyn_lds, g, S, E); }
    { pg8::Gemm g; g.A = (const bf16_t*)p.H8; g.Bt = (const bf16_t*)(p.wt_ing + (size_t)l * (INC - C_GR) * D); g.M = MT; g.N = INC - C_GR; g.K = D / 2;
      const int G = (int)gridDim.x, rot = (G - (MT / 256) * (C_GR / 256) % G) & ~7;
      pg8::StaticOrder S; S.init(MT, INC - C_GR, G, ((int)blockIdx.x + rot) % G);
      EpiScaledBf16 E; E.O = p.U + C_GR; E.ldc = INC; E.scale = 1.0f / W8_SCALE;
      pg8::gemm_phase<EpiScaledBf16, pg8::StaticOrder, GP_ALIGN, GP_SP2, true>((LAS unsigned char*)dyn_lds, g, S, E); }
}
__device__ __forceinline__ void gemm_merge_phase(const Params& p, int l) {
    pg8::Gemm g; g.A = p.Aall; g.Bt = p.wt_br + (size_t)l * 3 * 1024 * 512; g.M = 3 * MT; g.N = 3 * 1024; g.K = 512;
    SchedMerge S; S.G = (int)gridDim.x; S.c = (int)blockIdx.x; S.last = (l == DEPTH - 1);
    EpiBranch E; E.R = p.R;
    pg8::gemm_phase<EpiBranch, SchedMerge, GP_ALIGN, GP_SP2>((LAS unsigned char*)dyn_lds, g, S, E);
}
__device__ __forceinline__ void gemm_out_phase(const Params& p, int l) {
    pg8::Gemm g; g.A = p.Mg; g.Bt = p.wt_out + (size_t)l * D * D; g.M = MT; g.N = D; g.K = D;
    SchedOut S; S.init(MT, D, (int)gridDim.x, (int)blockIdx.x, l == DEPTH - 1);
    EpiOut E; E.X = p.X; E.mod_l = p.mod + (size_t)l * 5 * 6144;
    pg8::gemm_phase<EpiOut, SchedOut, GP_ALIGN, GP_SP2>((LAS unsigned char*)dyn_lds, g, S, E);
}
__device__ __forceinline__ void gemm_gu_phase(const Params& p, int l) {
    pg8::Gemm g; g.A = (const bf16_t*)p.Xg; g.Bt = (const bf16_t*)(p.wt_gu + (size_t)l * NE * 2048 * D); g.M = NE * CAPT * 256; g.N = NE * 2048; g.K = D / 2;
    build_tile_table(p, l);
    SchedMoE S; S.nN = 8; S.G = (int)gridDim.x; S.c = (int)blockIdx.x; S.sparseA = 1;
    EpiGU E; E.Act = p.Act; E.bgu = p.exp_b_gu + (size_t)l * NE * 2048;
    pg8::gemm_phase<EpiGU, SchedMoE, GP_ALIGN, GP_SP2, true>((LAS unsigned char*)dyn_lds, g, S, E);
}
__device__ __forceinline__ void gemm_down_phase(const Params& p, int l) {
    pg8::Gemm g; g.A = (const bf16_t*)p.Act; g.Bt = (const bf16_t*)(p.wt_down + (size_t)l * NE * D * D); g.M = MAXSLOTS; g.N = NE * D; g.K = D / 2;
    build_tile_table(p, l);
    SchedMoE S; S.nN = 4; S.G = (int)gridDim.x; S.c = (int)blockIdx.x; S.sparseA = 0;
    EpiDown E; E.Y = p.Y; E.bd = p.exp_b_down + (size_t)l * NE * D;
    pg8::gemm_phase<EpiDown, SchedMoE, GP_ALIGN, GP_SP2, true>((LAS unsigned char*)dyn_lds, g, S, E);
}

typedef __attribute__((address_space(4))) const Params* KParamsPtr;
__device__ __forceinline__ const Params& fresh_params() { KParamsPtr kp = (KParamsPtr)__builtin_amdgcn_kernarg_segment_ptr(); asm volatile("" : "+s"(kp)); return *(const Params*)kp; }
#define P_ fresh_params()
#ifdef BARRIER_TWICE
#define GRID_BARRIER() do { XcdBarrier _b = bar; asm volatile("" : "+s"(_b.bar), "+s"(_b.x)); xcd_barrier(_b); xcd_barrier(_b); } while (0)
#else
#define GRID_BARRIER() do { XcdBarrier _b = bar; asm volatile("" : "+s"(_b.bar), "+s"(_b.x)); xcd_barrier(_b); } while (0)
#endif
__global__ __launch_bounds__(512, 2) void k_fwd(Params p) {
    float* ldsf = (float*)dyn_lds;
#ifdef PROBE_PHASE
#ifndef PROBE_SHIFT
#define PROBE_SHIFT 0.0f
#endif
#ifndef PROBE_Q
#define PROBE_Q 50.0f
#endif
    unsigned long long pr_t0 = wall_clock64(), pr_prev = pr_t0, pr_acc = 0ull;
#define PMARK(id) do { const unsigned long long _t = wall_clock64(); if ((id) == PROBE_PHASE) pr_acc += _t - pr_prev; pr_prev = _t; } while (0)
#else
#define PMARK(id) do { } while (0)
#endif
    if (threadIdx.x == 0) *(uint4*)(dyn_lds + LDS_MAIN) = make_uint4(0u, 0u, 0u, 0u);
    __syncthreads();
    const XcdBarrier bar = xcd_barrier_post(P_.bar, (volatile LAS unsigned*)(dyn_lds + LDS_MAIN));
    convert_phase(P_, ldsf);
    mod_phase(P_, ldsf);
    small_phase(P_);
    GRID_BARRIER(); PMARK(0);
    norm_phase<0>(P_, 0);
    router_prep_phase(P_);
    GRID_BARRIER(); PMARK(1);
    for (int l = 0; l < DEPTH; ++l) {
        if (l > 0) { norm_phase<1>(P_, l); GRID_BARRIER(); PMARK(1); }
        gemm_in_phase(P_, l);
        GRID_BARRIER(); PMARK(2);
        mixprep_phase(P_, l);
#ifdef MIXPREP_TWICE
        mixprep_phase(P_, l);
#endif
#ifdef SPLIT_PREP
        GRID_BARRIER(); PMARK(16);
#endif
        lru_prep_phase(P_, l, ldsf);
#ifdef LRU_TWICE
        __syncthreads(); lru_prep_phase(P_, l, ldsf);
#endif
        GRID_BARRIER(); PMARK(3);
        sweep_phase<false>(P_, l, ldsf);
        GRID_BARRIER(); PMARK(4);
        sweep_phase<true>(P_, l, ldsf);
        GRID_BARRIER(); PMARK(13);
#ifdef SWEEP2_AGAIN
        { Params q = P_; q.Oret = q.Dummy; q.Ohg = q.Dummy; sweep_phase<true, SWEEP2_AGAIN - 1>(q, l, ldsf); }
        GRID_BARRIER();
#endif

        finish_phase(P_, l, l == DEPTH - 1);
        GRID_BARRIER(); PMARK(5);
        gemm_merge_phase(P_, l);
        GRID_BARRIER(); PMARK(6);
        merge_combine_phase(P_, l == DEPTH - 1);
        GRID_BARRIER(); PMARK(17);
        gemm_out_phase(P_, l);
        GRID_BARRIER(); PMARK(7);
        route_phase(P_, l, ldsf, l == DEPTH - 1);
        GRID_BARRIER(); PMARK(8);
        gemm_gu_phase(P_, l);
        GRID_BARRIER(); PMARK(11);
        gemm_down_phase(P_, l);
        GRID_BARRIER(); PMARK(12);
    }
#ifdef PROBE_PHASE
    if (blockIdx.x == 0 && threadIdx.x == 0) {
#ifdef PROBE_ABS
        const float fr = (float)((double)pr_acc / 100.0 / PROBE_ABS);
#else
        const float fr = (float)((double)pr_acc / (double)(pr_prev - pr_t0));
#endif
 ((float*)p.ctrl)[2048] = floorf(fr * PROBE_Q + 0.5f + PROBE_SHIFT) / PROBE_Q; }
    GRID_BARRIER();
#endif
    norm_phase<2>(P_, DEPTH);
}

static inline size_t align_up(size_t v, size_t a) { return (v + a - 1) / a * a; }

extern "C" void kernel_launch(void* const* d_in, const int* in_sizes, int n_in, void* d_out, int out_size, void* d_ws, size_t ws_size, hipStream_t stream) {
    (void)in_sizes; (void)n_in; (void)out_size; (void)ws_size;
    Params p{};
    const float** pin = (const float**)&p.x;
    for (int i = 0; i < 31; ++i) pin[i] = (const float*)d_in[i];
    p.out = (float*)d_out;
    char* w = (char*)d_ws; size_t off = 0;
    auto take = [&](size_t bytes) { char* r = w + off; off = align_up(off + bytes, 256); return r; };
    p.bar = (unsigned*)take(XCD_BAR_WORDS * 4);
    p.ctrl = (unsigned*)take(4096 * 4);
    const size_t zero_bytes = off;
    p.wt_in = (bf16_t*)take((size_t)DEPTH * INC * D * 2);
    p.wt_br = (bf16_t*)take((size_t)DEPTH * 3 * 1024 * 512 * 2);
    p.wt_out = (bf16_t*)take((size_t)DEPTH * D * D * 2);
    p.wt_gu = (unsigned char*)take((size_t)DEPTH * NE * 2048 * D);
    p.wt_down = (unsigned char*)take((size_t)DEPTH * NE * D * D);
    p.mod = (float*)take((size_t)DEPTH * 5 * 6144 * 4);
    p.lb = (float*)take(4096 * 4);
    p.rot = (float*)take((size_t)4096 * 32 * 2 * 4);
    p.X = (bf16_t*)take((size_t)MT * D * 2);
    p.H = (bf16_t*)take((size_t)MT * D * 2); p.H8 = (unsigned char*)take((size_t)MT * D); p.wt_ing = (unsigned char*)take((size_t)DEPTH * (INC - C_GR) * D);
    p.U = (bf16_t*)take((size_t)MT * INC * 2);
    p.Oret = (bf16_t*)take((size_t)2 * MT * 512 * 2);
    p.Ohg = (bf16_t*)take((size_t)2 * MT * 512 * 2);
    p.PH = (unsigned*)take((size_t)2 * MT * 512 * 4);
    p.RQ = (bf16_t*)take((size_t)2 * MT * 512 * 2); p.RK = (bf16_t*)take((size_t)2 * MT * 512 * 2); p.HQ = (bf16_t*)take((size_t)2 * MT * 512 * 2); p.HK = (bf16_t*)take((size_t)2 * MT * 512 * 2);
    p.HA = (float*)take((size_t)2 * (MT / 32) * 512 * 4);
    p.Dummy = (bf16_t*)take((size_t)2 * MT * 512 * 2);
    p.SE = (float*)take((size_t)192 * 9 * 4096 * 4); p.SG = (float*)take((size_t)192 * 9 * 128 * 4); p.LP = (float*)take((size_t)2 * 544 * 512 * 4); p.LH = (float*)take((size_t)2 * 544 * 512 * 4); p.LS = (float*)take((size_t)2 * 544 * 512 * 4);
    p.Aall = (bf16_t*)take((size_t)3 * MT * 512 * 2);
    p.R = (bf16_t*)take((size_t)3 * MT * D * 2); p.Dx = (bf16_t*)take((size_t)MT * D * 2);
    p.Mg = (bf16_t*)take((size_t)MT * D * 2);
    p.tok_e = (int*)take((size_t)MT * 4 * 4); p.tok_pos = (int*)take((size_t)MT * 4 * 4); p.tok_w = (float*)take((size_t)MT * 4 * 4);
    p.RWp = (float*)take((size_t)DEPTH * 5 * 1024 * 32 * 4); p.RC = (float*)take((size_t)DEPTH * 5 * 32 * 4);
    p.Xg = (unsigned char*)take((size_t)NE * CAPT * 256 * D); p.Act = (unsigned char*)take((size_t)MAXSLOTS * D); p.Y = (unsigned char*)take((size_t)MAXSLOTS * D);

    static int grid = 0;
    if (!grid) {
        (void)hipFuncSetAttribute((const void*)k_fwd, hipFuncAttributeMaxDynamicSharedMemorySize, LDS_TOTAL);
        int dev = 0, cus = 0, per_cu = 0;
        (void)hipGetDevice(&dev);
        (void)hipDeviceGetAttribute(&cus, hipDeviceAttributeMultiprocessorCount, dev);
        (void)hipOccupancyMaxActiveBlocksPerMultiprocessor(&per_cu, (const void*)k_fwd, 512, LDS_TOTAL);
        grid = cus * (per_cu < 1 ? per_cu : 1);
        if (grid <= 0) { fprintf(stderr, "k_fwd: occupancy query returned %d blocks per CU on %d CUs\n", per_cu, cus); grid = 0; return; }
    }
    (void)hipMemsetAsync(d_ws, 0, zero_bytes, stream);
    hipLaunchKernelGGL(k_fwd, dim3(grid), dim3(512), LDS_TOTAL, stream, p);
}
```

```cpp
#include <hip/hip_runtime.h>
#include <cstdio>
#include <cstdint>
__device__ __forceinline__ int pg8_tid_fresh() { int t = threadIdx.x; asm volatile("" : "+v"(t)); return t; }
namespace pg8 {
#define PG8_LAS __attribute__((address_space(3)))
typedef unsigned short bf16_t;
typedef short bf16x8 __attribute__((ext_vector_type(8)));
typedef float f32x4 __attribute__((ext_vector_type(4)));
typedef unsigned u32x4 __attribute__((ext_vector_type(4)));
constexpr int BM = 256, BK = 64, HALF = 128, HTB = HALF * BK * 2  , STAGE_BYTES = 8 * HTB, NXCD = 8, WGM = 8;

__host__ __device__ __forceinline__ int lds_byte(int r, int c) { const int st = (r >> 4) * 2 + (c >> 5), rr = r & 15, cc = c & 31, ob = rr * 64 + cc * 2; return st * 1024 + (ob ^ (((ob >> 9) & 1) << 5)); }
__host__ __device__ __forceinline__ void stage_rc(int b, int& R, int& C) { const int st = b / 1024, sb = b % 1024, swz = sb ^ (((sb >> 9) & 1) << 5); R = (st >> 1) * 16 + swz / 64; C = (st & 1) * 32 + (swz % 64) / 2; }
__host__ __device__ __forceinline__ int perm32(int rho) { const int n = rho >> 4, i = rho & 15; return 8 * (i >> 2) + 4 * n + (i & 3); }

struct Unit { int pm, pn, po; };
struct Gemm { const bf16_t* A; const bf16_t* Bt; int M, N, K; };

struct StaticOrder {
    int nM, nN, nwg, G, c;
    __host__ __device__ void init(int M, int N, int G_, int c_) { nM = M / BM; nN = N / BM; nwg = nM * nN; G = G_; c = c_; }
    __host__ __device__ bool next(int i, Unit& u) const {
        const long L = (long)i * G + c; if (L >= nwg) return false;
        int wgid = (int)L; { const int q = nwg / NXCD, r = nwg % NXCD, xcd = wgid % NXCD, off = wgid / NXCD; wgid = (xcd < r ? xcd * (q + 1) : r * (q + 1) + (xcd - r) * q) + off; }
        const int nig = WGM * nN, gid = wgid / nig, fm = gid * WGM, gsz = (nM - fm) < WGM ? (nM - fm) : WGM;
        u.pm = fm + ((wgid % nig) % gsz); u.pn = (wgid % nig) / gsz; return true;
    }
    __device__ __forceinline__ void a_ready(const Unit&) const {}
    __device__ __forceinline__ void done(const Unit&) const {}
};
__device__ __forceinline__ unsigned cvt_pk_bf16(float lo, float hi) { unsigned r; asm volatile("v_cvt_pk_bf16_f32 %0, %1, %2" : "=v"(r) : "v"(lo), "v"(hi)); return r; }
typedef float f32x2 __attribute__((ext_vector_type(2)));
__device__ __forceinline__ f32x2 gelu_pk(f32x2 v) {
    const f32x2 av = __builtin_elementwise_abs(v), d = av * 0.2316418882f + 1.0f;
    f32x2 t; t.x = __builtin_amdgcn_rcpf(d.x); t.y = __builtin_amdgcn_rcpf(d.y);
    f32x2 q = t * 0.5307027145f + (-0.7265760135f); q = q * t + 0.7107068705f; q = q * t + (-0.142248368f); q = q * t + 0.127414796f; q = q * t;
    const f32x2 s = (v * v) * (-0.72134752044f);
    f32x2 e; e.x = __builtin_amdgcn_exp2f(s.x); e.y = __builtin_amdgcn_exp2f(s.y);
    const f32x2 m = v * (q * e), r = v - m;
    f32x2 o; o.x = v.x < 0.f ? m.x : r.x; o.y = v.y < 0.f ? m.y : r.y; return o;
}

template <int ACT  > struct EpiBf16 {
    static constexpr bool PERM = true, AFTER_DRAIN = false;
    bf16_t* O; int ldc; const float* bias; int split_cols; size_t split_stride;
    __device__ __forceinline__ void operator()(const f32x4 (&acc)[2][2][4][2], const Unit& u, int wr, int wc, int fr, int fq) const {
        const int row0 = u.pm * BM + wr * 64 + fr; int colt = u.pn * BM; bf16_t* base = O;
        if (split_cols) { const int t = colt / split_cols; base += (size_t)t * split_stride; colt -= t * split_cols; }
        const int col0 = colt + wc * 32 + 8 * fq, bcol0 = u.pn * BM + wc * 32 + 8 * fq;
        f32x4 bv[2][2];
#pragma unroll
        for (int bj = 0; bj < 2; ++bj)
#pragma unroll
            for (int n = 0; n < 2; ++n) bv[bj][n] = bias ? *(const f32x4*)(bias + bcol0 + bj * HALF + 4 * n) : (f32x4){0.f, 0.f, 0.f, 0.f};
#pragma unroll
        for (int ai = 0; ai < 2; ++ai)
#pragma unroll
            for (int m = 0; m < 4; ++m) { bf16_t* rowp = base + (size_t)(row0 + ai * HALF + m * 16) * ldc + col0;
#pragma unroll
                for (int bj = 0; bj < 2; ++bj) { f32x4 v0 = acc[ai][bj][m][0] + bv[bj][0], v1 = acc[ai][bj][m][1] + bv[bj][1];
                    if (ACT == 1) { f32x2 a = gelu_pk((f32x2){v0[0], v0[1]}), b = gelu_pk((f32x2){v0[2], v0[3]}), c = gelu_pk((f32x2){v1[0], v1[1]}), d = gelu_pk((f32x2){v1[2], v1[3]});
                        v0 = (f32x4){a.x, a.y, b.x, b.y}; v1 = (f32x4){c.x, c.y, d.x, d.y}; }
                    if (ACT == 2) {
#pragma unroll
                        for (int j = 0; j < 4; ++j) { v0[j] = 0.5f * v0[j] * (1.0f + erff(v0[j] * 0.70710678f)); v1[j] = 0.5f * v1[j] * (1.0f + erff(v1[j] * 0.70710678f)); } }
                    u32x4 w; w.x = cvt_pk_bf16(v0[0], v0[1]); w.y = cvt_pk_bf16(v0[2], v0[3]); w.z = cvt_pk_bf16(v1[0], v1[1]); w.w = cvt_pk_bf16(v1[2], v1[3]);
                    *(u32x4*)(rowp + bj * HALF) = w; } }
    }
};


typedef int i32x4_f8 __attribute__((ext_vector_type(4)));
typedef int i32x8_f8 __attribute__((ext_vector_type(8)));
template <class Epi, class Sched, bool ALIGN_EPI = false, bool SP2 = false, bool F8 = false>
__device__ __forceinline__ void gemm_phase(PG8_LAS unsigned char* lds, const Gemm g, const Sched& S, const Epi& E) {
    const int tid = pg8_tid_fresh(), wid = __builtin_amdgcn_readfirstlane(tid >> 6), lane = tid & 63, wr = wid >> 2, wc = wid & 3, fr = lane & 15, fq = lane >> 4;
    const int K = g.K, nt = K / BK;
    unsigned voffA[2], voffB[2];
#pragma unroll
    for (int i = 0; i < 2; ++i) { int R, C; stage_rc(tid * 16 + i * 8192, R, C); const int Rb = Epi::PERM ? ((R & ~31) + perm32(R & 31)) : R;
        voffA[i] = (unsigned)(R * K + C) * 2u; voffB[i] = (unsigned)(Rb * K + C) * 2u; }
    const size_t kstep = (size_t)(BK * 2);
    const size_t hstep = (size_t)HALF * K * 2;
    const size_t tstep = 2 * hstep;
    const unsigned ldsw = (unsigned)wid * 1024u;
    const int aoff = lds_byte(wr * 64 + fr, fq * 8), boff = lds_byte(wc * 32 + fr, fq * 8);
#define PG8_SA(b, h) (((b) * 2 + (h)) * HTB)
#define PG8_SB(b, h) ((4 + (b) * 2 + (h)) * HTB)
#define PG8_STAGE(bufoff, gbase, voff) do { _Pragma("unroll") for (int _i = 0; _i < 2; ++_i) \
        __builtin_amdgcn_global_load_lds((const unsigned*)((const char*)(gbase) + (voff)[_i]), (PG8_LAS unsigned*)(lds + (bufoff) + ldsw + _i * 8192), 16, 0, 0); } while (0)
#define PG8_LDA(dst, b, h) do { if constexpr (F8) { _Pragma("unroll") for (int m = 0; m < 4; ++m) dst##8[m] = __builtin_shufflevector(*(const PG8_LAS i32x4_f8*)(lds + PG8_SA(b, h) + aoff + m * 2048), *(const PG8_LAS i32x4_f8*)(lds + PG8_SA(b, h) + aoff + m * 2048 + 1024), 0, 1, 2, 3, 4, 5, 6, 7); } \
        else { _Pragma("unroll") for (int m = 0; m < 4; ++m) _Pragma("unroll") for (int k = 0; k < 2; ++k) dst[m][k] = *(const PG8_LAS bf16x8*)(lds + PG8_SA(b, h) + aoff + m * 2048 + k * 1024); } } while (0)
#define PG8_LDB(dst, b, h) do { if constexpr (F8) { _Pragma("unroll") for (int n = 0; n < 2; ++n) dst##8[n] = __builtin_shufflevector(*(const PG8_LAS i32x4_f8*)(lds + PG8_SB(b, h) + boff + n * 2048), *(const PG8_LAS i32x4_f8*)(lds + PG8_SB(b, h) + boff + n * 2048 + 1024), 0, 1, 2, 3, 4, 5, 6, 7); } \
        else { _Pragma("unroll") for (int n = 0; n < 2; ++n) _Pragma("unroll") for (int k = 0; k < 2; ++k) dst[n][k] = *(const PG8_LAS bf16x8*)(lds + PG8_SB(b, h) + boff + n * 2048 + k * 1024); } } while (0)
#define PG8_MMA(ai, bj, At, Bt) do { __builtin_amdgcn_s_setprio(1); _Pragma("unroll") for (int m = 0; m < 4; ++m) _Pragma("unroll") for (int n = 0; n < 2; ++n) { \
        if constexpr (F8) { asm volatile("v_mfma_f32_16x16x128_f8f6f4 %0, %1, %2, %0" : "+v"(acc[ai][bj][m][n]) : "v"(Bt##8[n]), "v"(At##8[m])); } \
        else { _Pragma("unroll") for (int k = 0; k < 2; ++k) acc[ai][bj][m][n] = __builtin_amdgcn_mfma_f32_16x16x32_bf16(Bt[n][k], At[m][k], acc[ai][bj][m][n], 0, 0, 0); } } \
        __builtin_amdgcn_s_setprio(0); } while (0)
#define PG8_WAIT_V(n) asm volatile("s_waitcnt vmcnt(" #n ")" ::: "memory")
#define PG8_WAIT_L(n) asm volatile("s_waitcnt lgkmcnt(" #n ")" ::: "memory")
#define PG8_BAR __builtin_amdgcn_s_barrier()
#define PG8_SCHED __builtin_amdgcn_sched_barrier(0)
    Unit cur, nxt; int ui = 0;
    if (!S.next(0, cur)) return;
    float zf = 0.f; asm volatile("" : "+v"(zf));
    f32x4 acc[2][2][4][2];
#pragma unroll
    for (int a = 0; a < 2; ++a)
#pragma unroll
        for (int b = 0; b < 2; ++b)
#pragma unroll
            for (int m = 0; m < 4; ++m)
#pragma unroll
                for (int n = 0; n < 2; ++n) acc[a][b][m][n] = (f32x4){zf, zf, zf, zf};
    bf16x8 At[4][2], B0[2][2], B1[2][2]; i32x8_f8 At8[4], B08[2], B18[2];
    const char* cA = (const char*)g.A + (size_t)cur.pm * tstep; const char* cB = (const char*)g.Bt + (size_t)cur.pn * tstep;
    S.a_ready(cur);
    if constexpr (SP2) {
        PG8_STAGE(PG8_SB(0, 0), cB, voffB); PG8_STAGE(PG8_SB(0, 1), cB + hstep, voffB); PG8_STAGE(PG8_SA(0, 0), cA, voffA); PG8_STAGE(PG8_SA(0, 1), cA + hstep, voffA);
        if (wr == 1) PG8_BAR;
        PG8_WAIT_V(2); PG8_BAR;
        PG8_STAGE(PG8_SB(1, 0), cB + kstep, voffB); PG8_STAGE(PG8_SA(1, 0), cA + kstep, voffA); PG8_STAGE(PG8_SB(1, 1), cB + hstep + kstep, voffB);
        PG8_WAIT_V(6); PG8_BAR;
    } else {
        PG8_STAGE(PG8_SB(0, 0), cB, voffB); PG8_STAGE(PG8_SA(0, 0), cA, voffA); PG8_STAGE(PG8_SB(0, 1), cB + hstep, voffB); PG8_STAGE(PG8_SA(0, 1), cA + hstep, voffA);
        if (wr == 1) PG8_BAR;
        PG8_WAIT_V(4); PG8_BAR;
        PG8_STAGE(PG8_SB(1, 0), cB + kstep, voffB); PG8_STAGE(PG8_SA(1, 0), cA + kstep, voffA); PG8_STAGE(PG8_SB(1, 1), cB + hstep + kstep, voffB);
        PG8_WAIT_V(6); PG8_BAR;
    }
    for (;;) {
        const bool has_next = S.next(ui + 1, nxt);
        const char* nA = has_next ? (const char*)g.A + (size_t)nxt.pm * tstep : cA; const char* nB = has_next ? (const char*)g.Bt + (size_t)nxt.pn * tstep : cB;
        for (int t = 0; t < nt; t += 2) {
            const bool last = (t == nt - 2);
            const char* a1 = cA + (size_t)(t + 1) * kstep;
            const char* a2 = last ? nA : cA + (size_t)(t + 2) * kstep; const char* b2 = last ? nB : cB + (size_t)(t + 2) * kstep;
            const char* a3 = a2 + kstep; const char* b3 = b2 + kstep;
            if (last && has_next) S.a_ready(nxt);
            if constexpr (SP2) {
            PG8_LDB(B0, 0, 0); PG8_LDB(B1, 0, 1); PG8_SCHED; PG8_LDA(At, 0, 0); PG8_STAGE(PG8_SA(1, 1), a1 + hstep, voffA);
            PG8_WAIT_V(8); PG8_WAIT_L(0); PG8_BAR; PG8_MMA(0, 0, At, B0); PG8_MMA(0, 1, At, B1); PG8_BAR; PG8_SCHED;
            PG8_LDA(At, 0, 1); PG8_STAGE(PG8_SB(0, 0), b2, voffB); PG8_STAGE(PG8_SB(0, 1), b2 + hstep, voffB); PG8_STAGE(PG8_SA(0, 0), a2, voffA);
            PG8_WAIT_V(8); PG8_WAIT_L(0); PG8_BAR; PG8_MMA(1, 0, At, B0); PG8_MMA(1, 1, At, B1); PG8_BAR; PG8_SCHED;
            PG8_LDB(B0, 1, 0); PG8_LDB(B1, 1, 1); PG8_SCHED; PG8_LDA(At, 1, 0); PG8_STAGE(PG8_SA(0, 1), a2 + hstep, voffA);
            PG8_WAIT_V(8); PG8_WAIT_L(0); PG8_BAR; PG8_MMA(0, 0, At, B0); PG8_MMA(0, 1, At, B1); PG8_BAR; PG8_SCHED;
            PG8_LDA(At, 1, 1); PG8_STAGE(PG8_SB(1, 0), b3, voffB); PG8_STAGE(PG8_SB(1, 1), b3 + hstep, voffB); PG8_STAGE(PG8_SA(1, 0), a3, voffA);
            PG8_WAIT_V(8); PG8_WAIT_L(0); PG8_BAR; PG8_MMA(1, 0, At, B0); PG8_MMA(1, 1, At, B1); PG8_BAR; PG8_SCHED;
            } else {
            PG8_LDB(B0, 0, 0); PG8_SCHED; PG8_LDA(At, 0, 0); PG8_STAGE(PG8_SA(1, 1), a1 + hstep, voffA);
            PG8_WAIT_L(8); PG8_BAR; PG8_WAIT_L(0); PG8_MMA(0, 0, At, B0); PG8_BAR; PG8_SCHED;
            PG8_LDB(B1, 0, 1); PG8_STAGE(PG8_SB(0, 0), b2, voffB);
            PG8_BAR; PG8_WAIT_L(0); PG8_MMA(0, 1, At, B1); PG8_BAR;
            PG8_LDA(At, 0, 1); PG8_STAGE(PG8_SA(0, 0), a2, voffA);
            PG8_BAR; PG8_WAIT_L(0); PG8_MMA(1, 0, At, B0); PG8_BAR; PG8_SCHED;
            PG8_STAGE(PG8_SB(0, 1), b2 + hstep, voffB);
            PG8_WAIT_V(6); PG8_BAR; PG8_MMA(1, 1, At, B1); PG8_BAR;
            PG8_LDB(B0, 1, 0); PG8_SCHED; PG8_LDA(At, 1, 0); PG8_STAGE(PG8_SA(0, 1), a2 + hstep, voffA);
            PG8_WAIT_L(8); PG8_BAR; PG8_WAIT_L(0); PG8_MMA(0, 0, At, B0); PG8_BAR; PG8_SCHED;
            PG8_LDB(B1, 1, 1); PG8_STAGE(PG8_SB(1, 0), b3, voffB);
            PG8_BAR; PG8_WAIT_L(0); PG8_MMA(0, 1, At, B1); PG8_BAR;
            PG8_LDA(At, 1, 1); PG8_STAGE(PG8_SA(1, 0), a3, voffA);
            PG8_BAR; PG8_WAIT_L(0); PG8_MMA(1, 0, At, B0); PG8_BAR; PG8_SCHED;
            PG8_STAGE(PG8_SB(1, 1), b3 + hstep, voffB);
            PG8_WAIT_V(6); PG8_BAR; PG8_MMA(1, 1, At, B1); PG8_BAR;
            }
        }
        if constexpr (ALIGN_EPI) { if (wr == 0) PG8_BAR; }
        if constexpr (F8) asm volatile("s_nop 15\n\ts_nop 15" ::: "memory");
        if constexpr (!Epi::AFTER_DRAIN) { E(acc, cur, wr, wc, fr, fq); S.done(cur); }
        if (!has_next) break;
#pragma unroll
        for (int a = 0; a < 2; ++a)
#pragma unroll
            for (int b = 0; b < 2; ++b)
#pragma unroll
                for (int m = 0; m < 4; ++m)
#pragma unroll
                    for (int n = 0; n < 2; ++n) acc[a][b][m][n] = (f32x4){zf, zf, zf, zf};
        cur = nxt; cA = nA; cB = nB; ++ui;
        if constexpr (ALIGN_EPI) { if (wr == 1) PG8_BAR; }
    }
    PG8_WAIT_V(0);
    if constexpr (!ALIGN_EPI) { if (wr == 0) PG8_BAR; }
    PG8_BAR;
    if constexpr (Epi::AFTER_DRAIN) { E.fused(acc, cur, wr, wc, fr, fq, lds, wid, lane); S.done(cur); }
#undef PG8_SA
#undef PG8_SB
#undef PG8_STAGE
#undef PG8_LDA
#undef PG8_LDB
#undef PG8_MMA
#undef PG8_WAIT_V
#undef PG8_WAIT_L
#undef PG8_BAR
#undef PG8_SCHED
}
}
#include <hip/hip_runtime.h>
#include <cstdio>
#include <cstdint>
#include <cstdlib>
#include <vector>

#define XB_TMO      128
#define XB_XCNT(j)  (256  + 64 * (j))
#define XB_XSUB(j)  (1280 + 64 * (j))
#define XB_XGEN(j)  (2304 + 64 * (j))
#define XB_TOP      3328
#define XB_TOPGEN   3392
#define XCD_BAR_WORDS 3456
#define XB_SPIN_CAP (1u << 18)
#ifndef LAS
#define LAS __attribute__((address_space(3)))
#endif

__device__ __forceinline__ unsigned xb_ld(unsigned* p)              { return __hip_atomic_load(p, __ATOMIC_RELAXED, __HIP_MEMORY_SCOPE_AGENT); }
__device__ __forceinline__ unsigned xb_add(unsigned* p, unsigned v) { return __hip_atomic_fetch_add(p, v, __ATOMIC_RELAXED, __HIP_MEMORY_SCOPE_AGENT); }
__device__ __forceinline__ unsigned xb_xcc_id() { return (unsigned)__builtin_amdgcn_s_getreg((3 << 11) | 20) & 0xFu; }
#define XB_SPIN(cond, bar) do { unsigned _sp = 0; while (cond) { __builtin_amdgcn_s_sleep(1); \
    if ((++_sp & 255u) == 0u) { if (xb_ld(&(bar)[XB_TMO])) break; if (_sp > XB_SPIN_CAP) { atomicAdd(&(bar)[XB_TMO], 1u); break; } } } } while (0)

struct XcdBarrier {
    unsigned* bar; unsigned x;
    volatile LAS unsigned* st;
};

__device__ __forceinline__ XcdBarrier xcd_barrier_post(unsigned* bar, volatile LAS unsigned* st) {
    XcdBarrier b; b.bar = bar; b.x = xb_xcc_id(); b.st = st;
    if (threadIdx.x == 0) (void)xb_add(&bar[XB_XCNT(b.x)], 1u);
    return b;
}
__device__ __forceinline__ void xcd_barrier_complete(unsigned* bar, unsigned x, unsigned& nloc, unsigned& nx) {
    const unsigned G = gridDim.x * gridDim.y * gridDim.z;
    unsigned sum, cnt, mine, sp = 0u;
    for (;;) {
        sum = 0u; cnt = 0u; mine = 0u;
#pragma unroll
        for (unsigned j = 0; j < 16; ++j) { const unsigned c = xb_ld(&bar[XB_XCNT(j)]); sum += c; cnt += (c > 0u) ? 1u : 0u; mine = (j == x) ? c : mine; }
        if (sum == G) break;
        __builtin_amdgcn_s_sleep(1);
        if ((++sp & 255u) == 0u) { if (xb_ld(&bar[XB_TMO])) break; if (sp > XB_SPIN_CAP) { atomicAdd(&bar[XB_TMO], 1u); break; } }
    }
    nloc = mine > 0u ? mine : 1u; nx = cnt > 0u ? cnt : 1u;
}

__device__ __forceinline__ void xcd_barrier(const XcdBarrier& b) {
    asm volatile("s_waitcnt vmcnt(0)" ::: "memory");
    __syncthreads();
    if (threadIdx.x == 0) {
        unsigned* bar = b.bar;
        __builtin_amdgcn_s_waitcnt(0);
        unsigned nloc = b.st[0], nx = b.st[1];
        if (nloc == 0u) { xcd_barrier_complete(bar, b.x, nloc, nx); b.st[0] = nloc; b.st[1] = nx; }
        const unsigned old = xb_add(&bar[XB_XSUB(b.x)], 1u);
        const unsigned gen = old / nloc;
        if (old + 1u == (gen + 1u) * nloc) {
            __builtin_amdgcn_fence(__ATOMIC_RELEASE, "agent");
            asm volatile("s_waitcnt vmcnt(0)" ::: "memory");
            const unsigned og = xb_add(&bar[XB_TOP], 1u);
            const unsigned tg = og / nx;
            if (og + 1u == (tg + 1u) * nx) xb_add(&bar[XB_TOPGEN], 1u);
            else XB_SPIN(xb_ld(&bar[XB_TOPGEN]) == tg, bar);
            __builtin_amdgcn_fence(__ATOMIC_ACQUIRE, "agent");
            xb_add(&bar[XB_XGEN(b.x)], 1u);
            asm volatile("s_waitcnt vmcnt(0)" ::: "memory");
        } else {
            XB_SPIN(xb_ld(&bar[XB_XGEN(b.x)]) == gen, bar);
            __builtin_amdgcn_fence(__ATOMIC_ACQUIRE, "agent");
            asm volatile("s_waitcnt vmcnt(0)" ::: "memory");
        }
    }
    __syncthreads();
}


typedef unsigned short bf16_t;
using pg8::f32x4; using pg8::u32x4; using pg8::Unit;
typedef unsigned u32x2 __attribute__((ext_vector_type(2)));
#define LAS __attribute__((address_space(3)))
#define TIDX pg8_tid_fresh()

constexpr int D = 1024, NB = 4, SEQ = 4096, DEPTH = 4, LC = 256, LT = SEQ + LC, MT = NB * LT;
constexpr int INC = 8704;
constexpr int C_RQ = 0, C_RK = 512, C_RV = 1024, C_RG = 1536, C_HQ = 2048, C_HFF = 2560, C_HFB = 3072, C_HI = 3584, C_HGT = 4096, C_LX = 4608, C_LGT = 5120, C_GR = 5632;
constexpr float W8_SCALE = 64.0f;
constexpr int NE = 32, MAXTILES = 304, MAXSLOTS = MAXTILES * 256, CAPT = 68;
constexpr int TB_OFF = 131072;
constexpr int NTHREADS = 512;

struct Params {
    const float *x, *c, *ctx, *c_ctx, *mod_w, *mod_b, *norm1_g, *norm2_g, *final_g, *w_in, *ret_decay, *ret_gn_g, *w_ret_o, *hgrn_lb_logits, *hgrn_gn_g, *w_hgrn_o,
        *lru_conv_w, *lru_conv_b, *lru_wa, *lru_ba, *lru_wx, *lru_bx, *lru_lambda, *w_lru_o, *w_out, *router_w, *router_b, *exp_w_gu, *exp_b_gu, *exp_w_down, *exp_b_down;
    float* out;
    bf16_t *wt_in, *wt_br, *wt_out; unsigned char *wt_gu, *wt_down;
    float *mod, *lb, *rot;
    bf16_t* X; bf16_t* H; unsigned char* H8; unsigned char* wt_ing; bf16_t* U;
    bf16_t *Oret, *Ohg, *Dummy; unsigned* PH;
    bf16_t *RQ, *RK, *HQ, *HK; float *HA, *SE, *SG, *LP, *LH, *LS;
    bf16_t* Aall; bf16_t* R; bf16_t* Mg; bf16_t* Dx;
    unsigned* bar; unsigned* ctrl;
    int *tok_e, *tok_pos; float* tok_w;
    float *RWp, *RC;
    unsigned char *Xg, *Act; unsigned char* Y;
};

__device__ __forceinline__ float bf2f(bf16_t v) { return __uint_as_float(((unsigned)v) << 16); }
__device__ __forceinline__ float bflo(unsigned w) { return __uint_as_float(w << 16); }
__device__ __forceinline__ float bfhi(unsigned w) { return __uint_as_float(w & 0xffff0000u); }
__device__ __forceinline__ float sigmoidf_(float x) { return __builtin_amdgcn_rcpf(1.0f + __expf(-x)); }
__device__ __forceinline__ float shx(float v, int o, int lane) { return __int_as_float(__builtin_amdgcn_ds_bpermute((lane ^ o) << 2, __float_as_int(v))); }
__device__ __forceinline__ float wave_sum(float v, int lane) {
#pragma unroll
    for (int o = 32; o >= 1; o >>= 1) v += shx(v, o, lane);
    return v;
}

extern __shared__ __attribute__((aligned(16))) unsigned char dyn_lds[];
__device__ __forceinline__ unsigned char* dyn_lds_base() { return dyn_lds; }
typedef short bf16x8_t __attribute__((ext_vector_type(8)));
typedef short s16x4_t __attribute__((ext_vector_type(4)));
typedef float f32x16_t __attribute__((ext_vector_type(16)));
typedef float f32x2_t __attribute__((ext_vector_type(2)));
typedef __bf16 bf16v2_t __attribute__((ext_vector_type(2)));
constexpr int NCH = MT / 32;
#define MFMA32(a, b, c) __builtin_amdgcn_mfma_f32_32x32x16_bf16((a), (b), (c), 0, 0, 0)

#define GAS __attribute__((address_space(1)))
__device__ __forceinline__ const GAS char* uni_ptr(const void* p) { const unsigned long long v = (unsigned long long)p;
    const unsigned lo = __builtin_amdgcn_readfirstlane((unsigned)v), hi = __builtin_amdgcn_readfirstlane((unsigned)(v >> 32)); return (const GAS char*)(((unsigned long long)hi << 32) | lo); }
__device__ __forceinline__ unsigned pk_fp8x4(float a, float b, float c, float d) {
    a = fminf(fmaxf(a, -448.f), 448.f); b = fminf(fmaxf(b, -448.f), 448.f); c = fminf(fmaxf(c, -448.f), 448.f); d = fminf(fmaxf(d, -448.f), 448.f);
    int t = __builtin_amdgcn_cvt_pk_fp8_f32(a, b, 0, false); t = __builtin_amdgcn_cvt_pk_fp8_f32(c, d, t, true); return (unsigned)t; }
__device__ __forceinline__ unsigned pk_bf16(float a, float b) { const f32x2_t v = {a, b}; return __builtin_bit_cast(unsigned, __builtin_convertvector(v, bf16v2_t)); }
template <int s> __device__ __forceinline__ bf16x8_t pack8(const f32x16_t& x) {
    u32x4 w; w[0] = pk_bf16(x[8 * s], x[8 * s + 1]); w[1] = pk_bf16(x[8 * s + 2], x[8 * s + 3]); w[2] = pk_bf16(x[8 * s + 4], x[8 * s + 5]); w[3] = pk_bf16(x[8 * s + 6], x[8 * s + 7]);
    return __builtin_bit_cast(bf16x8_t, w);
}
__device__ __forceinline__ bf16x8_t frag_row(const LAS char* t, int pitch, int row, int colbase) {
    const s16x4_t lo = *(const LAS s16x4_t*)(t + row * pitch + colbase * 2), hi = *(const LAS s16x4_t*)(t + row * pitch + colbase * 2 + 16);
    return __builtin_shufflevector(lo, hi, 0, 1, 2, 3, 4, 5, 6, 7);
}
__device__ __forceinline__ bf16x8_t frag_tr(const LAS char* t, int pitch, int jb, int ct, int lane) {
    const int q = (lane & 15) >> 2, pp = lane & 3, blk = (lane >> 4) & 1;
    const LAS char* a0 = t + (jb + q) * pitch + (32 * ct + 16 * blk + 4 * pp) * 2;
    const s16x4_t lo = __builtin_amdgcn_ds_read_tr16_b64_v4i16((LAS s16x4_t*)a0), hi = __builtin_amdgcn_ds_read_tr16_b64_v4i16((LAS s16x4_t*)(a0 + 8 * pitch));
    return __builtin_shufflevector(lo, hi, 0, 1, 2, 3, 4, 5, 6, 7);
}


__device__ __forceinline__ void build_tile_table(const Params& p, int l) {
    LAS int* te = (LAS int*)((LAS char*)dyn_lds_base() + TB_OFF); LAS int* tb = te + MAXTILES; LAS int* tc = tb + NE + 1; const int t = TIDX;
    if (t < NE) tc[t] = ((int)p.ctrl[l * 64 + t] + 255) >> 8;
    __syncthreads();
    if (t <= NE) { int s = 0;
#pragma unroll 1
        for (int k = 0; k < t; ++k) s += tc[k];
        tb[t] = s; }
    __syncthreads();
    if (t < MAXTILES) { int e = 0;
#pragma unroll 1
        for (int k = 1; k < NE; ++k) e += (tb[k] <= t) ? 1 : 0;
        te[t] = e; }
    __syncthreads();
}

#ifndef CT_NN
#define CT_NN 128
#endif
constexpr int CT_K = 128, CT_N = CT_NN, CT_P = CT_N + 1;
__device__ __forceinline__ void convert_tiles(const float* __restrict__ src, bf16_t* __restrict__ dst, int K, int N, size_t sstride, size_t dstride, int mode, int nbatch, float* lds, int f8 = 0, int ld = 0) {
    const int t = TIDX & 255, half = TIDX >> 8; float* tile = lds + half * (CT_K * CT_P); if (ld == 0) ld = N;
    const int tn = N / CT_N, tk = K / CT_K, per = tn * tk, total = per * nbatch, stride = gridDim.x * 2, hb = blockIdx.x * 2 + half;
    const int iters = (total + stride - 1) / stride;
    for (int it = 0; it < iters; ++it) {
        const int idx = it * stride + hb; const bool valid = idx < total;
        const int bz = idx / per, rem = idx - bz * per, ky = rem / tn, nx = rem - ky * tn; const int n0 = nx * CT_N, k0 = ky * CT_K;
        if (valid) { const float* s = src + (size_t)bz * sstride;
#pragma unroll
            for (int i = 0; i < CT_K * (CT_N / 4) / 256; ++i) { const int r = t / (CT_N / 4) + (1024 / CT_N) * i, cq = (t % (CT_N / 4)) * 4; const float4 v = *(const float4*)(s + (size_t)(k0 + r) * ld + n0 + cq);
                tile[r * CT_P + cq] = v.x; tile[r * CT_P + cq + 1] = v.y; tile[r * CT_P + cq + 2] = v.z; tile[r * CT_P + cq + 3] = v.w; } }
        __syncthreads();
        if (valid) { bf16_t* d = dst + (size_t)bz * dstride; const int kq = (t & 3) * (CT_K / 4);
#pragma unroll
          for (int nn = 0; nn < CT_N / 64; ++nn) { const int n = (t >> 2) + 64 * nn;
            int nd = n0 + n; if (mode == 1) { const int j = nd & 1023, up = nd >> 10; nd = (j >> 7) * 256 + up * 128 + (j & 127); }
            if (f8) { uint4* o = (uint4*)((unsigned char*)dst + (size_t)bz * dstride + (size_t)nd * K + k0 + kq);
#pragma unroll
                for (int q = 0; q < CT_K / 64; ++q) { unsigned w[4];
#pragma unroll
                    for (int i = 0; i < 4; ++i) { const int kk = kq + 16 * q + 4 * i; w[i] = pk_fp8x4(W8_SCALE * tile[kk * CT_P + n], W8_SCALE * tile[(kk + 1) * CT_P + n], W8_SCALE * tile[(kk + 2) * CT_P + n], W8_SCALE * tile[(kk + 3) * CT_P + n]); }
                    o[q] = make_uint4(w[0], w[1], w[2], w[3]); }
            } else { uint4* o = (uint4*)(d + (size_t)nd * K + k0 + kq);
#pragma unroll
                for (int q = 0; q < CT_K / 32; ++q) { unsigned w[4];
#pragma unroll
                    for (int i = 0; i < 4; ++i) { const int kk = kq + 8 * q + 2 * i; w[i] = pg8::cvt_pk_bf16(tile[kk * CT_P + n], tile[(kk + 1) * CT_P + n]); }
                    o[q] = make_uint4(w[0], w[1], w[2], w[3]); } } } }
        __syncthreads();
    }
}
__device__ __forceinline__ void convert_phase(const Params& p, float* lds) {
    convert_tiles(p.w_in, p.wt_in, D, C_GR, (size_t)D * INC, (size_t)INC * D, 0, DEPTH, lds, 0, INC);
    convert_tiles(p.w_in + C_GR, (bf16_t*)p.wt_ing, D, INC - C_GR, (size_t)D * INC, (size_t)(INC - C_GR) * D, 0, DEPTH, lds, 1, INC);
    convert_tiles(p.w_ret_o, p.wt_br, 512, 1024, (size_t)512 * 1024, (size_t)3 * 1024 * 512, 0, DEPTH, lds);
    convert_tiles(p.w_hgrn_o, p.wt_br + (size_t)1024 * 512, 512, 1024, (size_t)512 * 1024, (size_t)3 * 1024 * 512, 0, DEPTH, lds);
    convert_tiles(p.w_lru_o, p.wt_br + (size_t)2 * 1024 * 512, 512, 1024, (size_t)512 * 1024, (size_t)3 * 1024 * 512, 0, DEPTH, lds);
    convert_tiles(p.w_out, p.wt_out, D, D, (size_t)D * D, (size_t)D * D, 0, DEPTH, lds);
    convert_tiles(p.exp_w_gu, (bf16_t*)p.wt_gu, D, 2048, (size_t)D * 2048, (size_t)2048 * D, 1, DEPTH * NE, lds, 1);
    convert_tiles(p.exp_w_down, (bf16_t*)p.wt_down, D, D, (size_t)D * D, (size_t)D * D, 0, DEPTH * NE, lds, 1);
}

__device__ __forceinline__ void mod_phase(const Params& p, float* lds) {
    float* s = lds; float* red = lds + 5 * 1024;
    const int t = TIDX;
    for (int i = t; i < 5 * 1024; i += NTHREADS) { const int r = i >> 10, k = i & 1023; const float v = (r < 4) ? p.c[r * 1024 + k] : p.c_ctx[k]; s[i] = v / (1.0f + expf(-v)); }
    __syncthreads();
    for (int unit = blockIdx.x; unit < 96 * DEPTH; unit += gridDim.x) {
        const int l = unit / 96, n0 = (unit - l * 96) * 64;
        const int nn = t & 63, kg = t >> 6; const float* w = p.mod_w + (size_t)l * 1024 * 6144 + n0 + nn;
        float acc[5] = {0.f, 0.f, 0.f, 0.f, 0.f};
        for (int k = kg * 128; k < kg * 128 + 128; ++k) { const float wv = w[(size_t)k * 6144];
#pragma unroll
            for (int r = 0; r < 5; ++r) acc[r] += s[r * 1024 + k] * wv; }
#pragma unroll
        for (int r = 0; r < 5; ++r) red[(kg * 5 + r) * 64 + nn] = acc[r];
        __syncthreads();
        if (t < 320) { const int r = t >> 6, n2 = t & 63; float a = 0.f;
#pragma unroll
            for (int g = 0; g < 8; ++g) a += red[(g * 5 + r) * 64 + n2];
            p.mod[(size_t)(l * 5 + r) * 6144 + n0 + n2] = a + p.mod_b[l * 6144 + n0 + n2]; }
        __syncthreads();
    }
}
__device__ __forceinline__ void small_phase(const Params& p) {
    for (int i = blockIdx.x * NTHREADS + TIDX; i < 4096 * 32; i += gridDim.x * NTHREADS) {
        if (i < 1024) { float v[4], m = -1e30f;
#pragma unroll
            for (int l = 0; l < 4; ++l) { v[l] = p.hgrn_lb_logits[l * 1024 + i]; m = fmaxf(m, v[l]); }
            float sum = 0.f;
#pragma unroll
            for (int l = 0; l < 4; ++l) { v[l] = expf(v[l] - m); sum += v[l]; }
            float cum = 0.f;
#pragma unroll
            for (int l = 0; l < 4; ++l) { const float sm = v[l] / sum; if (l > 0) cum += sm; p.lb[l * 1024 + i] = cum; } }
        const int t = i >> 5, f = i & 31; const float inv = powf(10000.0f, -(float)(f & 15) / 16.0f); const float pos = (f < 16) ? (float)(t >> 6) : (float)(t & 63);
        const float ang = pos * inv; p.rot[i * 2] = cosf(ang); p.rot[i * 2 + 1] = sinf(ang); }
}
template <int MODE> __device__ __forceinline__ void norm_phase(const Params& p, int l) {
    if (MODE != 0) build_tile_table(p, l - 1);
    const LAS int* tbp = (const LAS int*)((const LAS char*)dyn_lds_base() + TB_OFF) + MAXTILES;
    const int lane = TIDX & 63; const int gw = blockIdx.x * (NTHREADS / 64) + __builtin_amdgcn_readfirstlane(TIDX >> 6), nw = gridDim.x * (NTHREADS / 64);
    int ne[4] = {0, 0, 0, 0}, np[4] = {0, 0, 0, 0}; float nwt[4] = {0.f, 0.f, 0.f, 0.f};
    const bool bymap = (nw == 2048); const int wb = gw >> 9, wj = gw & 511; const int nit = bymap ? (wj < 256 ? 9 : 8) : (MT - gw + nw - 1) / nw;
#define NP_ROW(IT) (bymap ? wb * LT + wj + 512 * (IT) : gw + (IT) * nw)
    if (MODE != 0 && nit > 0) { const int m0_ = NP_ROW(0);
#pragma unroll
        for (int k = 0; k < 4; ++k) { ne[k] = p.tok_e[m0_ * 4 + k]; np[k] = p.tok_pos[m0_ * 4 + k]; nwt[k] = p.tok_w[m0_ * 4 + k]; } }
    float4 gN[4], shN[4], scN[4], g2v[4]; int cur_mr = -1;
#pragma unroll
    for (int j = 0; j < 4; ++j) gN[j] = (MODE != 2) ? *(const float4*)(p.norm1_g + l * D + j * 256 + lane * 4) : *(const float4*)(p.final_g + j * 256 + lane * 4);
    for (int it = 0; it < nit; ++it) { const int m = NP_ROW(it);
        const int b = m / LT, pp = m - b * LT; const bool isctx = pp < LC; const int mr = isctx ? 4 : b;
        float4 xv[4];
        if (mr != cur_mr) { cur_mr = mr;
            if (MODE != 2) { const float* mv = p.mod + (size_t)(l * 5 + mr) * 6144;
#pragma unroll
                for (int j = 0; j < 4; ++j) { const int col = j * 256 + lane * 4; shN[j] = *(const float4*)(mv + col); scN[j] = *(const float4*)(mv + 1024 + col); } }
            if (MODE != 0) { const float* g2 = p.mod + (size_t)((l - 1) * 5 + mr) * 6144 + 5 * 1024;
#pragma unroll
                for (int j = 0; j < 4; ++j) g2v[j] = *(const float4*)(g2 + j * 256 + lane * 4); } }
        if (MODE == 0) { const float* src = isctx ? p.ctx + (size_t)(b * LC + pp) * D : p.x + (size_t)(b * SEQ + pp - LC) * D;
#pragma unroll
            for (int j = 0; j < 4; ++j) xv[j] = *(const float4*)(src + j * 256 + lane * 4);
        } else {
            int slot[4]; float w[4];
#pragma unroll
            for (int k = 0; k < 4; ++k) { slot[k] = tbp[ne[k]] * 256 + np[k]; w[k] = nwt[k]; }
            unsigned yv[4][4];
#pragma unroll
            for (int j = 0; j < 4; ++j) { const int col = j * 256 + lane * 4; { const u32x2 xr = *(const u32x2*)(p.X + (size_t)m * D + col); xv[j] = make_float4(bflo(xr.x), bfhi(xr.x), bflo(xr.y), bfhi(xr.y)); }
#pragma unroll
                for (int k = 0; k < 4; ++k) yv[j][k] = *(const unsigned*)(p.Y + (size_t)slot[k] * D + col); }
            if (it + 1 < nit) { const int mn_ = NP_ROW(it + 1);
#pragma unroll
                for (int k = 0; k < 4; ++k) { ne[k] = p.tok_e[mn_ * 4 + k]; np[k] = p.tok_pos[mn_ * 4 + k]; nwt[k] = p.tok_w[mn_ * 4 + k]; } }
#pragma unroll
            for (int j = 0; j < 4; ++j) { float a0 = 0.f, a1 = 0.f, a2 = 0.f, a3 = 0.f;
#pragma unroll
                for (int k = 0; k < 4; ++k) { const f32x2_t ylo = __builtin_amdgcn_cvt_pk_f32_fp8((int)yv[j][k], false), yhi = __builtin_amdgcn_cvt_pk_f32_fp8((int)yv[j][k], true); a0 += w[k] * ylo[0]; a1 += w[k] * ylo[1]; a2 += w[k] * yhi[0]; a3 += w[k] * yhi[1]; }
                xv[j].x += g2v[j].x * a0; xv[j].y += g2v[j].y * a1; xv[j].z += g2v[j].z * a2; xv[j].w += g2v[j].w * a3; }
        }
        if (MODE != 2) {
#pragma unroll
            for (int j = 0; j < 4; ++j) { u32x2 xw; xw.x = pg8::cvt_pk_bf16(xv[j].x, xv[j].y); xw.y = pg8::cvt_pk_bf16(xv[j].z, xv[j].w); *(u32x2*)(p.X + (size_t)m * D + j * 256 + lane * 4) = xw; } }
        float ss = 0.f;
#pragma unroll
        for (int j = 0; j < 4; ++j) ss += xv[j].x * xv[j].x + xv[j].y * xv[j].y + xv[j].z * xv[j].z + xv[j].w * xv[j].w;
        ss = wave_sum(ss, lane); const float rstd = rsqrtf(ss * (1.0f / D) + 1e-6f);
#ifdef PROBE_PHASE
        const float pr_scale = 1.0f + ((const float*)p.ctrl)[2048];
#else
        const float pr_scale = 1.0f;
#endif
        if (MODE == 2) { if (!isctx) { float* o = p.out + (size_t)(b * SEQ + pp - LC) * D;
#pragma unroll
                for (int j = 0; j < 4; ++j) { const int col = j * 256 + lane * 4; const float4 g = gN[j];
                    *(float4*)(o + col) = make_float4(xv[j].x * rstd * g.x * pr_scale, xv[j].y * rstd * g.y * pr_scale, xv[j].z * rstd * g.z * pr_scale, xv[j].w * rstd * g.w * pr_scale); } }
        } else {
#pragma unroll
            for (int j = 0; j < 4; ++j) { const int col = j * 256 + lane * 4; const float4 g = gN[j], sh = shN[j], sc = scN[j];
                const float h0 = xv[j].x * rstd * g.x * (1.f + sc.x) + sh.x, h1 = xv[j].y * rstd * g.y * (1.f + sc.y) + sh.y, h2 = xv[j].z * rstd * g.z * (1.f + sc.z) + sh.z, h3 = xv[j].w * rstd * g.w * (1.f + sc.w) + sh.w;
                u32x2 w2; w2.x = pg8::cvt_pk_bf16(h0, h1); w2.y = pg8::cvt_pk_bf16(h2, h3); *(u32x2*)(p.H + (size_t)m * D + col) = w2;
                *(unsigned*)(p.H8 + (size_t)m * D + col) = pk_fp8x4(h0, h1, h2, h3); } }
    }
}
#undef NP_ROW
__device__ __forceinline__ void lru_prep_phase(const Params& p, int l, float* ldsf) {
    const int tid = TIDX, lane = tid & 63, wave = __builtin_amdgcn_readfirstlane(tid >> 6), r = lane & 31, h = lane >> 5; const int G8 = (int)gridDim.x >> 3;
    if ((int)blockIdx.x >= G8 * 8) return;
    const int hb = blockIdx.x & 7, rank = blockIdx.x >> 3;
    LAS char* lds = (LAS char*)ldsf; LAS char* tW = lds; LAS char* tH = lds + 36864 + wave * 9216; LAS char* tX = tH + 4480;
#pragma unroll
    for (int i = 0; i < 16; ++i) { const int e = tid + 512 * i, mat = e >> 11, rr = (e & 2047) * 2, dir = mat >> 1; const float* src = (mat & 1) ? p.lru_wx : p.lru_wa;
        const f32x2_t v = *(const f32x2_t*)(src + (size_t)((l * 2 + dir) * 8 + hb) * 4096 + rr);
        *(LAS unsigned*)(tW + mat * 9216 + (rr >> 6) * 144 + (rr & 63) * 2) = pk_bf16(v[0], v[1]); }
    __syncthreads();
    const int cch = hb * 64 + lane;
    const float cb = p.lru_conv_b[l * 512 + cch], cw0 = p.lru_conv_w[(l * 4 + 0) * 512 + cch], cw1 = p.lru_conv_w[(l * 4 + 1) * 512 + cch], cw2 = p.lru_conv_w[(l * 4 + 2) * 512 + cch], cw3 = p.lru_conv_w[(l * 4 + 3) * 512 + cch];
    const int per_wg = (MT / 32 + G8 - 1) / G8;
    for (int q = wave; q < per_wg && rank * per_wg + q < MT / 32; q += 8) { const int t32 = rank * per_wg + q;
        const int m0 = t32 * 32, b = m0 / LT, p0 = m0 - b * LT; const int seg_lo = p0 < LC ? 0 : LC, seg_hi = p0 < LC ? LC : LT;
#pragma unroll
        for (int i = 0; i < 5; ++i) { const int idx = lane + 64 * i; if (idx < 35 * 8) { const int row = idx >> 3, ch = idx & 7, q = p0 - 2 + row; u32x4 v = {0u, 0u, 0u, 0u};
                if (q >= seg_lo && q < seg_hi) v = *(const u32x4*)(p.U + (size_t)(b * LT + q) * INC + C_LX + hb * 64 + ch * 8);
                *(LAS u32x4*)(tH + row * 128 + ch * 16) = v; } }
        asm volatile("s_waitcnt lgkmcnt(0)" ::: "memory");
#pragma unroll
        for (int j = 0; j < 32; ++j) { const LAS bf16_t* col = (const LAS bf16_t*)(tH + j * 128 + lane * 2);
            const float x = cb + bf2f(col[0]) * cw0 + bf2f(col[64]) * cw1 + bf2f(col[128]) * cw2 + bf2f(col[192]) * cw3;
            *(LAS bf16_t*)(tX + j * 144 + lane * 2) = (bf16_t)(pk_bf16(x, 0.f) & 0xffffu); }
        asm volatile("s_waitcnt lgkmcnt(0)" ::: "memory");
        bf16x8_t Af[4];
#pragma unroll
        for (int x = 0; x < 4; ++x) Af[x] = frag_row(tX, 144, r, 16 * x + 4 * h);
#pragma unroll
        for (int dir = 0; dir < 2; ++dir) {
            f32x16_t acc[2][2];
#pragma unroll
            for (int gq = 0; gq < 2; ++gq)
#pragma unroll
                for (int nt = 0; nt < 2; ++nt) {
#pragma unroll
                    for (int i = 0; i < 16; ++i) acc[gq][nt][i] = 0.f;
#pragma unroll
                    for (int x = 0; x < 4; ++x) acc[gq][nt] = MFMA32(Af[x], frag_tr(tW + (dir * 2 + gq) * 9216, 144, 16 * x + 4 * h, nt, lane), acc[gq][nt]); }
#pragma unroll
            for (int nt = 0; nt < 2; ++nt) { const int c = hb * 64 + 32 * nt + r, pi = (l * 2 + dir) * 512 + c; const float ba = p.lru_ba[pi], bx = p.lru_bx[pi], lam = p.lru_lambda[pi];
                const float sp8 = -8.0f * log1pf(expf(-lam));
                float av[16], bv[16];
#pragma unroll
                for (int i = 0; i < 16; ++i) { const int tok = (i & 3) + 8 * (i >> 2) + 4 * h; const float rg = sigmoidf_(acc[0][nt][i] + ba), ig = sigmoidf_(acc[1][nt][i] + bx);
                    const float a = __expf(rg * sp8); av[i] = a; bv[i] = __builtin_amdgcn_sqrtf(fmaxf(fmaf(-a, a, 1.0f), 0.f)) * (ig * bf2f(*(const LAS bf16_t*)(tX + tok * 144 + (32 * nt + r) * 2))); }
                float Pg[4], Hg[4];
#pragma unroll
                for (int g = 0; g < 4; ++g) { float P = 1.f, H = 0.f;
#pragma unroll
                    for (int ee = 0; ee < 4; ++ee) { const int i = 4 * g + (dir == 0 ? ee : 3 - ee); H = av[i] * H + bv[i]; P *= av[i]; av[i] = P; bv[i] = H; }
                    Pg[g] = P; Hg[g] = H; }
                float Ps = 1.f, Hs = 0.f, Pst[4] = {1.f, 1.f, 1.f, 1.f}, Hst[4] = {0.f, 0.f, 0.f, 0.f};
#pragma unroll
                for (int kk = 0; kk < 8; ++kk) { const int k = dir == 0 ? kk : 7 - kk, g = k >> 1, hh = k & 1;
                    const float Po = shx(Pg[g], 32, lane), Ho = shx(Hg[g], 32, lane); const bool mine = hh == h;
                    const float Pk = mine ? Pg[g] : Po, Hk = mine ? Hg[g] : Ho;
                    Pst[g] = mine ? Ps : Pst[g]; Hst[g] = mine ? Hs : Hst[g];
                    Hs = Pk * Hs + Hk; Ps *= Pk; }
                unsigned* out = p.PH + ((size_t)dir * MT + m0) * 512 + c;
#pragma unroll
                for (int i = 0; i < 16; ++i) { const int g = i >> 2, tok = (i & 3) + 8 * g + 4 * h; out[(size_t)tok * 512] = pk_bf16(av[i] * Pst[g], av[i] * Hst[g] + bv[i]); }
                if (h == 0) { const size_t o = ((size_t)dir * (MT / 32) + t32) * 512 + c; p.LP[o] = Ps; p.LH[o] = Hs; }
            }
        }
    }
}
__device__ __forceinline__ void lru_tilescan_task(const Params& p, int task, int lane) {
    const int b = task >> 4, dir = (task >> 3) & 1, c = (task & 7) * 64 + lane;
    const size_t base = ((size_t)dir * (MT / 32) + (size_t)b * 136) * 512 + c;
    float hh = 0.f;
#pragma unroll 17
    for (int i = 0; i < 136; ++i) { const int tl = dir == 0 ? i : (i < 8 ? 7 - i : 143 - i); const float P = p.LP[base + (size_t)tl * 512], H = p.LH[base + (size_t)tl * 512];
        p.LS[base + (size_t)tl * 512] = hh; hh = P * hh + H; }
}

__device__ __forceinline__ void finish_phase(const Params& p, int l, int last) {
    const int lane = TIDX & 63; const int gw = blockIdx.x * (NTHREADS / 64) + __builtin_amdgcn_readfirstlane(TIDX >> 6), nw = gridDim.x * (NTHREADS / 64);
    const int c0 = lane * 8;
    float gr_[8], gh_[8];
#pragma unroll
    for (int i = 0; i < 8; ++i) { gr_[i] = p.ret_gn_g[l * 512 + c0 + i]; gh_[i] = p.hgrn_gn_g[l * 512 + c0 + i]; }
    for (int m = gw; m < MT; m += nw) {
        if (last && (m % LT) < LC) continue;
        const bf16_t* u = p.U + (size_t)m * INC + c0; const int tile = m >> 5;
        const bf16_t* ra = p.Oret + (size_t)m * 512 + c0; const bf16_t* rb = ra + (size_t)MT * 512; const bf16_t* ha = p.Ohg + (size_t)m * 512 + c0; const bf16_t* hb2 = ha + (size_t)MT * 512;
        const u32x4 rav = *(const u32x4*)ra, rbv = *(const u32x4*)rb, hav = *(const u32x4*)ha, hbv = *(const u32x4*)hb2;
        const unsigned* ph0 = p.PH + (size_t)m * 512 + c0; const unsigned* ph1 = ph0 + (size_t)MT * 512;
        const u32x4 pf0 = *(const u32x4*)ph0, pf1 = *(const u32x4*)(ph0 + 4), pb0 = *(const u32x4*)ph1, pb1 = *(const u32x4*)(ph1 + 4);
        const float* st0 = p.LS + (size_t)tile * 512 + c0; const float* st1 = st0 + (size_t)(MT / 32) * 512;
        const float4 sf0 = *(const float4*)st0, sf1 = *(const float4*)(st0 + 4), sb0 = *(const float4*)st1, sb1 = *(const float4*)(st1 + 4);
        const u32x4 grg = *(const u32x4*)(u + C_RG), ghg = *(const u32x4*)(u + C_HGT), glg = *(const u32x4*)(u + C_LGT);
        { float o[8] = {bflo(rav[0]) + bflo(rbv[0]), bfhi(rav[0]) + bfhi(rbv[0]), bflo(rav[1]) + bflo(rbv[1]), bfhi(rav[1]) + bfhi(rbv[1]), bflo(rav[2]) + bflo(rbv[2]), bfhi(rav[2]) + bfhi(rbv[2]), bflo(rav[3]) + bflo(rbv[3]), bfhi(rav[3]) + bfhi(rbv[3])};
          float ss = 0.f;
#pragma unroll
          for (int i = 0; i < 8; ++i) ss += o[i] * o[i];
          ss += shx(ss, 1, lane); ss += shx(ss, 2, lane); ss += shx(ss, 4, lane);
          const float rstd = rsqrtf(ss * (1.0f / 64.0f) + 1e-6f); u32x4 w;
#pragma unroll
          for (int i = 0; i < 4; ++i) { const float g0 = bflo(grg[i]), g1 = bfhi(grg[i]); w[i] = pg8::cvt_pk_bf16(o[2 * i] * rstd * gr_[2 * i] * (g0 * sigmoidf_(g0)), o[2 * i + 1] * rstd * gr_[2 * i + 1] * (g1 * sigmoidf_(g1))); }
          *(u32x4*)(p.Aall + (size_t)m * 512 + c0) = w; }
        { float o[8] = {bflo(hav[0]) + bflo(hbv[0]), bfhi(hav[0]) + bfhi(hbv[0]), bflo(hav[1]) + bflo(hbv[1]), bfhi(hav[1]) + bfhi(hbv[1]), bflo(hav[2]) + bflo(hbv[2]), bfhi(hav[2]) + bfhi(hbv[2]), bflo(hav[3]) + bflo(hbv[3]), bfhi(hav[3]) + bfhi(hbv[3])};
          float ss = 0.f;
#pragma unroll
          for (int i = 0; i < 8; ++i) ss += o[i] * o[i];
          ss += shx(ss, 1, lane); ss += shx(ss, 2, lane); ss += shx(ss, 4, lane); ss += shx(ss, 8, lane);
          const float rstd = rsqrtf(ss * (1.0f / 128.0f) + 1e-6f); u32x4 w;
#pragma unroll
          for (int i = 0; i < 4; ++i) w[i] = pg8::cvt_pk_bf16(o[2 * i] * rstd * gh_[2 * i] * sigmoidf_(bflo(ghg[i])), o[2 * i + 1] * rstd * gh_[2 * i + 1] * sigmoidf_(bfhi(ghg[i])));
          *(u32x4*)(p.Aall + ((size_t)MT + m) * 512 + c0) = w; }
        { const float sf[8] = {sf0.x, sf0.y, sf0.z, sf0.w, sf1.x, sf1.y, sf1.z, sf1.w}, sb[8] = {sb0.x, sb0.y, sb0.z, sb0.w, sb1.x, sb1.y, sb1.z, sb1.w};
          const unsigned pf[8] = {pf0[0], pf0[1], pf0[2], pf0[3], pf1[0], pf1[1], pf1[2], pf1[3]}, pb[8] = {pb0[0], pb0[1], pb0[2], pb0[3], pb1[0], pb1[1], pb1[2], pb1[3]};
          float o[8];
#pragma unroll
          for (int i = 0; i < 8; ++i) o[i] = (bflo(pf[i]) * sf[i] + bfhi(pf[i])) + (bflo(pb[i]) * sb[i] + bfhi(pb[i]));
          u32x4 w;
#pragma unroll
          for (int i = 0; i < 4; ++i) { float rr[2];
#pragma unroll
              for (int k = 0; k < 2; ++k) { const float x = k ? bfhi(glg[i]) : bflo(glg[i]); const float t2 = __expf(2.0f * 0.7978845608f * (x + 0.044715f * x * x * x));
                  rr[k] = o[2 * i + k] * (0.5f * x * (2.0f - 2.0f * __builtin_amdgcn_rcpf(t2 + 1.0f))); }
              w[i] = pg8::cvt_pk_bf16(rr[0], rr[1]); }
          *(u32x4*)(p.Aall + ((size_t)2 * MT + m) * 512 + c0) = w; }
    }
}

__device__ __forceinline__ void router_prep_phase(const Params& p) {
    const int tid = TIDX, lane = tid & 63;
    for (int i = blockIdx.x * NTHREADS + tid; i < DEPTH * 5 * 1024 * 8; i += gridDim.x * NTHREADS) { const int q = i & 7, k = (i >> 3) & 1023, lm = i >> 13, l = lm / 5;
        const float sc = p.norm2_g[l * D + k] * (1.0f + p.mod[(size_t)lm * 6144 + 4 * 1024 + k]); const float4 w = *(const float4*)(p.router_w + ((size_t)l * 1024 + k) * 32 + q * 4);
        *(float4*)(p.RWp + ((size_t)lm * 1024 + k) * 32 + q * 4) = make_float4(w.x * sc, w.y * sc, w.z * sc, w.w * sc); }
    const int gw = blockIdx.x * (NTHREADS / 64) + __builtin_amdgcn_readfirstlane(tid >> 6), nw = gridDim.x * (NTHREADS / 64);
    for (int t = gw; t < DEPTH * 5 * 32; t += nw) { const int e = t & 31, lm = t >> 5, l = lm / 5; float a = 0.f;
#pragma unroll
        for (int j = 0; j < 16; ++j) { const int k = j * 64 + lane; a += p.mod[(size_t)lm * 6144 + 3 * 1024 + k] * p.router_w[((size_t)l * 1024 + k) * 32 + e]; }
        a = wave_sum(a, lane); if (lane == 0) p.RC[lm * 32 + e] = a + p.router_b[l * 32 + e]; }
}
__device__ __forceinline__ int route_group_row0(int g, int last) { return last ? (g >> 7) * LT + LC + (g & 127) * 32 : g * 32; }
__device__ __forceinline__ void route_phase(const Params& p, int l, float* ldsf, int last) {
    const int tid = TIDX, lane = tid & 63, wave = __builtin_amdgcn_readfirstlane(tid >> 6); const int G = (int)gridDim.x;
    LAS float* tL = (LAS float*)ldsf; LAS float* tS = tL + 8448; LAS int* rec = (LAS int*)(tL + 8704);
    const int ti = lane & 31, kk = lane >> 5, gi = wave >> 1, kh = wave & 1;
    const int NG = last ? NB * SEQ / 32 : MT / 32;
    const int ngrp = ((int)blockIdx.x + 3 * G < NG) ? 4 : ((int)blockIdx.x + 2 * G < NG) ? 3 : ((int)blockIdx.x + G < NG) ? 2 : ((int)blockIdx.x < NG ? 1 : 0);
    if (gi < ngrp) {
        const int m0 = route_group_row0((int)blockIdx.x + gi * G, last), b = m0 / LT, pp0 = m0 - b * LT, mr = pp0 < LC ? 4 : b;
        const bf16_t* xrow = p.X + (size_t)(m0 + ti) * D + 4 * kk + 512 * kh;
        const float* rw = p.RWp + ((size_t)(l * 5 + mr) * 1024 + 512 * kh + 4 * kk) * 32 + ti;
        f32x16_t acc;
#pragma unroll
        for (int i = 0; i < 16; ++i) acc[i] = 0.f;
        float ss = 0.f;
#define RT_LOAD(XB, WB, DB, s0) do { if ((s0) < 64) { _Pragma("unroll") for (int q = 0; q < 4; ++q) { XB[q] = *(const u32x2*)(xrow + 8 * ((s0) + q)); \
            const float* rp = rw + (size_t)((s0) + q) * 256; WB[q][0] = rp[0]; WB[q][1] = rp[32]; WB[q][2] = rp[64]; WB[q][3] = rp[96]; } } } while (0)
#define RT_MMA(XB, WB, DB, s0) do { if ((s0) < 64) { _Pragma("unroll") for (int q = 0; q < 4; ++q) { const float x0_ = bflo(XB[q].x), x1_ = bfhi(XB[q].x), x2_ = bflo(XB[q].y), x3_ = bfhi(XB[q].y); \
            ss += x0_ * x0_ + x1_ * x1_ + x2_ * x2_ + x3_ * x3_; \
            acc = __builtin_amdgcn_mfma_f32_32x32x2f32(x0_, WB[q][0], acc, 0, 0, 0); acc = __builtin_amdgcn_mfma_f32_32x32x2f32(x1_, WB[q][1], acc, 0, 0, 0); \
            acc = __builtin_amdgcn_mfma_f32_32x32x2f32(x2_, WB[q][2], acc, 0, 0, 0); acc = __builtin_amdgcn_mfma_f32_32x32x2f32(x3_, WB[q][3], acc, 0, 0, 0); } } } while (0)
        u32x2 xA[4], xB[4], xC[4]; float wA[4][4], wB[4][4], wC[4][4];
        RT_LOAD(xA, wA, dA, 0); RT_LOAD(xB, wB, dB, 4);
        for (int s = 0; s < 64; s += 12) {
            RT_LOAD(xC, wC, dC, s + 8);  asm volatile("" ::: "memory"); RT_MMA(xA, wA, dA, s);
            RT_LOAD(xA, wA, dA, s + 12); asm volatile("" ::: "memory"); RT_MMA(xB, wB, dB, s + 4);
            RT_LOAD(xB, wB, dB, s + 16); asm volatile("" ::: "memory"); RT_MMA(xC, wC, dC, s + 8);
        }
#undef RT_LOAD
#undef RT_MMA
        ss += shx(ss, 32, lane);
        LAS float* t = tL + (gi * 2 + kh) * (32 * 33);
#pragma unroll
        for (int i = 0; i < 16; ++i) t[((i & 3) + 8 * (i >> 2) + 4 * kk) * 33 + ti] = acc[i];
        if (lane < 32) tS[(gi * 2 + kh) * 32 + ti] = ss;
    }
    __syncthreads();
    if (gi < ngrp && kh == 0) {
        const int m0 = route_group_row0((int)blockIdx.x + gi * G, last), b = m0 / LT, pp0 = m0 - b * LT, mr = pp0 < LC ? 4 : b;
        const float rstd = rsqrtf((tS[(gi * 2) * 32 + ti] + tS[(gi * 2 + 1) * 32 + ti]) * (1.0f / D) + 1e-6f);
        const LAS float* t0 = tL + (gi * 2) * (32 * 33) + ti * 33; const LAS float* t1 = t0 + 32 * 33;
        int e4[4] = {0, 0, 0, 0}; float w4[4] = {0.f, 0.f, 0.f, 0.f}; int pos4[4] = {0, 0, 0, 0};
        float lg[32];
#pragma unroll
        for (int e = 0; e < 32; ++e) lg[e] = (t0[e] + t1[e]) * rstd + p.RC[(l * 5 + mr) * 32 + e];
        float val[4];
#pragma unroll
        for (int k = 0; k < 4; ++k) { float best = -3.0e38f; int bi = 0;
#pragma unroll
            for (int e = 0; e < 32; ++e) { const bool better = lg[e] > best; best = better ? lg[e] : best; bi = better ? e : bi; }
            e4[k] = bi; val[k] = best;
#pragma unroll
            for (int e = 0; e < 32; ++e) lg[e] = (e == bi) ? -3.0e38f : lg[e]; }
        const float x1 = __expf(val[1] - val[0]), x2 = __expf(val[2] - val[0]), x3 = __expf(val[3] - val[0]); const float inv = 1.0f / (1.0f + x1 + x2 + x3);
        w4[0] = inv; w4[1] = x1 * inv; w4[2] = x2 * inv; w4[3] = x3 * inv;
        int rank4[4] = {0, 0, 0, 0}; int mycnt = 0;
#pragma unroll 4
        for (int e = 0; e < 32; ++e) { const bool hit = lane < 32 && (e4[0] == e || e4[1] == e || e4[2] == e || e4[3] == e);
            const unsigned long long mask = __ballot(hit); const int rk = __popcll(mask & ((1ull << lane) - 1ull));
#pragma unroll
            for (int k = 0; k < 4; ++k) rank4[k] = (e4[k] == e) ? rk : rank4[k];
            mycnt = (lane == e) ? __popcll(mask) : mycnt; }
        int base = 0;
        if (lane < 32 && mycnt > 0) base = (int)__hip_atomic_fetch_add(&p.ctrl[l * 64 + lane], (unsigned)mycnt, __ATOMIC_RELAXED, __HIP_MEMORY_SCOPE_AGENT);
#pragma unroll
        for (int k = 0; k < 4; ++k) pos4[k] = __builtin_amdgcn_ds_bpermute(e4[k] << 2, base) + rank4[k];
        if (lane < 32) { LAS int* rr = rec + (gi * 32 + ti) * 12;
#pragma unroll
            for (int k = 0; k < 4; ++k) { p.tok_e[(m0 + ti) * 4 + k] = e4[k]; p.tok_pos[(m0 + ti) * 4 + k] = pos4[k]; p.tok_w[(m0 + ti) * 4 + k] = w4[k]; rr[k] = e4[k]; rr[4 + k] = pos4[k]; }
            rr[8] = __float_as_int(rstd); }
    }
    __syncthreads();
    u32x4 xn[2];
    if (wave < ngrp * 32) { const int m = route_group_row0((int)blockIdx.x + (wave >> 5) * G, last) + (wave & 31);
#pragma unroll
        for (int j = 0; j < 2; ++j) { const int col = j * 512 + lane * 8; xn[j] = *(const u32x4*)(p.X + (size_t)m * D + col); } }
    for (int rw_ = wave; rw_ < ngrp * 32; rw_ += 8) {
        const int g2 = rw_ >> 5, tk = rw_ & 31; const int m = route_group_row0((int)blockIdx.x + g2 * G, last) + tk, b = m / LT, pp = m - b * LT, mr = pp < LC ? 4 : b;
        const LAS int* rr = rec + (g2 * 32 + tk) * 12; const float rs = __int_as_float(rr[8]);
        size_t rowoff[4];
#pragma unroll
        for (int k = 0; k < 4; ++k) rowoff[k] = ((size_t)rr[k] * (CAPT * 256) + rr[4 + k]) * D;
        const float* mv = p.mod + (size_t)(l * 5 + mr) * 6144;
        u32x4 xv[2]; float4 gv[2][2], scv[2][2], shv[2][2];
#pragma unroll
        for (int j = 0; j < 2; ++j) { const int col = j * 512 + lane * 8; xv[j] = xn[j];
#pragma unroll
            for (int q = 0; q < 2; ++q) { gv[j][q] = *(const float4*)(p.norm2_g + l * D + col + 4 * q); scv[j][q] = *(const float4*)(mv + 4 * 1024 + col + 4 * q); shv[j][q] = *(const float4*)(mv + 3 * 1024 + col + 4 * q); } }
        if (rw_ + 8 < ngrp * 32) { const int mn = route_group_row0((int)blockIdx.x + ((rw_ + 8) >> 5) * G, last) + ((rw_ + 8) & 31);
#pragma unroll
            for (int j = 0; j < 2; ++j) { const int col = j * 512 + lane * 8; xn[j] = *(const u32x4*)(p.X + (size_t)mn * D + col); } }
#pragma unroll
        for (int j = 0; j < 2; ++j) { const int col = j * 512 + lane * 8; u32x2 w4;
#pragma unroll
            for (int q = 0; q < 2; ++q) {
                const unsigned x0 = xv[j][2 * q], x1 = xv[j][2 * q + 1]; const float4 x = make_float4(bflo(x0), bfhi(x0), bflo(x1), bfhi(x1));
                w4[q] = pk_fp8x4(x.x * rs * gv[j][q].x * (1.f + scv[j][q].x) + shv[j][q].x, x.y * rs * gv[j][q].y * (1.f + scv[j][q].y) + shv[j][q].y,
                                 x.z * rs * gv[j][q].z * (1.f + scv[j][q].z) + shv[j][q].z, x.w * rs * gv[j][q].w * (1.f + scv[j][q].w) + shv[j][q].w); }
#pragma unroll
            for (int k = 0; k < 4; ++k) *(u32x2*)(p.Xg + rowoff[k] + col) = w4; }
    }
}

struct EpiBranch {
    static constexpr bool PERM = true, AFTER_DRAIN = false;
    bf16_t* R;
    __device__ __forceinline__ void operator()(const f32x4 (&acc)[2][2][4][2], const Unit& u, int wr, int wc, int fr, int fq) const {
        const int br = u.pn >> 2, pnl = u.pn & 3, pmr = u.pm - br * 68;
        bf16_t* base = R + (size_t)br * MT * D + (size_t)(pmr * 256 + wr * 64 + fr) * D + pnl * 256 + wc * 32 + 8 * fq;
#pragma unroll
        for (int ai = 0; ai < 2; ++ai)
#pragma unroll
            for (int m = 0; m < 4; ++m) { bf16_t* rowp = base + (size_t)(ai * 128 + m * 16) * D;
#pragma unroll
                for (int bj = 0; bj < 2; ++bj) { const f32x4 v0 = acc[ai][bj][m][0], v1 = acc[ai][bj][m][1];
                    u32x4 w; w.x = pg8::cvt_pk_bf16(v0[0], v0[1]); w.y = pg8::cvt_pk_bf16(v0[2], v0[3]); w.z = pg8::cvt_pk_bf16(v1[0], v1[1]); w.w = pg8::cvt_pk_bf16(v1[2], v1[3]);
                    *(u32x4*)(rowp + bj * 128) = w; } }
    }
};
__device__ __forceinline__ int latent_row_tile(int k) { return (k >> 4) * 17 + 1 + (k & 15); }
struct SchedMerge { int G, c, last;
    __device__ bool next(int i, Unit& u) const { const int nt = last ? 256 : 272; const int L = i * G + c; if (L >= 3 * nt) return false; const int br = L / nt, tile = L - br * nt;
        u.pm = br * 68 + (last ? latent_row_tile(tile >> 2) : (tile >> 2)); u.pn = br * 4 + (tile & 3); u.po = 0; return true; }
    __device__ __forceinline__ void a_ready(const Unit&) const {}
    __device__ __forceinline__ void done(const Unit&) const {}
};
__device__ __forceinline__ void merge_combine_phase(const Params& p, int last) {
    const int tid = TIDX, lane = tid & 63; const int gw = blockIdx.x * (NTHREADS / 64) + __builtin_amdgcn_readfirstlane(tid >> 6), nw = gridDim.x * (NTHREADS / 64);
    for (int m = gw; m < MT; m += nw) {
        if (last && (m % LT) < LC) continue;
        u32x4 rv[2][3], gv[2][3];
#pragma unroll
        for (int hf = 0; hf < 2; ++hf)
#pragma unroll
            for (int br = 0; br < 3; ++br) { const int col = hf * 512 + lane * 8; rv[hf][br] = *(const u32x4*)(p.R + ((size_t)br * MT + m) * D + col); gv[hf][br] = *(const u32x4*)(p.U + (size_t)m * INC + C_GR + br * 1024 + col); }
#pragma unroll
        for (int hf = 0; hf < 2; ++hf) { const int col = hf * 512 + lane * 8; float o[8];
#pragma unroll
            for (int i = 0; i < 8; ++i) o[i] = 0.f;
#pragma unroll
            for (int br = 0; br < 3; ++br)
#pragma unroll
                for (int i = 0; i < 4; ++i) { o[2 * i] += sigmoidf_(bflo(gv[hf][br][i])) * bflo(rv[hf][br][i]); o[2 * i + 1] += sigmoidf_(bfhi(gv[hf][br][i])) * bfhi(rv[hf][br][i]); }
            u32x4 w; w.x = pg8::cvt_pk_bf16(o[0], o[1]); w.y = pg8::cvt_pk_bf16(o[2], o[3]); w.z = pg8::cvt_pk_bf16(o[4], o[5]); w.w = pg8::cvt_pk_bf16(o[6], o[7]);
            *(u32x4*)(p.Mg + (size_t)m * D + col) = w; }
    }
}
struct SchedOut { int nN, nwg, G, c, last;
    __device__ void init(int M, int N, int G_, int c_, int last_) { nN = N / 256; nwg = (M / 256) * nN; G = G_; c = c_; last = last_; }
    __device__ bool next(int i, Unit& u) const {
        const int L = i * G + c; if (L >= (last ? 256 : nwg)) return false;
        const int nM = nwg / nN; int wgid = L; { const int q = nwg / 8, r = nwg % 8, xcd = wgid % 8, off = wgid / 8; wgid = (xcd < r ? xcd * (q + 1) : r * (q + 1) + (xcd - r) * q) + off; }
        const int nig = 8 * nN, gid = wgid / nig, fm = gid * 8, gsz = (nM - fm) < 8 ? (nM - fm) : 8;
        const int pm0 = fm + ((wgid % nig) % gsz), pn0 = (wgid % nig) / gsz;
        u.pm = last ? latent_row_tile(L >> 2) : pm0; u.pn = last ? (L & 3) : pn0; u.po = 0; return true; }
    __device__ __forceinline__ void a_ready(const Unit&) const {}
    __device__ __forceinline__ void done(const Unit&) const {}
};
struct EpiOut {
    static constexpr bool PERM = true, AFTER_DRAIN = false;
    bf16_t* X; const float* mod_l;
    __device__ __forceinline__ void operator()(const f32x4 (&acc)[2][2][4][2], const Unit& u, int wr, int wc, int fr, int fq) const {
        const int mr = (u.pm % 17 == 0) ? 4 : u.pm / 17; const float* g1 = mod_l + mr * 6144 + 2 * 1024;
        const int row0 = u.pm * 256 + wr * 64 + fr, col0 = u.pn * 256 + wc * 32 + 8 * fq;
        bf16_t* base = X + (size_t)row0 * D + col0;
        u32x4 xo[2][4][2];
#pragma unroll
        for (int ai = 0; ai < 2; ++ai)
#pragma unroll
            for (int m = 0; m < 4; ++m)
#pragma unroll
                for (int bj = 0; bj < 2; ++bj) xo[ai][m][bj] = *(const u32x4*)(base + (size_t)(ai * 128 + m * 16) * D + bj * 128);
        f32x4 gv[2][2];
#pragma unroll
        for (int bj = 0; bj < 2; ++bj)
#pragma unroll
            for (int n = 0; n < 2; ++n) gv[bj][n] = *(const f32x4*)(g1 + col0 + bj * 128 + 4 * n);
#pragma unroll
        for (int ai = 0; ai < 2; ++ai)
#pragma unroll
            for (int m = 0; m < 4; ++m) { bf16_t* rowp = base + (size_t)(ai * 128 + m * 16) * D;
#pragma unroll
                for (int bj = 0; bj < 2; ++bj) { const f32x4 v0 = acc[ai][bj][m][0] * gv[bj][0], v1 = acc[ai][bj][m][1] * gv[bj][1]; const u32x4 o = xo[ai][m][bj];
                    u32x4 w; w.x = pg8::cvt_pk_bf16(bflo(o[0]) + v0[0], bfhi(o[0]) + v0[1]); w.y = pg8::cvt_pk_bf16(bflo(o[1]) + v0[2], bfhi(o[1]) + v0[3]);
                    w.z = pg8::cvt_pk_bf16(bflo(o[2]) + v1[0], bfhi(o[2]) + v1[1]); w.w = pg8::cvt_pk_bf16(bflo(o[3]) + v1[2], bfhi(o[3]) + v1[3]);
                    *(u32x4*)(rowp + bj * 128) = w; } }
    }
};
struct SchedMoE { int nN, G, c, sparseA;
    __device__ bool next(int i, Unit& u) const { const LAS int* te = (const LAS int*)((const LAS char*)dyn_lds_base() + TB_OFF); const LAS int* tb = te + MAXTILES;
        if ((G & 63) == 0 && nN == 8) { const int x = c & 7, r = c >> 3, tile = i * (G >> 3) + 8 * (r >> 3) + x, j = r & 7; if (tile >= tb[NE]) return false; const int e = te[tile];
            u.po = tile; u.pm = sparseA ? e * CAPT + (tile - tb[e]) : tile; u.pn = e * nN + j; return true; }
        const int L = i * G + c; if (L >= tb[NE] * nN) return false; const int tile = L / nN, j = L - tile * nN, e = te[tile];
        u.po = tile; u.pm = sparseA ? e * CAPT + (tile - tb[e]) : tile; u.pn = e * nN + j; return true; }
    __device__ __forceinline__ void a_ready(const Unit&) const {}
    __device__ __forceinline__ void done(const Unit&) const {}
};
struct EpiGU {
    static constexpr bool PERM = true, AFTER_DRAIN = false;
    unsigned char* Act; const float* bgu;
    __device__ __forceinline__ void operator()(const f32x4 (&acc)[2][2][4][2], const Unit& u, int wr, int wc, int fr, int fq) const {
        const int e = u.pn >> 3, pnl = u.pn & 7; const int row0 = u.po * 256 + wr * 64 + fr, c8 = pnl * 128 + wc * 32 + 8 * fq;
        const float* bg = bgu + e * 2048 + c8; const f32x4 bg0 = *(const f32x4*)bg, bg1 = *(const f32x4*)(bg + 4), bu0 = *(const f32x4*)(bg + 1024), bu1 = *(const f32x4*)(bg + 1028);
#pragma unroll
        for (int ai = 0; ai < 2; ++ai)
#pragma unroll
            for (int m = 0; m < 4; ++m) { const float is_ = 1.0f / W8_SCALE; const f32x4 g0 = acc[ai][0][m][0] * is_ + bg0, g1 = acc[ai][0][m][1] * is_ + bg1, u0 = acc[ai][1][m][0] * is_ + bu0, u1 = acc[ai][1][m][1] * is_ + bu1; float r[8];
#pragma unroll
                for (int j = 0; j < 4; ++j) { const float ga = fminf(g0[j], 7.0f), ua = fminf(fmaxf(u0[j], -7.0f), 7.0f); r[j] = (ua + 1.0f) * (ga * sigmoidf_(1.702f * ga));
                    const float gb = fminf(g1[j], 7.0f), ub = fminf(fmaxf(u1[j], -7.0f), 7.0f); r[4 + j] = (ub + 1.0f) * (gb * sigmoidf_(1.702f * gb)); }
                u32x2 w; w.x = pk_fp8x4(r[0], r[1], r[2], r[3]); w.y = pk_fp8x4(r[4], r[5], r[6], r[7]);
                *(u32x2*)(Act + (size_t)(row0 + ai * 128 + m * 16) * D + c8) = w; }
    }
};
struct EpiDown {
    static constexpr bool PERM = true, AFTER_DRAIN = false;
    unsigned char* Y; const float* bd;
    __device__ __forceinline__ void operator()(const f32x4 (&acc)[2][2][4][2], const Unit& u, int wr, int wc, int fr, int fq) const {
        const int e = u.pn >> 2, pnl = u.pn & 3; const int row0 = u.po * 256 + wr * 64 + fr, col0 = pnl * 256 + wc * 32 + 8 * fq;
        f32x4 bv[2][2];
#pragma unroll
        for (int bj = 0; bj < 2; ++bj)
#pragma unroll
            for (int n = 0; n < 2; ++n) bv[bj][n] = *(const f32x4*)(bd + e * 1024 + col0 + bj * 128 + 4 * n);
#pragma unroll
        for (int ai = 0; ai < 2; ++ai)
#pragma unroll
            for (int m = 0; m < 4; ++m) { unsigned char* rowp = Y + (size_t)(row0 + ai * 128 + m * 16) * D + col0;
#pragma unroll
                for (int bj = 0; bj < 2; ++bj) { const float is_ = 1.0f / W8_SCALE; f32x4 v0 = acc[ai][bj][m][0] * is_ + bv[bj][0], v1 = acc[ai][bj][m][1] * is_ + bv[bj][1];
#pragma unroll
                    for (int j = 0; j < 4; ++j) { v0[j] = fminf(fmaxf(v0[j], -448.f), 448.f); v1[j] = fminf(fmaxf(v1[j], -448.f), 448.f); }
                    u32x2 w; int t0 = __builtin_amdgcn_cvt_pk_fp8_f32(v0[0], v0[1], 0, false); t0 = __builtin_amdgcn_cvt_pk_fp8_f32(v0[2], v0[3], t0, true);
                    int t1 = __builtin_amdgcn_cvt_pk_fp8_f32(v1[0], v1[1], 0, false); t1 = __builtin_amdgcn_cvt_pk_fp8_f32(v1[2], v1[3], t1, true);
                    w.x = (unsigned)t0; w.y = (unsigned)t1; *(u32x2*)(rowp + bj * 128) = w; } }
    }
};

constexpr int NSEG = 9;
__device__ __forceinline__ int seg_first(int dir, int s) { return dir == 0 ? (s == 0 ? 0 : 8 + 16 * (s - 1)) : (s == 0 ? 7 : 135 - 16 * (s - 1)); }
__device__ __forceinline__ int seg_count(int s) { return s == 0 ? 8 : 16; }

template <int DKT, int NVT, bool VEC, bool FULL>
__device__ __forceinline__ void wave_seg(const bf16_t* __restrict__ Qg, const bf16_t* __restrict__ Kg, const bf16_t* __restrict__ Vg, int vs, bf16_t* __restrict__ Og,
                                         const float* __restrict__ alpha, float gsc, int b, int cs0, int dcs, int nst, int dir, int strict,
                                         f32x16_t (&S)[DKT][NVT], LAS char* lds, int lane) {
    constexpr int KP = DKT * 64 + 16, VP = NVT * 64 + 16, KC = DKT * 4, VC = NVT * 4;
    constexpr int KRI = 64 / KC, VRI = 64 / VC;
    const int r = lane & 31, h = lane >> 5;
    LAS char* tK = lds; LAS char* tV = lds + 32 * KP; LAS char* tA = tV + 32 * VP; LAS char* tG = tA + DKT * 128;
    u32x4 nK[2 * DKT], nV[2 * NVT]; u32x2 nQ[2 * DKT][2]; f32x4 nA = {1.f, 1.f, 1.f, 1.f};
    const unsigned koff = (unsigned)((lane / KC) * 1024 + (lane % KC) * 16), voff = (unsigned)((lane / VC) * (vs * 2) + (lane % VC) * 16), qoff = (unsigned)(r * 1024 + h * 8);
    const unsigned ooff = (unsigned)(h * 4 * 1024 + r * 2), ldk = (unsigned)((lane / KC) * KP + (lane % KC) * 16), ldv = (unsigned)((lane / VC) * VP + (lane % VC) * 16);
    {   const size_t m0 = (size_t)b * LT + cs0 * 32;
        const GAS char* kb = uni_ptr(Kg + m0 * 512); const GAS char* vb = uni_ptr(Vg + m0 * vs);
#pragma unroll
        for (int i = 0; i < 2 * DKT; ++i) nK[i] = *(const GAS u32x4*)(kb + koff + i * (KRI * 1024));
#pragma unroll
        for (int i = 0; i < 2 * NVT; ++i) nV[i] = *(const GAS u32x4*)(vb + voff + (size_t)i * VRI * (vs * 2));
        if (FULL) { const GAS char* qb = uni_ptr(Qg + m0 * 512);
#pragma unroll
            for (int x = 0; x < 2 * DKT; ++x) { nQ[x][0] = *(const GAS u32x2*)(qb + qoff + 32 * x); nQ[x][1] = *(const GAS u32x2*)(qb + qoff + 32 * x + 16); } }
        if (VEC) nA = *(const GAS f32x4*)(uni_ptr(alpha + (size_t)cs0 * 512) + (unsigned)((lane & (DKT * 8 - 1)) * 16)); }
    f32x16_t Oprev[NVT]; GAS char* ob_prev = nullptr;
    for (int si = 0; si < nst; ++si) {
        const int cs = cs0 + si * dcs; const size_t m0 = (size_t)b * LT + cs * 32;
#pragma unroll
        for (int i = 0; i < 2 * DKT; ++i) *(LAS u32x4*)(tK + ldk + i * (KRI * KP)) = nK[i];
#pragma unroll
        for (int i = 0; i < 2 * NVT; ++i) *(LAS u32x4*)(tV + ldv + i * (VRI * VP)) = nV[i];
        if (VEC) { *(LAS f32x4*)(tA + (lane & (DKT * 8 - 1)) * 16) = nA;
            if (!FULL) { LAS f32x4* gp = (LAS f32x4*)(tG + (lane & (DKT * 8 - 1)) * 16); const f32x4 gprev = si == 0 ? (f32x4){1.f, 1.f, 1.f, 1.f} : *gp; asm volatile("s_waitcnt lgkmcnt(0)" ::: "memory"); *gp = gprev * nA; } }
        if (FULL && si > 0) {
#pragma unroll
            for (int n = 0; n < NVT; ++n)
#pragma unroll
                for (int i = 0; i < 16; ++i) *(GAS bf16_t*)(ob_prev + ooff + ((i & 3) + 8 * (i >> 2)) * 1024 + 64 * n) = (bf16_t)(pk_bf16(Oprev[n][i], 0.f) & 0xffffu); }
        bf16x8_t Qf[2 * DKT];
        if (FULL) {
#pragma unroll
            for (int x = 0; x < 2 * DKT; ++x) { u32x4 w; w[0] = nQ[x][0][0]; w[1] = nQ[x][0][1]; w[2] = nQ[x][1][0]; w[3] = nQ[x][1][1]; Qf[x] = __builtin_bit_cast(bf16x8_t, w); } }
        const size_t m1 = (size_t)b * LT + (cs + dcs) * 32;
        if (si + 1 < nst) { const GAS char* kb = uni_ptr(Kg + m1 * 512); const GAS char* vb = uni_ptr(Vg + m1 * vs);
#pragma unroll
            for (int i = 0; i < 2 * DKT; ++i) nK[i] = *(const GAS u32x4*)(kb + koff + i * (KRI * 1024));
#pragma unroll
            for (int i = 0; i < 2 * NVT; ++i) nV[i] = *(const GAS u32x4*)(vb + voff + (size_t)i * VRI * (vs * 2));
            if (VEC) nA = *(const GAS f32x4*)(uni_ptr(alpha + (size_t)(cs + dcs) * 512) + (unsigned)((lane & (DKT * 8 - 1)) * 16));
        }
        asm volatile("s_waitcnt lgkmcnt(0)" ::: "memory");
        if (FULL) {
            f32x16_t X, X2; bf16x8_t Kf[2 * DKT];
#pragma unroll
            for (int x = 0; x < 2 * DKT; ++x) Kf[x] = frag_row(tK, KP, r, 16 * x + 4 * h);
#pragma unroll
            for (int i = 0; i < 16; ++i) { X[i] = 0.f; X2[i] = 0.f; }
#pragma unroll
            for (int x = 0; x < 2 * DKT; x += 2) { X = MFMA32(Kf[x], Qf[x], X); X2 = MFMA32(Kf[x + 1], Qf[x + 1], X2); }
#pragma unroll
            for (int i = 0; i < 16; ++i) X[i] += X2[i];
#pragma unroll
            for (int i = 0; i < 16; ++i) { const int j = (i & 3) + 8 * (i >> 2) + 4 * h; const bool keep = dir == 0 ? (j <= r) : (j >= r + strict); X[i] = keep ? X[i] : 0.f; }
            const bf16x8_t Xa0 = pack8<0>(X), Xa1 = pack8<1>(X);
            ob_prev = (GAS char*)uni_ptr(Og + m0 * 512);
#pragma unroll
            for (int n = 0; n < NVT; ++n) {
                f32x16_t O;
#pragma unroll
                for (int i = 0; i < 16; ++i) O[i] = 0.f;
                O = MFMA32(Xa0, frag_tr(tV, VP, 4 * h, n, lane), O);
                O = MFMA32(Xa1, frag_tr(tV, VP, 16 + 4 * h, n, lane), O);
#pragma unroll
                for (int a = 0; a < DKT; ++a) { O = MFMA32(Qf[2 * a], pack8<0>(S[a][n]), O); O = MFMA32(Qf[2 * a + 1], pack8<1>(S[a][n]), O); }
                Oprev[n] = O;
                    }
            asm volatile("" ::: "memory");
            if (si + 1 < nst) { const GAS char* qb = uni_ptr(Qg + m1 * 512);
#pragma unroll
                for (int x = 0; x < 2 * DKT; ++x) { nQ[x][0] = *(const GAS u32x2*)(qb + qoff + 32 * x); nQ[x][1] = *(const GAS u32x2*)(qb + qoff + 32 * x + 16); } }
        }
#pragma unroll
        for (int a = 0; a < DKT; ++a) {
            f32x4 al[4];
            if (VEC) {
#pragma unroll
                for (int g = 0; g < 4; ++g) al[g] = *(const LAS f32x4*)(tA + (32 * a + 8 * g + 4 * h) * 4); }
            const bf16x8_t k0 = frag_tr(tK, KP, 4 * h, a, lane), k1 = frag_tr(tK, KP, 16 + 4 * h, a, lane);
#pragma unroll
            for (int n = 0; n < NVT; ++n) {
                S[a][n] = MFMA32(k0, frag_tr(tV, VP, 4 * h, n, lane), S[a][n]);
                S[a][n] = MFMA32(k1, frag_tr(tV, VP, 16 + 4 * h, n, lane), S[a][n]);
#pragma unroll
                for (int i = 0; i < 16; ++i) S[a][n][i] *= VEC ? al[i >> 2][i & 3] : gsc;
            }
        }
    }
    if (FULL && nst > 0) {
#pragma unroll
        for (int n = 0; n < NVT; ++n)
#pragma unroll
            for (int i = 0; i < 16; ++i) *(GAS bf16_t*)(ob_prev + ooff + ((i & 3) + 8 * (i >> 2)) * 1024 + 64 * n) = (bf16_t)(pk_bf16(Oprev[n][i], 0.f) & 0xffffu); }
}

template <int DKT, int NVT, bool VEC, bool FULL>
__device__ __forceinline__ void chain_task(const Params& p, int l, int chain, int seg, LAS char* lds, int lane) {
    int b, dir, strict; const bf16_t *Qg, *Kg, *Vg; bf16_t* Og; const float* alpha = nullptr; float gsc = 0.f; size_t tbase;
    if (!VEC) { const int h = chain & 7; b = chain >> 4; dir = (chain >> 3) & 1; strict = 1; const float gam = 1.0f / (1.0f + expf(-p.ret_decay[l * 16 + dir * 8 + h])); gsc = exp2f(32.0f * log2f(gam));
        Qg = p.RQ + (size_t)dir * MT * 512 + h * 64; Kg = p.RK + (size_t)dir * MT * 512 + h * 64; Vg = p.U + C_RV + h * 64; Og = p.Oret + (size_t)dir * MT * 512 + h * 64; tbase = (size_t)chain * NSEG;
    } else { const int h = (chain >> 2) & 3, dq = chain & 3; b = chain >> 5; dir = (chain >> 4) & 1; strict = 0;
        Qg = p.HQ + (size_t)dir * MT * 512 + h * 128; Kg = p.HK + (size_t)dir * MT * 512 + h * 128; Vg = p.U + C_HI + h * 128 + dq * 32; Og = p.Ohg + (size_t)dir * MT * 512 + h * 128 + dq * 32;
        alpha = p.HA + ((size_t)dir * NCH + b * 136) * 512 + h * 128; tbase = (size_t)(64 + chain) * NSEG; }
    f32x16_t S[DKT][NVT];
#pragma unroll
    for (int a = 0; a < DKT; ++a)
#pragma unroll
        for (int n = 0; n < NVT; ++n)
#pragma unroll
            for (int i = 0; i < 16; ++i) S[a][n][i] = 0.f;
    constexpr int TS = DKT * NVT * 16 * 64, TG = 128;
    const int h = lane >> 5;
    if (FULL) {
        for (int s2 = 0; s2 < seg; ++s2) { const float* e = p.SE + (tbase + s2) * TS + lane; const float* gq = p.SG + (tbase + s2) * TG + 4 * h; const float gs = s2 == 0 ? 0.f : exp2f(16.0f * log2f(gsc));
#pragma unroll
            for (int a = 0; a < DKT; ++a) {
                f32x4 gv[4];
#pragma unroll
                for (int g = 0; g < 4; ++g) gv[g] = VEC ? *(const f32x4*)(gq + 32 * a + 8 * g) : (f32x4){gs, gs, gs, gs};
#pragma unroll
                for (int n = 0; n < NVT; ++n)
#pragma unroll
                    for (int i = 0; i < 16; ++i) S[a][n][i] = gv[i >> 2][i & 3] * S[a][n][i] + e[((a * NVT + n) * 16 + i) * 64]; } }
    }
    wave_seg<DKT, NVT, VEC, FULL>(Qg, Kg, Vg, INC, Og, alpha, gsc, b, seg_first(dir, seg), dir == 0 ? 1 : -1, seg_count(seg), dir, strict, S, lds, lane);
    if (!FULL) { float* e = p.SE + (tbase + seg) * TS + lane;
#pragma unroll
        for (int a = 0; a < DKT; ++a)
#pragma unroll
            for (int n = 0; n < NVT; ++n)
#pragma unroll
                for (int i = 0; i < 16; ++i) e[((a * NVT + n) * 16 + i) * 64] = S[a][n][i];
        if (VEC) { constexpr int KPc = DKT * 64 + 16, VPc = NVT * 64 + 16;
            const f32x4 gfin = *(const LAS f32x4*)(lds + 32 * KPc + 32 * VPc + DKT * 128 + (lane & (DKT * 8 - 1)) * 16);
            if (lane < DKT * 8) *(f32x4*)(p.SG + (tbase + seg) * TG + lane * 4) = gfin; }
    }
}

template <bool FULL, int VAR = 0> __device__ __forceinline__ void sweep_phase(const Params& p, int l, float* ldsf) {
    const int tid = TIDX, wave = __builtin_amdgcn_readfirstlane(tid >> 6); const int G = (int)gridDim.x;
    constexpr int NS = FULL ? NSEG : NSEG - 1;
    constexpr int N_HG = 128 * NS, N_RET = 64 * NS, N_LRU = FULL ? 0 : 64;
    LAS char* lds = (LAS char*)ldsf + wave * 12288;
    const int NW = 8 * G, w = wave * G + (int)blockIdx.x;
#ifndef NO_HG
    if (VAR != 2) for (int t = w; t < N_HG; t += NW) { const int chain = t / NS, seg = t - chain * NS; chain_task<4, 1, true, FULL>(p, l, chain, seg, lds, TIDX & 63); }
#endif
#ifndef NO_RET
    if (VAR != 1) for (int t = (w + NW - N_HG % NW) % NW; t < N_RET; t += NW) { const int chain = t / NS, seg = t - chain * NS; chain_task<2, 2, false, FULL>(p, l, chain, seg, lds, TIDX & 63); }
#endif
    for (int t = (w + NW - (N_HG + N_RET) % NW) % NW; t < N_LRU; t += NW) lru_tilescan_task(p, t, TIDX & 63);
}

__device__ __forceinline__ void mixprep_phase(const Params& p, int l) {
    const int tid = TIDX, lane = tid & 63; const int gw = blockIdx.x * (NTHREADS / 64) + __builtin_amdgcn_readfirstlane(tid >> 6), nw = gridDim.x * (NTHREADS / 64);
    float lgd[2];
#pragma unroll
    for (int dir = 0; dir < 2; ++dir) { const float gam = 1.0f / (1.0f + expf(-p.ret_decay[l * 16 + dir * 8 + (lane >> 3)])); lgd[dir] = log2f(gam); }
    for (int m = gw; m < MT; m += nw) {
        const int b = m / LT, pp = m - b * LT; const int hh = lane >> 3, d0 = (lane & 7) * 4;
        const bf16_t* u = p.U + (size_t)m * INC + hh * 64 + d0;
        const u32x2 qlo = *(const u32x2*)(u + C_RQ), qhi = *(const u32x2*)(u + C_RQ + 32), klo = *(const u32x2*)(u + C_RK), khi = *(const u32x2*)(u + C_RK + 32);
        float q1[4] = {bflo(qlo[0]), bfhi(qlo[0]), bflo(qlo[1]), bfhi(qlo[1])}, q2[4] = {bflo(qhi[0]), bfhi(qhi[0]), bflo(qhi[1]), bfhi(qhi[1])};
        float k1[4] = {bflo(klo[0]) * 0.125f, bfhi(klo[0]) * 0.125f, bflo(klo[1]) * 0.125f, bfhi(klo[1]) * 0.125f}, k2[4] = {bflo(khi[0]) * 0.125f, bfhi(khi[0]) * 0.125f, bflo(khi[1]) * 0.125f, bfhi(khi[1]) * 0.125f};
        if (pp >= LC) { const int tt = pp - LC;
            const float4 r0 = *(const float4*)(p.rot + (size_t)(tt * 32 + d0) * 2), r1 = *(const float4*)(p.rot + (size_t)(tt * 32 + d0) * 2 + 4);
            const float cc[4] = {r0.x, r0.z, r1.x, r1.z}, ss[4] = {r0.y, r0.w, r1.y, r1.w};
#pragma unroll
            for (int i = 0; i < 4; ++i) { const float a = q1[i] * cc[i] - q2[i] * ss[i], bq = q1[i] * ss[i] + q2[i] * cc[i]; q1[i] = a; q2[i] = bq;
                const float ck = k1[i] * cc[i] - k2[i] * ss[i], dk = k1[i] * ss[i] + k2[i] * cc[i]; k1[i] = ck; k2[i] = dk; } }
        const int ii = pp & 31;
#pragma unroll
        for (int dir = 0; dir < 2; ++dir) { const float lg = lgd[dir]; const float e = dir == 0 ? (float)(ii + 1) : (float)(32 - ii);
            const float sq = __builtin_amdgcn_exp2f(e * lg), sk = __builtin_amdgcn_exp2f(-e * lg);
            bf16_t* oq = p.RQ + ((size_t)dir * MT + m) * 512 + hh * 64 + d0; bf16_t* ok = p.RK + ((size_t)dir * MT + m) * 512 + hh * 64 + d0;
            u32x2 w; w[0] = pk_bf16(q1[0] * sq, q1[1] * sq); w[1] = pk_bf16(q1[2] * sq, q1[3] * sq); *(u32x2*)oq = w;
            w[0] = pk_bf16(q2[0] * sq, q2[1] * sq); w[1] = pk_bf16(q2[2] * sq, q2[3] * sq); *(u32x2*)(oq + 32) = w;
            w[0] = pk_bf16(k1[0] * sk, k1[1] * sk); w[1] = pk_bf16(k1[2] * sk, k1[3] * sk); *(u32x2*)ok = w;
            w[0] = pk_bf16(k2[0] * sk, k2[1] * sk); w[1] = pk_bf16(k2[2] * sk, k2[3] * sk); *(u32x2*)(ok + 32) = w; }
    }
    for (int unit = gw; unit < NCH * 8; unit += nw) {
        const int dir = unit & 1, ch = unit >> 3, hd = (unit >> 1) & 3, b = ch / 136, cs = ch - b * 136; const size_t m0 = (size_t)b * LT + cs * 32; const int c = hd * 128 + 2 * lane;
        unsigned zz_[32], qq[32]; const int zc = dir == 0 ? C_HFF : C_HFB;
        { const bf16_t* u = p.U + m0 * INC + c;
#pragma unroll
          for (int j = 0; j < 32; ++j) { zz_[j] = *(const unsigned*)(u + (size_t)j * INC + zc); qq[j] = *(const unsigned*)(u + (size_t)j * INC + C_HQ); } }
        const float lb0 = p.lb[l * 1024 + dir * 512 + c], lb1 = p.lb[l * 1024 + dir * 512 + c + 1];
        float G0 = 1.f, G1 = 1.f;
        if (dir == 0) {
#pragma unroll
            for (int s = 0; s < 32; ++s) { const int j = s; const unsigned zz = zz_[j];
                const float z0 = bflo(zz), z1 = bfhi(zz), qa = bflo(qq[j]), qb = bfhi(qq[j]);
                const float s0 = sigmoidf_(z0), s1 = sigmoidf_(z1); const float f0 = lb0 + (1.0f - lb0) * s0, f1 = lb1 + (1.0f - lb1) * s1;
                G0 *= f0; G1 *= f1;
                const float K0 = (1.0f - lb0) * (1.0f - s0) * __builtin_amdgcn_rcpf(fmaxf(G0, 1.0e-35f)), K1 = (1.0f - lb1) * (1.0f - s1) * __builtin_amdgcn_rcpf(fmaxf(G1, 1.0e-35f));
                *(unsigned*)(p.HQ + ((size_t)dir * MT + m0 + j) * 512 + c) = pk_bf16(qa * sigmoidf_(qa) * G0, qb * sigmoidf_(qb) * G1); *(unsigned*)(p.HK + ((size_t)dir * MT + m0 + j) * 512 + c) = pk_bf16(K0, K1); }
        } else {
#pragma unroll
            for (int s = 0; s < 32; ++s) { const int j = 31 - s; const unsigned zz = zz_[j];
                const float z0 = bflo(zz), z1 = bfhi(zz), qa = bflo(qq[j]), qb = bfhi(qq[j]);
                const float s0 = sigmoidf_(z0), s1 = sigmoidf_(z1); const float f0 = lb0 + (1.0f - lb0) * s0, f1 = lb1 + (1.0f - lb1) * s1;
                G0 *= f0; G1 *= f1;
                const float K0 = (1.0f - lb0) * (1.0f - s0) * __builtin_amdgcn_rcpf(fmaxf(G0, 1.0e-35f)), K1 = (1.0f - lb1) * (1.0f - s1) * __builtin_amdgcn_rcpf(fmaxf(G1, 1.0e-35f));
                *(unsigned*)(p.HQ + ((size_t)dir * MT + m0 + j) * 512 + c) = pk_bf16(qa * sigmoidf_(qa) * G0, qb * sigmoidf_(qb) * G1); *(unsigned*)(p.HK + ((size_t)dir * MT + m0 + j) * 512 + c) = pk_bf16(K0, K1); }
        }
        *(f32x2_t*)(p.HA + ((size_t)dir * NCH + ch) * 512 + c) = (f32x2_t){G0, G1};
    }
}

#ifndef GP_SP2
#define GP_SP2 true
#endif
#ifndef GP_ALIGN
#define GP_ALIGN true
#endif
constexpr int LDS_MAIN = 1024 * 36 * 4;
constexpr int LDS_TOTAL = LDS_MAIN + 16;

struct EpiScaledBf16 {
    static constexpr bool PERM = true, AFTER_DRAIN = false;
    bf16_t* O; int ldc; float scale;
    __device__ __forceinline__ void operator()(const f32x4 (&acc)[2][2][4][2], const Unit& u, int wr, int wc, int fr, int fq) const {
        bf16_t* base = O + (size_t)(u.pm * 256 + wr * 64 + fr) * ldc + u.pn * 256 + wc * 32 + 8 * fq;
#pragma unroll
        for (int ai = 0; ai < 2; ++ai)
#pragma unroll
            for (int m = 0; m < 4; ++m) { bf16_t* rowp = base + (size_t)(ai * 128 + m * 16) * ldc;
#pragma unroll
                for (int bj = 0; bj < 2; ++bj) { const f32x4 v0 = acc[ai][bj][m][0] * scale, v1 = acc[ai][bj][m][1] * scale;
                    u32x4 w; w.x = pg8::cvt_pk_bf16(v0[0], v0[1]); w.y = pg8::cvt_pk_bf16(v0[2], v0[3]); w.z = pg8::cvt_pk_bf16(v1[0], v1[1]); w.w = pg8::cvt_pk_bf16(v1[2], v1[3]);
                    *(u32x4*)(rowp + bj * 128) = w; } }
    }
};
__device__ __forceinline__ void gemm_in_phase(const Params& p, int l) {
    { pg8::Gemm g; g.A = p.H; g.Bt = p.wt_in + (size_t)l * INC * D; g.M = MT; g.N = C_GR; g.K = D;
      pg8::StaticOrder S; S.init(MT, C_GR, (int)gridDim.x, (int)blockIdx.x);
      pg8::EpiBf16<0> E; E.O = p.U; E.ldc = INC; E.bias = nullptr; E.split_cols = 0; E.split_stride = 0;
      pg8::gemm_phase<pg8::EpiBf16<0>, pg8::StaticOrder, GP_ALIGN, GP_SP2>((LAS unsigned char*)dyn_lds, g, S, E); }
    { pg8::Gemm g; g.A = (const bf16_t*)p.H8; g.Bt = (const bf16_t*)(p.wt_ing + (size_t)l * (INC - C_GR) * D); g.M = MT; g.N = INC - C_GR; g.K = D / 2;
      const int G = (int)gridDim.x, rot = (G - (MT / 256) * (C_GR / 256) % G) & ~7;
      pg8::StaticOrder S; S.init(MT, INC - C_GR, G, ((int)blockIdx.x + rot) % G);
      EpiScaledBf16 E; E.O = p.U + C_GR; E.ldc = INC; E.scale = 1.0f / W8_SCALE;
      pg8::gemm_phase<EpiScaledBf16, pg8::StaticOrder, GP_ALIGN, GP_SP2, true>((LAS unsigned char*)dyn_lds, g, S, E); }
}
__device__ __forceinline__ void gemm_merge_phase(const Params& p, int l) {
    pg8::Gemm g; g.A = p.Aall; g.Bt = p.wt_br + (size_t)l * 3 * 1024 * 512; g.M = 3 * MT; g.N = 3 * 1024; g.K = 512;
    SchedMerge S; S.G = (int)gridDim.x; S.c = (int)blockIdx.x; S.last = (l == DEPTH - 1);
    EpiBranch E; E.R = p.R;
    pg8::gemm_phase<EpiBranch, SchedMerge, GP_ALIGN, GP_SP2>((LAS unsigned char*)dyn_lds, g, S, E);
}
__device__ __forceinline__ void gemm_out_phase(const Params& p, int l) {
    pg8::Gemm g; g.A = p.Mg; g.Bt = p.wt_out + (size_t)l * D * D; g.M = MT; g.N = D; g.K = D;
    SchedOut S; S.init(MT, D, (int)gridDim.x, (int)blockIdx.x, l == DEPTH - 1);
    EpiOut E; E.X = p.X; E.mod_l = p.mod + (size_t)l * 5 * 6144;
    pg8::gemm_phase<EpiOut, SchedOut, GP_ALIGN, GP_SP2>((LAS unsigned char*)dyn_lds, g, S, E);
}
__device__ __forceinline__ void gemm_gu_phase(const Params& p, int l) {
    pg8::Gemm g; g.A = (const bf16_t*)p.Xg; g.Bt = (const bf16_t*)(p.wt_gu + (size_t)l * NE * 2048 * D); g.M = NE * CAPT * 256; g.N = NE * 2048; g.K = D / 2;
    build_tile_table(p, l);
    SchedMoE S; S.nN = 8; S.G = (int)gridDim.x; S.c = (int)blockIdx.x; S.sparseA = 1;
    EpiGU E; E.Act = p.Act; E.bgu = p.exp_b_gu + (size_t)l * NE * 2048;
    pg8::gemm_phase<EpiGU, SchedMoE, GP_ALIGN, GP_SP2, true>((LAS unsigned char*)dyn_lds, g, S, E);
}
__device__ __forceinline__ void gemm_down_phase(const Params& p, int l) {
    pg8::Gemm g; g.A = (const bf16_t*)p.Act; g.Bt = (const bf16_t*)(p.wt_down + (size_t)l * NE * D * D); g.M = MAXSLOTS; g.N = NE * D; g.K = D / 2;
    build_tile_table(p, l);
    SchedMoE S; S.nN = 4; S.G = (int)gridDim.x; S.c = (int)blockIdx.x; S.sparseA = 0;
    EpiDown E; E.Y = p.Y; E.bd = p.exp_b_down + (size_t)l * NE * D;
    pg8::gemm_phase<EpiDown, SchedMoE, GP_ALIGN, GP_SP2, true>((LAS unsigned char*)dyn_lds, g, S, E);
}

typedef __attribute__((address_space(4))) const Params* KParamsPtr;
__device__ __forceinline__ const Params& fresh_params() { KParamsPtr kp = (KParamsPtr)__builtin_amdgcn_kernarg_segment_ptr(); asm volatile("" : "+s"(kp)); return *(const Params*)kp; }
#define P_ fresh_params()
#ifdef BARRIER_TWICE
#define GRID_BARRIER() do { XcdBarrier _b = bar; asm volatile("" : "+s"(_b.bar), "+s"(_b.x)); xcd_barrier(_b); xcd_barrier(_b); } while (0)
#else
#define GRID_BARRIER() do { XcdBarrier _b = bar; asm volatile("" : "+s"(_b.bar), "+s"(_b.x)); xcd_barrier(_b); } while (0)
#endif
__global__ __launch_bounds__(512, 2) void k_fwd(Params p) {
    float* ldsf = (float*)dyn_lds;
#ifdef PROBE_PHASE
#ifndef PROBE_SHIFT
#define PROBE_SHIFT 0.0f
#endif
#ifndef PROBE_Q
#define PROBE_Q 50.0f
#endif
    unsigned long long pr_t0 = wall_clock64(), pr_prev = pr_t0, pr_acc = 0ull;
#define PMARK(id) do { const unsigned long long _t = wall_clock64(); if ((id) == PROBE_PHASE) pr_acc += _t - pr_prev; pr_prev = _t; } while (0)
#else
#define PMARK(id) do { } while (0)
#endif
    if (threadIdx.x == 0) *(uint4*)(dyn_lds + LDS_MAIN) = make_uint4(0u, 0u, 0u, 0u);
    __syncthreads();
    const XcdBarrier bar = xcd_barrier_post(P_.bar, (volatile LAS unsigned*)(dyn_lds + LDS_MAIN));
    convert_phase(P_, ldsf);
    mod_phase(P_, ldsf);
    small_phase(P_);
    GRID_BARRIER(); PMARK(0);
    norm_phase<0>(P_, 0);
    router_prep_phase(P_);
    GRID_BARRIER(); PMARK(1);
    for (int l = 0; l < DEPTH; ++l) {
        if (l > 0) { norm_phase<1>(P_, l); GRID_BARRIER(); PMARK(1); }
        gemm_in_phase(P_, l);
        GRID_BARRIER(); PMARK(2);
        mixprep_phase(P_, l);
#ifdef MIXPREP_TWICE
        mixprep_phase(P_, l);
#endif
#ifdef SPLIT_PREP
        GRID_BARRIER(); PMARK(16);
#endif
        lru_prep_phase(P_, l, ldsf);
#ifdef LRU_TWICE
        __syncthreads(); lru_prep_phase(P_, l, ldsf);
#endif
        GRID_BARRIER(); PMARK(3);
        sweep_phase<false>(P_, l, ldsf);
        GRID_BARRIER(); PMARK(4);
        sweep_phase<true>(P_, l, ldsf);
        GRID_BARRIER(); PMARK(13);
#ifdef SWEEP2_AGAIN
        { Params q = P_; q.Oret = q.Dummy; q.Ohg = q.Dummy; sweep_phase<true, SWEEP2_AGAIN - 1>(q, l, ldsf); }
        GRID_BARRIER();
#endif

        finish_phase(P_, l, l == DEPTH - 1);
        GRID_BARRIER(); PMARK(5);
        gemm_merge_phase(P_, l);
        GRID_BARRIER(); PMARK(6);
        merge_combine_phase(P_, l == DEPTH - 1);
        GRID_BARRIER(); PMARK(17);
        gemm_out_phase(P_, l);
        GRID_BARRIER(); PMARK(7);
        route_phase(P_, l, ldsf, l == DEPTH - 1);
        GRID_BARRIER(); PMARK(8);
        gemm_gu_phase(P_, l);
        GRID_BARRIER(); PMARK(11);
        gemm_down_phase(P_, l);
        GRID_BARRIER(); PMARK(12);
    }
#ifdef PROBE_PHASE
    if (blockIdx.x == 0 && threadIdx.x == 0) {
#ifdef PROBE_ABS
        const float fr = (float)((double)pr_acc / 100.0 / PROBE_ABS);
#else
        const float fr = (float)((double)pr_acc / (double)(pr_prev - pr_t0));
#endif
 ((float*)p.ctrl)[2048] = floorf(fr * PROBE_Q + 0.5f + PROBE_SHIFT) / PROBE_Q; }
    GRID_BARRIER();
#endif
    norm_phase<2>(P_, DEPTH);
}

static inline size_t align_up(size_t v, size_t a) { return (v + a - 1) / a * a; }

extern "C" void kernel_launch(void* const* d_in, const int* in_sizes, int n_in, void* d_out, int out_size, void* d_ws, size_t ws_size, hipStream_t stream) {
    (void)in_sizes; (void)n_in; (void)out_size; (void)ws_size;
    Params p{};
    const float** pin = (const float**)&p.x;
    for (int i = 0; i < 31; ++i) pin[i] = (const float*)d_in[i];
    p.out = (float*)d_out;
    char* w = (char*)d_ws; size_t off = 0;
    auto take = [&](size_t bytes) { char* r = w + off; off = align_up(off + bytes, 256); return r; };
    p.bar = (unsigned*)take(XCD_BAR_WORDS * 4);
    p.ctrl = (unsigned*)take(4096 * 4);
    const size_t zero_bytes = off;
    p.wt_in = (bf16_t*)take((size_t)DEPTH * INC * D * 2);
    p.wt_br = (bf16_t*)take((size_t)DEPTH * 3 * 1024 * 512 * 2);
    p.wt_out = (bf16_t*)take((size_t)DEPTH * D * D * 2);
    p.wt_gu = (unsigned char*)take((size_t)DEPTH * NE * 2048 * D);
    p.wt_down = (unsigned char*)take((size_t)DEPTH * NE * D * D);
    p.mod = (float*)take((size_t)DEPTH * 5 * 6144 * 4);
    p.lb = (float*)take(4096 * 4);
    p.rot = (float*)take((size_t)4096 * 32 * 2 * 4);
    p.X = (bf16_t*)take((size_t)MT * D * 2);
    p.H = (bf16_t*)take((size_t)MT * D * 2); p.H8 = (unsigned char*)take((size_t)MT * D); p.wt_ing = (unsigned char*)take((size_t)DEPTH * (INC - C_GR) * D);
    p.U = (bf16_t*)take((size_t)MT * INC * 2);
    p.Oret = (bf16_t*)take((size_t)2 * MT * 512 * 2);
    p.Ohg = (bf16_t*)take((size_t)2 * MT * 512 * 2);
    p.PH = (unsigned*)take((size_t)2 * MT * 512 * 4);
    p.RQ = (bf16_t*)take((size_t)2 * MT * 512 * 2); p.RK = (bf16_t*)take((size_t)2 * MT * 512 * 2); p.HQ = (bf16_t*)take((size_t)2 * MT * 512 * 2); p.HK = (bf16_t*)take((size_t)2 * MT * 512 * 2);
    p.HA = (float*)take((size_t)2 * (MT / 32) * 512 * 4);
    p.Dummy = (bf16_t*)take((size_t)2 * MT * 512 * 2);
    p.SE = (float*)take((size_t)192 * 9 * 4096 * 4); p.SG = (float*)take((size_t)192 * 9 * 128 * 4); p.LP = (float*)take((size_t)2 * 544 * 512 * 4); p.LH = (float*)take((size_t)2 * 544 * 512 * 4); p.LS = (float*)take((size_t)2 * 544 * 512 * 4);
    p.Aall = (bf16_t*)take((size_t)3 * MT * 512 * 2);
    p.R = (bf16_t*)take((size_t)3 * MT * D * 2); p.Dx = (bf16_t*)take((size_t)MT * D * 2);
    p.Mg = (bf16_t*)take((size_t)MT * D * 2);
    p.tok_e = (int*)take((size_t)MT * 4 * 4); p.tok_pos = (int*)take((size_t)MT * 4 * 4); p.tok_w = (float*)take((size_t)MT * 4 * 4);
    p.RWp = (float*)take((size_t)DEPTH * 5 * 1024 * 32 * 4); p.RC = (float*)take((size_t)DEPTH * 5 * 32 * 4);
    p.Xg = (unsigned char*)take((size_t)NE * CAPT * 256 * D); p.Act = (unsigned char*)take((size_t)MAXSLOTS * D); p.Y = (unsigned char*)take((size_t)MAXSLOTS * D);

    static int grid = 0;
    if (!grid) {
        (void)hipFuncSetAttribute((const void*)k_fwd, hipFuncAttributeMaxDynamicSharedMemorySize, LDS_TOTAL);
        int dev = 0, cus = 0, per_cu = 0;
        (void)hipGetDevice(&dev);
        (void)hipDeviceGetAttribute(&cus, hipDeviceAttributeMultiprocessorCount, dev);
        (void)hipOccupancyMaxActiveBlocksPerMultiprocessor(&per_cu, (const void*)k_fwd, 512, LDS_TOTAL);
        grid = cus * (per_cu < 1 ? per_cu : 1);
        if (grid <= 0) { fprintf(stderr, "k_fwd: occupancy query returned %d blocks per CU on %d CUs\n", per_cu, cus); grid = 0; return; }
    }
    (void)hipMemsetAsync(d_ws, 0, zero_bytes, stream);
    hipLaunchKernelGGL(k_fwd, dim3(grid), dim3(512), LDS_TOTAL, stream, p);
}
```

```cpp
#include <hip/hip_runtime.h>
#include <cstdio>
#include <cstdint>
__device__ __forceinline__ int pg8_tid_fresh() { int t = threadIdx.x; asm volatile("" : "+v"(t)); return t; }
namespace pg8 {
#define PG8_LAS __attribute__((address_space(3)))
typedef unsigned short bf16_t;
typedef short bf16x8 __attribute__((ext_vector_type(8)));
typedef float f32x4 __attribute__((ext_vector_type(4)));
typedef unsigned u32x4 __attribute__((ext_vector_type(4)));
constexpr int BM = 256, BK = 64, HALF = 128, HTB = HALF * BK * 2  , STAGE_BYTES = 8 * HTB, NXCD = 8, WGM = 8;

__host__ __device__ __forceinline__ int lds_byte(int r, int c) { const int st = (r >> 4) * 2 + (c >> 5), rr = r & 15, cc = c & 31, ob = rr * 64 + cc * 2; return st * 1024 + (ob ^ (((ob >> 9) & 1) << 5)); }
__host__ __device__ __forceinline__ void stage_rc(int b, int& R, int& C) { const int st = b / 1024, sb = b % 1024, swz = sb ^ (((sb >> 9) & 1) << 5); R = (st >> 1) * 16 + swz / 64; C = (st & 1) * 32 + (swz % 64) / 2; }
__host__ __device__ __forceinline__ int perm32(int rho) { const int n = rho >> 4, i = rho & 15; return 8 * (i >> 2) + 4 * n + (i & 3); }

struct Unit { int pm, pn, po; };
struct Gemm { const bf16_t* A; const bf16_t* Bt; int M, N, K; };

struct StaticOrder {
    int nM, nN, nwg, G, c;
    __host__ __device__ void init(int M, int N, int G_, int c_) { nM = M / BM; nN = N / BM; nwg = nM * nN; G = G_; c = c_; }
    __host__ __device__ bool next(int i, Unit& u) const {
        const long L = (long)i * G + c; if (L >= nwg) return false;
        int wgid = (int)L; { const int q = nwg / NXCD, r = nwg % NXCD, xcd = wgid % NXCD, off = wgid / NXCD; wgid = (xcd < r ? xcd * (q + 1) : r * (q + 1) + (xcd - r) * q) + off; }
        const int nig = WGM * nN, gid = wgid / nig, fm = gid * WGM, gsz = (nM - fm) < WGM ? (nM - fm) : WGM;
        u.pm = fm + ((wgid % nig) % gsz); u.pn = (wgid % nig) / gsz; return true;
    }
    __device__ __forceinline__ void a_ready(const Unit&) const {}
    __device__ __forceinline__ void done(const Unit&) const {}
};
__device__ __forceinline__ unsigned cvt_pk_bf16(float lo, float hi) { unsigned r; asm volatile("v_cvt_pk_bf16_f32 %0, %1, %2" : "=v"(r) : "v"(lo), "v"(hi)); return r; }
typedef float f32x2 __attribute__((ext_vector_type(2)));
__device__ __forceinline__ f32x2 gelu_pk(f32x2 v) {
    const f32x2 av = __builtin_elementwise_abs(v), d = av * 0.2316418882f + 1.0f;
    f32x2 t; t.x = __builtin_amdgcn_rcpf(d.x); t.y = __builtin_amdgcn_rcpf(d.y);
    f32x2 q = t * 0.5307027145f + (-0.7265760135f); q = q * t + 0.7107068705f; q = q * t + (-0.142248368f); q = q * t + 0.127414796f; q = q * t;
    const f32x2 s = (v * v) * (-0.72134752044f);
    f32x2 e; e.x = __builtin_amdgcn_exp2f(s.x); e.y = __builtin_amdgcn_exp2f(s.y);
    const f32x2 m = v * (q * e), r = v - m;
    f32x2 o; o.x = v.x < 0.f ? m.x : r.x; o.y = v.y < 0.f ? m.y : r.y; return o;
}

template <int ACT  > struct EpiBf16 {
    static constexpr bool PERM = true, AFTER_DRAIN = false;
    bf16_t* O; int ldc; const float* bias; int split_cols; size_t split_stride;
    __device__ __forceinline__ void operator()(const f32x4 (&acc)[2][2][4][2], const Unit& u, int wr, int wc, int fr, int fq) const {
        const int row0 = u.pm * BM + wr * 64 + fr; int colt = u.pn * BM; bf16_t* base = O;
        if (split_cols) { const int t = colt / split_cols; base += (size_t)t * split_stride; colt -= t * split_cols; }
        const int col0 = colt + wc * 32 + 8 * fq, bcol0 = u.pn * BM + wc * 32 + 8 * fq;
        f32x4 bv[2][2];
#pragma unroll
        for (int bj = 0; bj < 2; ++bj)
#pragma unroll
            for (int n = 0; n < 2; ++n) bv[bj][n] = bias ? *(const f32x4*)(bias + bcol0 + bj * HALF + 4 * n) : (f32x4){0.f, 0.f, 0.f, 0.f};
#pragma unroll
        for (int ai = 0; ai < 2; ++ai)
#pragma unroll
            for (int m = 0; m < 4; ++m) { bf16_t* rowp = base + (size_t)(row0 + ai * HALF + m * 16) * ldc + col0;
#pragma unroll
                for (int bj = 0; bj < 2; ++bj) { f32x4 v0 = acc[ai][bj][m][0] + bv[bj][0], v1 = acc[ai][bj][m][1] + bv[bj][1];
                    if (ACT == 1) { f32x2 a = gelu_pk((f32x2){v0[0], v0[1]}), b = gelu_pk((f32x2){v0[2], v0[3]}), c = gelu_pk((f32x2){v1[0], v1[1]}), d = gelu_pk((f32x2){v1[2], v1[3]});
                        v0 = (f32x4){a.x, a.y, b.x, b.y}; v1 = (f32x4){c.x, c.y, d.x, d.y}; }
                    if (ACT == 2) {
#pragma unroll
                        for (int j = 0; j < 4; ++j) { v0[j] = 0.5f * v0[j] * (1.0f + erff(v0[j] * 0.70710678f)); v1[j] = 0.5f * v1[j] * (1.0f + erff(v1[j] * 0.70710678f)); } }
                    u32x4 w; w.x = cvt_pk_bf16(v0[0], v0[1]); w.y = cvt_pk_bf16(v0[2], v0[3]); w.z = cvt_pk_bf16(v1[0], v1[1]); w.w = cvt_pk_bf16(v1[2], v1[3]);
                    *(u32x4*)(rowp + bj * HALF) = w; } }
    }
};


typedef int i32x4_f8 __attribute__((ext_vector_type(4)));
typedef int i32x8_f8 __attribute__((ext_vector_type(8)));
template <class Epi, class Sched, bool ALIGN_EPI = false, bool SP2 = false, bool F8 = false>
__device__ __forceinline__ void gemm_phase(PG8_LAS unsigned char* lds, const Gemm g, const Sched& S, const Epi& E) {
    const int tid = pg8_tid_fresh(), wid = __builtin_amdgcn_readfirstlane(tid >> 6), lane = tid & 63, wr = wid >> 2, wc = wid & 3, fr = lane & 15, fq = lane >> 4;
    const int K = g.K, nt = K / BK;
    unsigned voffA[2], voffB[2];
#pragma unroll
    for (int i = 0; i < 2; ++i) { int R, C; stage_rc(tid * 16 + i * 8192, R, C); const int Rb = Epi::PERM ? ((R & ~31) + perm32(R & 31)) : R;
        voffA[i] = (unsigned)(R * K + C) * 2u; voffB[i] = (unsigned)(Rb * K + C) * 2u; }
    const size_t kstep = (size_t)(BK * 2);
    const size_t hstep = (size_t)HALF * K * 2;
    const size_t tstep = 2 * hstep;
    const unsigned ldsw = (unsigned)wid * 1024u;
    const int aoff = lds_byte(wr * 64 + fr, fq * 8), boff = lds_byte(wc * 32 + fr, fq * 8);
#define PG8_SA(b, h) (((b) * 2 + (h)) * HTB)
#define PG8_SB(b, h) ((4 + (b) * 2 + (h)) * HTB)
#define PG8_STAGE(bufoff, gbase, voff) do { _Pragma("unroll") for (int _i = 0; _i < 2; ++_i) \
        __builtin_amdgcn_global_load_lds((const unsigned*)((const char*)(gbase) + (voff)[_i]), (PG8_LAS unsigned*)(lds + (bufoff) + ldsw + _i * 8192), 16, 0, 0); } while (0)
#define PG8_LDA(dst, b, h) do { if constexpr (F8) { _Pragma("unroll") for (int m = 0; m < 4; ++m) dst##8[m] = __builtin_shufflevector(*(const PG8_LAS i32x4_f8*)(lds + PG8_SA(b, h) + aoff + m * 2048), *(const PG8_LAS i32x4_f8*)(lds + PG8_SA(b, h) + aoff + m * 2048 + 1024), 0, 1, 2, 3, 4, 5, 6, 7); } \
        else { _Pragma("unroll") for (int m = 0; m < 4; ++m) _Pragma("unroll") for (int k = 0; k < 2; ++k) dst[m][k] = *(const PG8_LAS bf16x8*)(lds + PG8_SA(b, h) + aoff + m * 2048 + k * 1024); } } while (0)
#define PG8_LDB(dst, b, h) do { if constexpr (F8) { _Pragma("unroll") for (int n = 0; n < 2; ++n) dst##8[n] = __builtin_shufflevector(*(const PG8_LAS i32x4_f8*)(lds + PG8_SB(b, h) + boff + n * 2048), *(const PG8_LAS i32x4_f8*)(lds + PG8_SB(b, h) + boff + n * 2048 + 1024), 0, 1, 2, 3, 4, 5, 6, 7); } \
        else { _Pragma("unroll") for (int n = 0; n < 2; ++n) _Pragma("unroll") for (int k = 0; k < 2; ++k) dst[n][k] = *(const PG8_LAS bf16x8*)(lds + PG8_SB(b, h) + boff + n * 2048 + k * 1024); } } while (0)
#define PG8_MMA(ai, bj, At, Bt) do { __builtin_amdgcn_s_setprio(1); _Pragma("unroll") for (int m = 0; m < 4; ++m) _Pragma("unroll") for (int n = 0; n < 2; ++n) { \
        if constexpr (F8) { asm volatile("v_mfma_f32_16x16x128_f8f6f4 %0, %1, %2, %0" : "+v"(acc[ai][bj][m][n]) : "v"(Bt##8[n]), "v"(At##8[m])); } \
        else { _Pragma("unroll") for (int k = 0; k < 2; ++k) acc[ai][bj][m][n] = __builtin_amdgcn_mfma_f32_16x16x32_bf16(Bt[n][k], At[m][k], acc[ai][bj][m][n], 0, 0, 0); } } \
        __builtin_amdgcn_s_setprio(0); } while (0)
#define PG8_WAIT_V(n) asm volatile("s_waitcnt vmcnt(" #n ")" ::: "memory")
#define PG8_WAIT_L(n) asm volatile("s_waitcnt lgkmcnt(" #n ")" ::: "memory")
#define PG8_BAR __builtin_amdgcn_s_barrier()
#define PG8_SCHED __builtin_amdgcn_sched_barrier(0)
    Unit cur, nxt; int ui = 0;
    if (!S.next(0, cur)) return;
    float zf = 0.f; asm volatile("" : "+v"(zf));
    f32x4 acc[2][2][4][2];
#pragma unroll
    for (int a = 0; a < 2; ++a)
#pragma unroll
        for (int b = 0; b < 2; ++b)
#pragma unroll
            for (int m = 0; m < 4; ++m)
#pragma unroll
                for (int n = 0; n < 2; ++n) acc[a][b][m][n] = (f32x4){zf, zf, zf, zf};
    bf16x8 At[4][2], B0[2][2], B1[2][2]; i32x8_f8 At8[4], B08[2], B18[2];
    const char* cA = (const char*)g.A + (size_t)cur.pm * tstep; const char* cB = (const char*)g.Bt + (size_t)cur.pn * tstep;
    S.a_ready(cur);
    if constexpr (SP2) {
        PG8_STAGE(PG8_SB(0, 0), cB, voffB); PG8_STAGE(PG8_SB(0, 1), cB + hstep, voffB); PG8_STAGE(PG8_SA(0, 0), cA, voffA); PG8_STAGE(PG8_SA(0, 1), cA + hstep, voffA);
        if (wr == 1) PG8_BAR;
        PG8_WAIT_V(2); PG8_BAR;
        PG8_STAGE(PG8_SB(1, 0), cB + kstep, voffB); PG8_STAGE(PG8_SA(1, 0), cA + kstep, voffA); PG8_STAGE(PG8_SB(1, 1), cB + hstep + kstep, voffB);
        PG8_WAIT_V(6); PG8_BAR;
    } else {
        PG8_STAGE(PG8_SB(0, 0), cB, voffB); PG8_STAGE(PG8_SA(0, 0), cA, voffA); PG8_STAGE(PG8_SB(0, 1), cB + hstep, voffB); PG8_STAGE(PG8_SA(0, 1), cA + hstep, voffA);
        if (wr == 1) PG8_BAR;
        PG8_WAIT_V(4); PG8_BAR;
        PG8_STAGE(PG8_SB(1, 0), cB + kstep, voffB); PG8_STAGE(PG8_SA(1, 0), cA + kstep, voffA); PG8_STAGE(PG8_SB(1, 1), cB + hstep + kstep, voffB);
        PG8_WAIT_V(6); PG8_BAR;
    }
    for (;;) {
        const bool has_next = S.next(ui + 1, nxt);
        const char* nA = has_next ? (const char*)g.A + (size_t)nxt.pm * tstep : cA; const char* nB = has_next ? (const char*)g.Bt + (size_t)nxt.pn * tstep : cB;
        for (int t = 0; t < nt; t += 2) {
            const bool last = (t == nt - 2);
            const char* a1 = cA + (size_t)(t + 1) * kstep;
            const char* a2 = last ? nA : cA + (size_t)(t + 2) * kstep; const char* b2 = last ? nB : cB + (size_t)(t + 2) * kstep;
            const char* a3 = a2 + kstep; const char* b3 = b2 + kstep;
            if (last && has_next) S.a_ready(nxt);
            if constexpr (SP2) {
            PG8_LDB(B0, 0, 0); PG8_LDB(B1, 0, 1); PG8_SCHED; PG8_LDA(At, 0, 0); PG8_STAGE(PG8_SA(1, 1), a1 + hstep, voffA);
            PG8_WAIT_V(8); PG8_WAIT_L(0); PG8_BAR; PG8_MMA(0, 0, At, B0); PG8_MMA(0, 1, At, B1); PG8_BAR; PG8_SCHED;
            PG8_LDA(At, 0, 1); PG8_STAGE(PG8_SB(0, 0), b2, voffB); PG8_STAGE(PG8_SB(0, 1), b2 + hstep, voffB); PG8_STAGE(PG8_SA(0, 0), a2, voffA);
            PG8_WAIT_V(8); PG8_WAIT_L(0); PG8_BAR; PG8_MMA(1, 0, At, B0); PG8_MMA(1, 1, At, B1); PG8_BAR; PG8_SCHED;
            PG8_LDB(B0, 1, 0); PG8_LDB(B1, 1, 1); PG8_SCHED; PG8_LDA(At, 1, 0); PG8_STAGE(PG8_SA(0, 1), a2 + hstep, voffA);
            PG8_WAIT_V(8); PG8_WAIT_L(0); PG8_BAR; PG8_MMA(0, 0, At, B0); PG8_MMA(0, 1, At, B1); PG8_BAR; PG8_SCHED;
            PG8_LDA(At, 1, 1); PG8_STAGE(PG8_SB(1, 0), b3, voffB); PG8_STAGE(PG8_SB(1, 1), b3 + hstep, voffB); PG8_STAGE(PG8_SA(1, 0), a3, voffA);
            PG8_WAIT_V(8); PG8_WAIT_L(0); PG8_BAR; PG8_MMA(1, 0, At, B0); PG8_MMA(1, 1, At, B1); PG8_BAR; PG8_SCHED;
            } else {
            PG8_LDB(B0, 0, 0); PG8_SCHED; PG8_LDA(At, 0, 0); PG8_STAGE(PG8_SA(1, 1), a1 + hstep, voffA);
            PG8_WAIT_L(8); PG8_BAR; PG8_WAIT_L(0); PG8_MMA(0, 0, At, B0); PG8_BAR; PG8_SCHED;
            PG8_LDB(B1, 0, 1); PG8_STAGE(PG8_SB(0, 0), b2, voffB);
            PG8_BAR; PG8_WAIT_L(0); PG8_MMA(0, 1, At, B1); PG8_BAR;
            PG8_LDA(At, 0, 1); PG8_STAGE(PG8_SA(0, 0), a2, voffA);
            PG8_BAR; PG8_WAIT_L(0); PG8_MMA(1, 0, At, B0); PG8_BAR; PG8_SCHED;
            PG8_STAGE(PG8_SB(0, 1), b2 + hstep, voffB);
            PG8_WAIT_V(6); PG8_BAR; PG8_MMA(1, 1, At, B1); PG8_BAR;
            PG8_LDB(B0, 1, 0); PG8_SCHED; PG8_LDA(At, 1, 0); PG8_STAGE(PG8_SA(0, 1), a2 + hstep, voffA);
            PG8_WAIT_L(8); PG8_BAR; PG8_WAIT_L(0); PG8_MMA(0, 0, At, B0); PG8_BAR; PG8_SCHED;
            PG8_LDB(B1, 1, 1); PG8_STAGE(PG8_SB(1, 0), b3, voffB);
            PG8_BAR; PG8_WAIT_L(0); PG8_MMA(0, 1, At, B1); PG8_BAR;
            PG8_LDA(At, 1, 1); PG8_STAGE(PG8_SA(1, 0), a3, voffA);
            PG8_BAR; PG8_WAIT_L(0); PG8_MMA(1, 0, At, B0); PG8_BAR; PG8_SCHED;
            PG8_STAGE(PG8_SB(1, 1), b3 + hstep, voffB);
            PG8_WAIT_V(6); PG8_BAR; PG8_MMA(1, 1, At, B1); PG8_BAR;
            }
        }
        if constexpr (ALIGN_EPI) { if (wr == 0) PG8_BAR; }
        if constexpr (F8) asm volatile("s_nop 15\n\ts_nop 15" ::: "memory");
        if constexpr (!Epi::AFTER_DRAIN) { E(acc, cur, wr, wc, fr, fq); S.done(cur); }
        if (!has_next) break;
#pragma unroll
        for (int a = 0; a < 2; ++a)
#pragma unroll
            for (int b = 0; b < 2; ++b)
#pragma unroll
                for (int m = 0; m < 4; ++m)
#pragma unroll
                    for (int n = 0; n < 2; ++n) acc[a][b][m][n] = (f32x4){zf, zf, zf, zf};
        cur = nxt; cA = nA; cB = nB; ++ui;
        if constexpr (ALIGN_EPI) { if (wr == 1) PG8_BAR; }
    }
    PG8_WAIT_V(0);
    if constexpr (!ALIGN_EPI) { if (wr == 0) PG8_BAR; }
    PG8_BAR;
    if constexpr (Epi::AFTER_DRAIN) { E.fused(acc, cur, wr, wc, fr, fq, lds, wid, lane); S.done(cur); }
#undef PG8_SA
#undef PG8_SB
#undef PG8_STAGE
#undef PG8_LDA
#undef PG8_LDB
#undef PG8_MMA
#undef PG8_WAIT_V
#undef PG8_WAIT_L
#undef PG8_BAR
#undef PG8_SCHED
}
}
#include <hip/hip_runtime.h>
#include <cstdio>
#include <cstdint>
#include <cstdlib>
#include <vector>

#define XB_TMO      128
#define XB_XCNT(j)  (256  + 64 * (j))
#define XB_XSUB(j)  (1280 + 64 * (j))
#define XB_XGEN(j)  (2304 + 64 * (j))
#define XB_TOP      3328
#define XB_TOPGEN   3392
#define XCD_BAR_WORDS 3456
#define XB_SPIN_CAP (1u << 18)
#ifndef LAS
#define LAS __attribute__((address_space(3)))
#endif

__device__ __forceinline__ unsigned xb_ld(unsigned* p)              { return __hip_atomic_load(p, __ATOMIC_RELAXED, __HIP_MEMORY_SCOPE_AGENT); }
__device__ __forceinline__ unsigned xb_add(unsigned* p, unsigned v) { return __hip_atomic_fetch_add(p, v, __ATOMIC_RELAXED, __HIP_MEMORY_SCOPE_AGENT); }
__device__ __forceinline__ unsigned xb_xcc_id() { return (unsigned)__builtin_amdgcn_s_getreg((3 << 11) | 20) & 0xFu; }
#define XB_SPIN(cond, bar) do { unsigned _sp = 0; while (cond) { __builtin_amdgcn_s_sleep(1); \
    if ((++_sp & 255u) == 0u) { if (xb_ld(&(bar)[XB_TMO])) break; if (_sp > XB_SPIN_CAP) { atomicAdd(&(bar)[XB_TMO], 1u); break; } } } } while (0)

struct XcdBarrier {
    unsigned* bar; unsigned x;
    volatile LAS unsigned* st;
};

__device__ __forceinline__ XcdBarrier xcd_barrier_post(unsigned* bar, volatile LAS unsigned* st) {
    XcdBarrier b; b.bar = bar; b.x = xb_xcc_id(); b.st = st;
    if (threadIdx.x == 0) (void)xb_add(&bar[XB_XCNT(b.x)], 1u);
    return b;
}
__device__ __forceinline__ void xcd_barrier_complete(unsigned* bar, unsigned x, unsigned& nloc, unsigned& nx) {
    const unsigned G = gridDim.x * gridDim.y * gridDim.z;
    unsigned sum, cnt, mine, sp = 0u;
    for (;;) {
        sum = 0u; cnt = 0u; mine = 0u;
#pragma unroll
        for (unsigned j = 0; j < 16; ++j) { const unsigned c = xb_ld(&bar[XB_XCNT(j)]); sum += c; cnt += (c > 0u) ? 1u : 0u; mine = (j == x) ? c : mine; }
        if (sum == G) break;
        __builtin_amdgcn_s_sleep(1);
        if ((++sp & 255u) == 0u) { if (xb_ld(&bar[XB_TMO])) break; if (sp > XB_SPIN_CAP) { atomicAdd(&bar[XB_TMO], 1u); break; } }
    }
    nloc = mine > 0u ? mine : 1u; nx = cnt > 0u ? cnt : 1u;
}

__device__ __forceinline__ void xcd_barrier(const XcdBarrier& b) {
    asm volatile("s_waitcnt vmcnt(0)" ::: "memory");
    __syncthreads();
    if (threadIdx.x == 0) {
        unsigned* bar = b.bar;
        __builtin_amdgcn_s_waitcnt(0);
        unsigned nloc = b.st[0], nx = b.st[1];
        if (nloc == 0u) { xcd_barrier_complete(bar, b.x, nloc, nx); b.st[0] = nloc; b.st[1] = nx; }
        const unsigned old = xb_add(&bar[XB_XSUB(b.x)], 1u);
        const unsigned gen = old / nloc;
        if (old + 1u == (gen + 1u) * nloc) {
            __builtin_amdgcn_fence(__ATOMIC_RELEASE, "agent");
            asm volatile("s_waitcnt vmcnt(0)" ::: "memory");
            const unsigned og = xb_add(&bar[XB_TOP], 1u);
            const unsigned tg = og / nx;
            if (og + 1u == (tg + 1u) * nx) xb_add(&bar[XB_TOPGEN], 1u);
            else XB_SPIN(xb_ld(&bar[XB_TOPGEN]) == tg, bar);
            __builtin_amdgcn_fence(__ATOMIC_ACQUIRE, "agent");
            xb_add(&bar[XB_XGEN(b.x)], 1u);
            asm volatile("s_waitcnt vmcnt(0)" ::: "memory");
        } else {
            XB_SPIN(xb_ld(&bar[XB_XGEN(b.x)]) == gen, bar);
            __builtin_amdgcn_fence(__ATOMIC_ACQUIRE, "agent");
            asm volatile("s_waitcnt vmcnt(0)" ::: "memory");
        }
    }
    __syncthreads();
}


typedef unsigned short bf16_t;
using pg8::f32x4; using pg8::u32x4; using pg8::Unit;
typedef unsigned u32x2 __attribute__((ext_vector_type(2)));
#define LAS __attribute__((address_space(3)))
#define TIDX pg8_tid_fresh()

constexpr int D = 1024, NB = 4, SEQ = 4096, DEPTH = 4, LC = 256, LT = SEQ + LC, MT = NB * LT;
constexpr int INC = 8704;
constexpr int C_RQ = 0, C_RK = 512, C_RV = 1024, C_RG = 1536, C_HQ = 2048, C_HFF = 2560, C_HFB = 3072, C_HI = 3584, C_HGT = 4096, C_LX = 4608, C_LGT = 5120, C_GR = 5632;
constexpr float W8_SCALE = 64.0f;
constexpr int NE = 32, MAXTILES = 304, MAXSLOTS = MAXTILES * 256, CAPT = 68;
constexpr int TB_OFF = 131072;
constexpr int NTHREADS = 512;

struct Params {
    const float *x, *c, *ctx, *c_ctx, *mod_w, *mod_b, *norm1_g, *norm2_g, *final_g, *w_in, *ret_decay, *ret_gn_g, *w_ret_o, *hgrn_lb_logits, *hgrn_gn_g, *w_hgrn_o,
        *lru_conv_w, *lru_conv_b, *lru_wa, *lru_ba, *lru_wx, *lru_bx, *lru_lambda, *w_lru_o, *w_out, *router_w, *router_b, *exp_w_gu, *exp_b_gu, *exp_w_down, *exp_b_down;
    float* out;
    bf16_t *wt_in, *wt_br, *wt_out; unsigned char *wt_gu, *wt_down;
    float *mod, *lb, *rot;
    bf16_t* X; bf16_t* H; unsigned char* H8; unsigned char* wt_ing; bf16_t* U;
    bf16_t *Oret, *Ohg, *Dummy; unsigned* PH;
    bf16_t *RQ, *RK, *HQ, *HK; float *HA, *SE, *SG, *LP, *LH, *LS;
    bf16_t* Aall; bf16_t* R; bf16_t* Mg; bf16_t* Dx;
    unsigned* bar; unsigned* ctrl;
    int *tok_e, *tok_pos; float* tok_w;
    float *RWp, *RC;
    unsigned char *Xg, *Act; unsigned char* Y;
};

__device__ __forceinline__ float bf2f(bf16_t v) { return __uint_as_float(((unsigned)v) << 16); }
__device__ __forceinline__ float bflo(unsigned w) { return __uint_as_float(w << 16); }
__device__ __forceinline__ float bfhi(unsigned w) { return __uint_as_float(w & 0xffff0000u); }
__device__ __forceinline__ float sigmoidf_(float x) { return __builtin_amdgcn_rcpf(1.0f + __expf(-x)); }
__device__ __forceinline__ float shx(float v, int o, int lane) { return __int_as_float(__builtin_amdgcn_ds_bpermute((lane ^ o) << 2, __float_as_int(v))); }
__device__ __forceinline__ float wave_sum(float v, int lane) {
#pragma unroll
    for (int o = 32; o >= 1; o >>= 1) v += shx(v, o, lane);
    return v;
}

extern __shared__ __attribute__((aligned(16))) unsigned char dyn_lds[];
__device__ __forceinline__ unsigned char* dyn_lds_base() { return dyn_lds; }
typedef short bf16x8_t __attribute__((ext_vector_type(8)));
typedef short s16x4_t __attribute__((ext_vector_type(4)));
typedef float f32x16_t __attribute__((ext_vector_type(16)));
typedef float f32x2_t __attribute__((ext_vector_type(2)));
typedef __bf16 bf16v2_t __attribute__((ext_vector_type(2)));
constexpr int NCH = MT / 32;
#define MFMA32(a, b, c) __builtin_amdgcn_mfma_f32_32x32x16_bf16((a), (b), (c), 0, 0, 0)

#define GAS __attribute__((address_space(1)))
__device__ __forceinline__ const GAS char* uni_ptr(const void* p) { const unsigned long long v = (unsigned long long)p;
    const unsigned lo = __builtin_amdgcn_readfirstlane((unsigned)v), hi = __builtin_amdgcn_readfirstlane((unsigned)(v >> 32)); return (const GAS char*)(((unsigned long long)hi << 32) | lo); }
__device__ __forceinline__ unsigned pk_fp8x4(float a, float b, float c, float d) {
    a = fminf(fmaxf(a, -448.f), 448.f); b = fminf(fmaxf(b, -448.f), 448.f); c = fminf(fmaxf(c, -448.f), 448.f); d = fminf(fmaxf(d, -448.f), 448.f);
    int t = __builtin_amdgcn_cvt_pk_fp8_f32(a, b, 0, false); t = __builtin_amdgcn_cvt_pk_fp8_f32(c, d, t, true); return (unsigned)t; }
__device__ __forceinline__ unsigned pk_bf16(float a, float b) { const f32x2_t v = {a, b}; return __builtin_bit_cast(unsigned, __builtin_convertvector(v, bf16v2_t)); }
template <int s> __device__ __forceinline__ bf16x8_t pack8(const f32x16_t& x) {
    u32x4 w; w[0] = pk_bf16(x[8 * s], x[8 * s + 1]); w[1] = pk_bf16(x[8 * s + 2], x[8 * s + 3]); w[2] = pk_bf16(x[8 * s + 4], x[8 * s + 5]); w[3] = pk_bf16(x[8 * s + 6], x[8 * s + 7]);
    return __builtin_bit_cast(bf16x8_t, w);
}
__device__ __forceinline__ bf16x8_t frag_row(const LAS char* t, int pitch, int row, int colbase) {
    const s16x4_t lo = *(const LAS s16x4_t*)(t + row * pitch + colbase * 2), hi = *(const LAS s16x4_t*)(t + row * pitch + colbase * 2 + 16);
    return __builtin_shufflevector(lo, hi, 0, 1, 2, 3, 4, 5, 6, 7);
}
__device__ __forceinline__ bf16x8_t frag_tr(const LAS char* t, int pitch, int jb, int ct, int lane) {
    const int q = (lane & 15) >> 2, pp = lane & 3, blk = (lane >> 4) & 1;
    const LAS char* a0 = t + (jb + q) * pitch + (32 * ct + 16 * blk + 4 * pp) * 2;
    const s16x4_t lo = __builtin_amdgcn_ds_read_tr16_b64_v4i16((LAS s16x4_t*)a0), hi = __builtin_amdgcn_ds_read_tr16_b64_v4i16((LAS s16x4_t*)(a0 + 8 * pitch));
    return __builtin_shufflevector(lo, hi, 0, 1, 2, 3, 4, 5, 6, 7);
}


__device__ __forceinline__ void build_tile_table(const Params& p, int l) {
    LAS int* te = (LAS int*)((LAS char*)dyn_lds_base() + TB_OFF); LAS int* tb = te + MAXTILES; LAS int* tc = tb + NE + 1; const int t = TIDX;
    if (t < NE) tc[t] = ((int)p.ctrl[l * 64 + t] + 255) >> 8;
    __syncthreads();
    if (t <= NE) { int s = 0;
#pragma unroll 1
        for (int k = 0; k < t; ++k) s += tc[k];
        tb[t] = s; }
    __syncthreads();
    if (t < MAXTILES) { int e = 0;
#pragma unroll 1
        for (int k = 1; k < NE; ++k) e += (tb[k] <= t) ? 1 : 0;
        te[t] = e; }
    __syncthreads();
}

#ifndef CT_NN
#define CT_NN 128
#endif
constexpr int CT_K = 128, CT_N = CT_NN, CT_P = CT_N + 1;
__device__ __forceinline__ void convert_tiles(const float* __restrict__ src, bf16_t* __restrict__ dst, int K, int N, size_t sstride, size_t dstride, int mode, int nbatch, float* lds, int f8 = 0, int ld = 0) {
    const int t = TIDX & 255, half = TIDX >> 8; float* tile = lds + half * (CT_K * CT_P); if (ld == 0) ld = N;
    const int tn = N / CT_N, tk = K / CT_K, per = tn * tk, total = per * nbatch, stride = gridDim.x * 2, hb = blockIdx.x * 2 + half;
    const int iters = (total + stride - 1) / stride;
    for (int it = 0; it < iters; ++it) {
        const int idx = it * stride + hb; const bool valid = idx < total;
        const int bz = idx / per, rem = idx - bz * per, ky = rem / tn, nx = rem - ky * tn; const int n0 = nx * CT_N, k0 = ky * CT_K;
        if (valid) { const float* s = src + (size_t)bz * sstride;
#pragma unroll
            for (int i = 0; i < CT_K * (CT_N / 4) / 256; ++i) { const int r = t / (CT_N / 4) + (1024 / CT_N) * i, cq = (t % (CT_N / 4)) * 4; const float4 v = *(const float4*)(s + (size_t)(k0 + r) * ld + n0 + cq);
                tile[r * CT_P + cq] = v.x; tile[r * CT_P + cq + 1] = v.y; tile[r * CT_P + cq + 2] = v.z; tile[r * CT_P + cq + 3] = v.w; } }
        __syncthreads();
        if (valid) { bf16_t* d = dst + (size_t)bz * dstride; const int kq = (t & 3) * (CT_K / 4);
#pragma unroll
          for (int nn = 0; nn < CT_N / 64; ++nn) { const int n = (t >> 2) + 64 * nn;
            int nd = n0 + n; if (mode == 1) { const int j = nd & 1023, up = nd >> 10; nd = (j >> 7) * 256 + up * 128 + (j & 127); }
            if (f8) { uint4* o = (uint4*)((unsigned char*)dst + (size_t)bz * dstride + (size_t)nd * K + k0 + kq);
#pragma unroll
                for (int q = 0; q < CT_K / 64; ++q) { unsigned w[4];
#pragma unroll
                    for (int i = 0; i < 4; ++i) { const int kk = kq + 16 * q + 4 * i; w[i] = pk_fp8x4(W8_SCALE * tile[kk * CT_P + n], W8_SCALE * tile[(kk + 1) * CT_P + n], W8_SCALE * tile[(kk + 2) * CT_P + n], W8_SCALE * tile[(kk + 3) * CT_P + n]); }
                    o[q] = make_uint4(w[0], w[1], w[2], w[3]); }
            } else { uint4* o = (uint4*)(d + (size_t)nd * K + k0 + kq);
#pragma unroll
                for (int q = 0; q < CT_K / 32; ++q) { unsigned w[4];
#pragma unroll
                    for (int i = 0; i < 4; ++i) { const int kk = kq + 8 * q + 2 * i; w[i] = pg8::cvt_pk_bf16(tile[kk * CT_P + n], tile[(kk + 1) * CT_P + n]); }
                    o[q] = make_uint4(w[0], w[1], w[2], w[3]); } } } }
        __syncthreads();
    }
}
__device__ __forceinline__ void convert_phase(const Params& p, float* lds) {
    convert_tiles(p.w_in, p.wt_in, D, C_GR, (size_t)D * INC, (size_t)INC * D, 0, DEPTH, lds, 0, INC);
    convert_tiles(p.w_in + C_GR, (bf16_t*)p.wt_ing, D, INC - C_GR, (size_t)D * INC, (size_t)(INC - C_GR) * D, 0, DEPTH, lds, 1, INC);
    convert_tiles(p.w_ret_o, p.wt_br, 512, 1024, (size_t)512 * 1024, (size_t)3 * 1024 * 512, 0, DEPTH, lds);
    convert_tiles(p.w_hgrn_o, p.wt_br + (size_t)1024 * 512, 512, 1024, (size_t)512 * 1024, (size_t)3 * 1024 * 512, 0, DEPTH, lds);
    convert_tiles(p.w_lru_o, p.wt_br + (size_t)2 * 1024 * 512, 512, 1024, (size_t)512 * 1024, (size_t)3 * 1024 * 512, 0, DEPTH, lds);
    convert_tiles(p.w_out, p.wt_out, D, D, (size_t)D * D, (size_t)D * D, 0, DEPTH, lds);
    convert_tiles(p.exp_w_gu, (bf16_t*)p.wt_gu, D, 2048, (size_t)D * 2048, (size_t)2048 * D, 1, DEPTH * NE, lds, 1);
    convert_tiles(p.exp_w_down, (bf16_t*)p.wt_down, D, D, (size_t)D * D, (size_t)D * D, 0, DEPTH * NE, lds, 1);
}

__device__ __forceinline__ void mod_phase(const Params& p, float* lds) {
    float* s = lds; float* red = lds + 5 * 1024;
    const int t = TIDX;
    for (int i = t; i < 5 * 1024; i += NTHREADS) { const int r = i >> 10, k = i & 1023; const float v = (r < 4) ? p.c[r * 1024 + k] : p.c_ctx[k]; s[i] = v / (1.0f + expf(-v)); }
    __syncthreads();
    for (int unit = blockIdx.x; unit < 96 * DEPTH; unit += gridDim.x) {
        const int l = unit / 96, n0 = (unit - l * 96) * 64;
        const int nn = t & 63, kg = t >> 6; const float* w = p.mod_w + (size_t)l * 1024 * 6144 + n0 + nn;
        float acc[5] = {0.f, 0.f, 0.f, 0.f, 0.f};
        for (int k = kg * 128; k < kg * 128 + 128; ++k) { const float wv = w[(size_t)k * 6144];
#pragma unroll
            for (int r = 0; r < 5; ++r) acc[r] += s[r * 1024 + k] * wv; }
#pragma unroll
        for (int r = 0; r < 5; ++r) red[(kg * 5 + r) * 64 + nn] = acc[r];
        __syncthreads();
        if (t < 320) { const int r = t >> 6, n2 = t & 63; float a = 0.f;
#pragma unroll
            for (int g = 0; g < 8; ++g) a += red[(g * 5 + r) * 64 + n2];
            p.mod[(size_t)(l * 5 + r) * 6144 + n0 + n2] = a + p.mod_b[l * 6144 + n0 + n2]; }
        __syncthreads();
    }
}
__device__ __forceinline__ void small_phase(const Params& p) {
    for (int i = blockIdx.x * NTHREADS + TIDX; i < 4096 * 32; i += gridDim.x * NTHREADS) {
        if (i < 1024) { float v[4], m = -1e30f;
#pragma unroll
            for (int l = 0; l < 4; ++l) { v[l] = p.hgrn_lb_logits[l * 1024 + i]; m = fmaxf(m, v[l]); }
            float sum = 0.f;
#pragma unroll
            for (int l = 0; l < 4; ++l) { v[l] = expf(v[l] - m); sum += v[l]; }
            float cum = 0.f;
#pragma unroll
            for (int l = 0; l < 4; ++l) { const float sm = v[l] / sum; if (l > 0) cum += sm; p.lb[l * 1024 + i] = cum; } }
        const int t = i >> 5, f = i & 31; const float inv = powf(10000.0f, -(float)(f & 15) / 16.0f); const float pos = (f < 16) ? (float)(t >> 6) : (float)(t & 63);
        const float ang = pos * inv; p.rot[i * 2] = cosf(ang); p.rot[i * 2 + 1] = sinf(ang); }
}
template <int MODE> __device__ __forceinline__ void norm_phase(const Params& p, int l) {
    if (MODE != 0) build_tile_table(p, l - 1);
    const LAS int* tbp = (const LAS int*)((const LAS char*)dyn_lds_base() + TB_OFF) + MAXTILES;
    const int lane = TIDX & 63; const int gw = blockIdx.x * (NTHREADS / 64) + __builtin_amdgcn_readfirstlane(TIDX >> 6), nw = gridDim.x * (NTHREADS / 64);
    int ne[4] = {0, 0, 0, 0}, np[4] = {0, 0, 0, 0}; float nwt[4] = {0.f, 0.f, 0.f, 0.f};
    const bool bymap = (nw == 2048); const int wb = gw >> 9, wj = gw & 511; const int nit = bymap ? (wj < 256 ? 9 : 8) : (MT - gw + nw - 1) / nw;
#define NP_ROW(IT) (bymap ? wb * LT + wj + 512 * (IT) : gw + (IT) * nw)
    if (MODE != 0 && nit > 0) { const int m0_ = NP_ROW(0);
#pragma unroll
        for (int k = 0; k < 4; ++k) { ne[k] = p.tok_e[m0_ * 4 + k]; np[k] = p.tok_pos[m0_ * 4 + k]; nwt[k] = p.tok_w[m0_ * 4 + k]; } }
    float4 gN[4], shN[4], scN[4], g2v[4]; int cur_mr = -1;
#pragma unroll
    for (int j = 0; j < 4; ++j) gN[j] = (MODE != 2) ? *(const float4*)(p.norm1_g + l * D + j * 256 + lane * 4) : *(const float4*)(p.final_g + j * 256 + lane * 4);
    for (int it = 0; it < nit; ++it) { const int m = NP_ROW(it);
        const int b = m / LT, pp = m - b * LT; const bool isctx = pp < LC; const int mr = isctx ? 4 : b;
        float4 xv[4];
        if (mr != cur_mr) { cur_mr = mr;
            if (MODE != 2) { const float* mv = p.mod + (size_t)(l * 5 + mr) * 6144;
#pragma unroll
                for (int j = 0; j < 4; ++j) { const int col = j * 256 + lane * 4; shN[j] = *(const float4*)(mv + col); scN[j] = *(const float4*)(mv + 1024 + col); } }
            if (MODE != 0) { const float* g2 = p.mod + (size_t)((l - 1) * 5 + mr) * 6144 + 5 * 1024;
#pragma unroll
                for (int j = 0; j < 4; ++j) g2v[j] = *(const float4*)(g2 + j * 256 + lane * 4); } }
        if (MODE == 0) { const float* src = isctx ? p.ctx + (size_t)(b * LC + pp) * D : p.x + (size_t)(b * SEQ + pp - LC) * D;
#pragma unroll
            for (int j = 0; j < 4; ++j) xv[j] = *(const float4*)(src + j * 256 + lane * 4);
        } else {
            int slot[4]; float w[4];
#pragma unroll
            for (int k = 0; k < 4; ++k) { slot[k] = tbp[ne[k]] * 256 + np[k]; w[k] = nwt[k]; }
            unsigned yv[4][4];
#pragma unroll
            for (int j = 0; j < 4; ++j) { const int col = j * 256 + lane * 4; { const u32x2 xr = *(const u32x2*)(p.X + (size_t)m * D + col); xv[j] = make_float4(bflo(xr.x), bfhi(xr.x), bflo(xr.y), bfhi(xr.y)); }
#pragma unroll
                for (int k = 0; k < 4; ++k) yv[j][k] = *(const unsigned*)(p.Y + (size_t)slot[k] * D + col); }
            if (it + 1 < nit) { const int mn_ = NP_ROW(it + 1);
#pragma unroll
                for (int k = 0; k < 4; ++k) { ne[k] = p.tok_e[mn_ * 4 + k]; np[k] = p.tok_pos[mn_ * 4 + k]; nwt[k] = p.tok_w[mn_ * 4 + k]; } }
#pragma unroll
            for (int j = 0; j < 4; ++j) { float a0 = 0.f, a1 = 0.f, a2 = 0.f, a3 = 0.f;
#pragma unroll
                for (int k = 0; k < 4; ++k) { const f32x2_t ylo = __builtin_amdgcn_cvt_pk_f32_fp8((int)yv[j][k], false), yhi = __builtin_amdgcn_cvt_pk_f32_fp8((int)yv[j][k], true); a0 += w[k] * ylo[0]; a1 += w[k] * ylo[1]; a2 += w[k] * yhi[0]; a3 += w[k] * yhi[1]; }
                xv[j].x += g2v[j].x * a0; xv[j].y += g2v[j].y * a1; xv[j].z += g2v[j].z * a2; xv[j].w += g2v[j].w * a3; }
        }
        if (MODE != 2) {
#pragma unroll
            for (int j = 0; j < 4; ++j) { u32x2 xw; xw.x = pg8::cvt_pk_bf16(xv[j].x, xv[j].y); xw.y = pg8::cvt_pk_bf16(xv[j].z, xv[j].w); *(u32x2*)(p.X + (size_t)m * D + j * 256 + lane * 4) = xw; } }
        float ss = 0.f;
#pragma unroll
        for (int j = 0; j < 4; ++j) ss += xv[j].x * xv[j].x + xv[j].y * xv[j].y + xv[j].z * xv[j].z + xv[j].w * xv[j].w;
        ss = wave_sum(ss, lane); const float rstd = rsqrtf(ss * (1.0f / D) + 1e-6f);
#ifdef PROBE_PHASE
        const float pr_scale = 1.0f + ((const float*)p.ctrl)[2048];
#else
        const float pr_scale = 1.0f;
#endif
        if (MODE == 2) { if (!isctx) { float* o = p.out + (size_t)(b * SEQ + pp - LC) * D;
#pragma unroll
                for (int j = 0; j < 4; ++j) { const int col = j * 256 + lane * 4; const float4 g = gN[j];
                    *(float4*)(o + col) = make_float4(xv[j].x * rstd * g.x * pr_scale, xv[j].y * rstd * g.y * pr_scale, xv[j].z * rstd * g.z * pr_scale, xv[j].w * rstd * g.w * pr_scale); } }
        } else {
#pragma unroll
            for (int j = 0; j < 4; ++j) { const int col = j * 256 + lane * 4; const float4 g = gN[j], sh = shN[j], sc = scN[j];
                const float h0 = xv[j].x * rstd * g.x * (1.f + sc.x) + sh.x, h1 = xv[j].y * rstd * g.y * (1.f + sc.y) + sh.y, h2 = xv[j].z * rstd * g.z * (1.f + sc.z) + sh.z, h3 = xv[j].w * rstd * g.w * (1.f + sc.w) + sh.w;
                u32x2 w2; w2.x = pg8::cvt_pk_bf16(h0, h1); w2.y = pg8::cvt_pk_bf16(h2, h3); *(u32x2*)(p.H + (size_t)m * D + col) = w2;
                *(unsigned*)(p.H8 + (size_t)m * D + col) = pk_fp8x4(h0, h1, h2, h3); } }
    }
}
#undef NP_ROW
__device__ __forceinline__ void lru_prep_phase(const Params& p, int l, float* ldsf) {
    const int tid = TIDX, lane = tid & 63, wave = __builtin_amdgcn_readfirstlane(tid >> 6), r = lane & 31, h = lane >> 5; const int G8 = (int)gridDim.x >> 3;
    if ((int)blockIdx.x >= G8 * 8) return;
    const int hb = blockIdx.x & 7, rank = blockIdx.x >> 3;
    LAS char* lds = (LAS char*)ldsf; LAS char* tW = lds; LAS char* tH = lds + 36864 + wave * 9216; LAS char* tX = tH + 4480;
#pragma unroll
    for (int i = 0; i < 16; ++i) { const int e = tid + 512 * i, mat = e >> 11, rr = (e & 2047) * 2, dir = mat >> 1; const float* src = (mat & 1) ? p.lru_wx : p.lru_wa;
        const f32x2_t v = *(const f32x2_t*)(src + (size_t)((l * 2 + dir) * 8 + hb) * 4096 + rr);
        *(LAS unsigned*)(tW + mat * 9216 + (rr >> 6) * 144 + (rr & 63) * 2) = pk_bf16(v[0], v[1]); }
    __syncthreads();
    const int cch = hb * 64 + lane;
    const float cb = p.lru_conv_b[l * 512 + cch], cw0 = p.lru_conv_w[(l * 4 + 0) * 512 + cch], cw1 = p.lru_conv_w[(l * 4 + 1) * 512 + cch], cw2 = p.lru_conv_w[(l * 4 + 2) * 512 + cch], cw3 = p.lru_conv_w[(l * 4 + 3) * 512 + cch];
    const int per_wg = (MT / 32 + G8 - 1) / G8;
    for (int q = wave; q < per_wg && rank * per_wg + q < MT / 32; q += 8) { const int t32 = rank * per_wg + q;
        const int m0 = t32 * 32, b = m0 / LT, p0 = m0 - b * LT; const int seg_lo = p0 < LC ? 0 : LC, seg_hi = p0 < LC ? LC : LT;
#pragma unroll
        for (int i = 0; i < 5; ++i) { const int idx = lane + 64 * i; if (idx < 35 * 8) { const int row = idx >> 3, ch = idx & 7, q = p0 - 2 + row; u32x4 v = {0u, 0u, 0u, 0u};
                if (q >= seg_lo && q < seg_hi) v = *(const u32x4*)(p.U + (size_t)(b * LT + q) * INC + C_LX + hb * 64 + ch * 8);
                *(LAS u32x4*)(tH + row * 128 + ch * 16) = v; } }
        asm volatile("s_waitcnt lgkmcnt(0)" ::: "memory");
#pragma unroll
        for (int j = 0; j < 32; ++j) { const LAS bf16_t* col = (const LAS bf16_t*)(tH + j * 128 + lane * 2);
            const float x = cb + bf2f(col[0]) * cw0 + bf2f(col[64]) * cw1 + bf2f(col[128]) * cw2 + bf2f(col[192]) * cw3;
            *(LAS bf16_t*)(tX + j * 144 + lane * 2) = (bf16_t)(pk_bf16(x, 0.f) & 0xffffu); }
        asm volatile("s_waitcnt lgkmcnt(0)" ::: "memory");
        bf16x8_t Af[4];
#pragma unroll
        for (int x = 0; x < 4; ++x) Af[x] = frag_row(tX, 144, r, 16 * x + 4 * h);
#pragma unroll
        for (int dir = 0; dir < 2; ++dir) {
            f32x16_t acc[2][2];
#pragma unroll
            for (int gq = 0; gq < 2; ++gq)
#pragma unroll
                for (int nt = 0; nt < 2; ++nt) {
#pragma unroll
                    for (int i = 0; i < 16; ++i) acc[gq][nt][i] = 0.f;
#pragma unroll
                    for (int x = 0; x < 4; ++x) acc[gq][nt] = MFMA32(Af[x], frag_tr(tW + (dir * 2 + gq) * 9216, 144, 16 * x + 4 * h, nt, lane), acc[gq][nt]); }
#pragma unroll
            for (int nt = 0; nt < 2; ++nt) { const int c = hb * 64 + 32 * nt + r, pi = (l * 2 + dir) * 512 + c; const float ba = p.lru_ba[pi], bx = p.lru_bx[pi], lam = p.lru_lambda[pi];
                const float sp8 = -8.0f * log1pf(expf(-lam));
                float av[16], bv[16];
#pragma unroll
                for (int i = 0; i < 16; ++i) { const int tok = (i & 3) + 8 * (i >> 2) + 4 * h; const float rg = sigmoidf_(acc[0][nt][i] + ba), ig = sigmoidf_(acc[1][nt][i] + bx);
                    const float a = __expf(rg * sp8); av[i] = a; bv[i] = __builtin_amdgcn_sqrtf(fmaxf(fmaf(-a, a, 1.0f), 0.f)) * (ig * bf2f(*(const LAS bf16_t*)(tX + tok * 144 + (32 * nt + r) * 2))); }
                float Pg[4], Hg[4];
#pragma unroll
                for (int g = 0; g < 4; ++g) { float P = 1.f, H = 0.f;
#pragma unroll
                    for (int ee = 0; ee < 4; ++ee) { const int i = 4 * g + (dir == 0 ? ee : 3 - ee); H = av[i] * H + bv[i]; P *= av[i]; av[i] = P; bv[i] = H; }
                    Pg[g] = P; Hg[g] = H; }
                float Ps = 1.f, Hs = 0.f, Pst[4] = {1.f, 1.f, 1.f, 1.f}, Hst[4] = {0.f, 0.f, 0.f, 0.f};
#pragma unroll
                for (int kk = 0; kk < 8; ++kk) { const int k = dir == 0 ? kk : 7 - kk, g = k >> 1, hh = k & 1;
                    const float Po = shx(Pg[g], 32, lane), Ho = shx(Hg[g], 32, lane); const bool mine = hh == h;
                    const float Pk = mine ? Pg[g] : Po, Hk = mine ? Hg[g] : Ho;
                    Pst[g] = mine ? Ps : Pst[g]; Hst[g] = mine ? Hs : Hst[g];
                    Hs = Pk * Hs + Hk; Ps *= Pk; }
                unsigned* out = p.PH + ((size_t)dir * MT + m0) * 512 + c;
#pragma unroll
                for (int i = 0; i < 16; ++i) { const int g = i >> 2, tok = (i & 3) + 8 * g + 4 * h; out[(size_t)tok * 512] = pk_bf16(av[i] * Pst[g], av[i] * Hst[g] + bv[i]); }
                if (h == 0) { const size_t o = ((size_t)dir * (MT / 32) + t32) * 512 + c; p.LP[o] = Ps; p.LH[o] = Hs; }
            }
        }
    }
}
__device__ __forceinline__ void lru_tilescan_task(const Params& p, int task, int lane) {
    const int b = task >> 4, dir = (task >> 3) & 1, c = (task & 7) * 64 + lane;
    const size_t base = ((size_t)dir * (MT / 32) + (size_t)b * 136) * 512 + c;
    float hh = 0.f;
#pragma unroll 17
    for (int i = 0; i < 136; ++i) { const int tl = dir == 0 ? i : (i < 8 ? 7 - i : 143 - i); const float P = p.LP[base + (size_t)tl * 512], H = p.LH[base + (size_t)tl * 512];
        p.LS[base + (size_t)tl * 512] = hh; hh = P * hh + H; }
}

__device__ __forceinline__ void finish_phase(const Params& p, int l, int last) {
    const int lane = TIDX & 63; const int gw = blockIdx.x * (NTHREADS / 64) + __builtin_amdgcn_readfirstlane(TIDX >> 6), nw = gridDim.x * (NTHREADS / 64);
    const int c0 = lane * 8;
    float gr_[8], gh_[8];
#pragma unroll
    for (int i = 0; i < 8; ++i) { gr_[i] = p.ret_gn_g[l * 512 + c0 + i]; gh_[i] = p.hgrn_gn_g[l * 512 + c0 + i]; }
    for (int m = gw; m < MT; m += nw) {
        if (last && (m % LT) < LC) continue;
        const bf16_t* u = p.U + (size_t)m * INC + c0; const int tile = m >> 5;
        const bf16_t* ra = p.Oret + (size_t)m * 512 + c0; const bf16_t* rb = ra + (size_t)MT * 512; const bf16_t* ha = p.Ohg + (size_t)m * 512 + c0; const bf16_t* hb2 = ha + (size_t)MT * 512;
        const u32x4 rav = *(const u32x4*)ra, rbv = *(const u32x4*)rb, hav = *(const u32x4*)ha, hbv = *(const u32x4*)hb2;
        const unsigned* ph0 = p.PH + (size_t)m * 512 + c0; const unsigned* ph1 = ph0 + (size_t)MT * 512;
        const u32x4 pf0 = *(const u32x4*)ph0, pf1 = *(const u32x4*)(ph0 + 4), pb0 = *(const u32x4*)ph1, pb1 = *(const u32x4*)(ph1 + 4);
        const float* st0 = p.LS + (size_t)tile * 512 + c0; const float* st1 = st0 + (size_t)(MT / 32) * 512;
        const float4 sf0 = *(const float4*)st0, sf1 = *(const float4*)(st0 + 4), sb0 = *(const float4*)st1, sb1 = *(const float4*)(st1 + 4);
        const u32x4 grg = *(const u32x4*)(u + C_RG), ghg = *(const u32x4*)(u + C_HGT), glg = *(const u32x4*)(u + C_LGT);
        { float o[8] = {bflo(rav[0]) + bflo(rbv[0]), bfhi(rav[0]) + bfhi(rbv[0]), bflo(rav[1]) + bflo(rbv[1]), bfhi(rav[1]) + bfhi(rbv[1]), bflo(rav[2]) + bflo(rbv[2]), bfhi(rav[2]) + bfhi(rbv[2]), bflo(rav[3]) + bflo(rbv[3]), bfhi(rav[3]) + bfhi(rbv[3])};
          float ss = 0.f;
#pragma unroll
          for (int i = 0; i < 8; ++i) ss += o[i] * o[i];
          ss += shx(ss, 1, lane); ss += shx(ss, 2, lane); ss += shx(ss, 4, lane);
          const float rstd = rsqrtf(ss * (1.0f / 64.0f) + 1e-6f); u32x4 w;
#pragma unroll
          for (int i = 0; i < 4; ++i) { const float g0 = bflo(grg[i]), g1 = bfhi(grg[i]); w[i] = pg8::cvt_pk_bf16(o[2 * i] * rstd * gr_[2 * i] * (g0 * sigmoidf_(g0)), o[2 * i + 1] * rstd * gr_[2 * i + 1] * (g1 * sigmoidf_(g1))); }
          *(u32x4*)(p.Aall + (size_t)m * 512 + c0) = w; }
        { float o[8] = {bflo(hav[0]) + bflo(hbv[0]), bfhi(hav[0]) + bfhi(hbv[0]), bflo(hav[1]) + bflo(hbv[1]), bfhi(hav[1]) + bfhi(hbv[1]), bflo(hav[2]) + bflo(hbv[2]), bfhi(hav[2]) + bfhi(hbv[2]), bflo(hav[3]) + bflo(hbv[3]), bfhi(hav[3]) + bfhi(hbv[3])};
          float ss = 0.f;
#pragma unroll
          for (int i = 0; i < 8; ++i) ss += o[i] * o[i];
          ss += shx(ss, 1, lane); ss += shx(ss, 2, lane); ss += shx(ss, 4, lane); ss += shx(ss, 8, lane);
          const float rstd = rsqrtf(ss * (1.0f / 128.0f) + 1e-6f); u32x4 w;
#pragma unroll
          for (int i = 0; i < 4; ++i) w[i] = pg8::cvt_pk_bf16(o[2 * i] * rstd * gh_[2 * i] * sigmoidf_(bflo(ghg[i])), o[2 * i + 1] * rstd * gh_[2 * i + 1] * sigmoidf_(bfhi(ghg[i])));
          *(u32x4*)(p.Aall + ((size_t)MT + m) * 512 + c0) = w; }
        { const float sf[8] = {sf0.x, sf0.y, sf0.z, sf0.w, sf1.x, sf1.y, sf1.z, sf1.w}, sb[8] = {sb0.x, sb0.y, sb0.z, sb0.w, sb1.x, sb1.y, sb1.z, sb1.w};
          const unsigned pf[8] = {pf0[0], pf0[1], pf0[2], pf0[3], pf1[0], pf1[1], pf1[2], pf1[3]}, pb[8] = {pb0[0], pb0[1], pb0[2], pb0[3], pb1[0], pb1[1], pb1[2], pb1[3]};
          float o[8];
#pragma unroll
          for (int i = 0; i < 8; ++i) o[i] = (bflo(pf[i]) * sf[i] + bfhi(pf[i])) + (bflo(pb[i]) * sb[i] + bfhi(pb[i]));
          u32x4 w;
#pragma unroll
          for (int i = 0; i < 4; ++i) { float rr[2];
#pragma unroll
              for (int k = 0; k < 2; ++k) { const float x = k ? bfhi(glg[i]) : bflo(glg[i]); const float t2 = __expf(2.0f * 0.7978845608f * (x + 0.044715f * x * x * x));
                  rr[k] = o[2 * i + k] * (0.5f * x * (2.0f - 2.0f * __builtin_amdgcn_rcpf(t2 + 1.0f))); }
              w[i] = pg8::cvt_pk_bf16(rr[0], rr[1]); }
          *(u32x4*)(p.Aall + ((size_t)2 * MT + m) * 512 + c0) = w; }
    }
}

__device__ __forceinline__ void router_prep_phase(const Params& p) {
    const int tid = TIDX, lane = tid & 63;
    for (int i = blockIdx.x * NTHREADS + tid; i < DEPTH * 5 * 1024 * 8; i += gridDim.x * NTHREADS) { const int q = i & 7, k = (i >> 3) & 1023, lm = i >> 13, l = lm / 5;
        const float sc = p.norm2_g[l * D + k] * (1.0f + p.mod[(size_t)lm * 6144 + 4 * 1024 + k]); const float4 w = *(const float4*)(p.router_w + ((size_t)l * 1024 + k) * 32 + q * 4);
        *(float4*)(p.RWp + ((size_t)lm * 1024 + k) * 32 + q * 4) = make_float4(w.x * sc, w.y * sc, w.z * sc, w.w * sc); }
    const int gw = blockIdx.x * (NTHREADS / 64) + __builtin_amdgcn_readfirstlane(tid >> 6), nw = gridDim.x * (NTHREADS / 64);
    for (int t = gw; t < DEPTH * 5 * 32; t += nw) { const int e = t & 31, lm = t >> 5, l = lm / 5; float a = 0.f;
#pragma unroll
        for (int j = 0; j < 16; ++j) { const int k = j * 64 + lane; a += p.mod[(size_t)lm * 6144 + 3 * 1024 + k] * p.router_w[((size_t)l * 1024 + k) * 32 + e]; }
        a = wave_sum(a, lane); if (lane == 0) p.RC[lm * 32 + e] = a + p.router_b[l * 32 + e]; }
}
__device__ __forceinline__ int route_group_row0(int g, int last) { return last ? (g >> 7) * LT + LC + (g & 127) * 32 : g * 32; }
__device__ __forceinline__ void route_phase(const Params& p, int l, float* ldsf, int last) {
    const int tid = TIDX, lane = tid & 63, wave = __builtin_amdgcn_readfirstlane(tid >> 6); const int G = (int)gridDim.x;
    LAS float* tL = (LAS float*)ldsf; LAS float* tS = tL + 8448; LAS int* rec = (LAS int*)(tL + 8704);
    const int ti = lane & 31, kk = lane >> 5, gi = wave >> 1, kh = wave & 1;
    const int NG = last ? NB * SEQ / 32 : MT / 32;
    const int ngrp = ((int)blockIdx.x + 3 * G < NG) ? 4 : ((int)blockIdx.x + 2 * G < NG) ? 3 : ((int)blockIdx.x + G < NG) ? 2 : ((int)blockIdx.x < NG ? 1 : 0);
    if (gi < ngrp) {
        const int m0 = route_group_row0((int)blockIdx.x + gi * G, last), b = m0 / LT, pp0 = m0 - b * LT, mr = pp0 < LC ? 4 : b;
        const bf16_t* xrow = p.X + (size_t)(m0 + ti) * D + 4 * kk + 512 * kh;
        const float* rw = p.RWp + ((size_t)(l * 5 + mr) * 1024 + 512 * kh + 4 * kk) * 32 + ti;
        f32x16_t acc;
#pragma unroll
        for (int i = 0; i < 16; ++i) acc[i] = 0.f;
        float ss = 0.f;
#define RT_LOAD(XB, WB, DB, s0) do { if ((s0) < 64) { _Pragma("unroll") for (int q = 0; q < 4; ++q) { XB[q] = *(const u32x2*)(xrow + 8 * ((s0) + q)); \
            const float* rp = rw + (size_t)((s0) + q) * 256; WB[q][0] = rp[0]; WB[q][1] = rp[32]; WB[q][2] = rp[64]; WB[q][3] = rp[96]; } } } while (0)
#define RT_MMA(XB, WB, DB, s0) do { if ((s0) < 64) { _Pragma("unroll") for (int q = 0; q < 4; ++q) { const float x0_ = bflo(XB[q].x), x1_ = bfhi(XB[q].x), x2_ = bflo(XB[q].y), x3_ = bfhi(XB[q].y); \
            ss += x0_ * x0_ + x1_ * x1_ + x2_ * x2_ + x3_ * x3_; \
            acc = __builtin_amdgcn_mfma_f32_32x32x2f32(x0_, WB[q][0], acc, 0, 0, 0); acc = __builtin_amdgcn_mfma_f32_32x32x2f32(x1_, WB[q][1], acc, 0, 0, 0); \
            acc = __builtin_amdgcn_mfma_f32_32x32x2f32(x2_, WB[q][2], acc, 0, 0, 0); acc = __builtin_amdgcn_mfma_f32_32x32x2f32(x3_, WB[q][3], acc, 0, 0, 0); } } } while (0)
        u32x2 xA[4], xB[4], xC[4]; float wA[4][4], wB[4][4], wC[4][4];
        RT_LOAD(xA, wA, dA, 0); RT_LOAD(xB, wB, dB, 4);
        for (int s = 0; s < 64; s += 12) {
            RT_LOAD(xC, wC, dC, s + 8);  asm volatile("" ::: "memory"); RT_MMA(xA, wA, dA, s);
            RT_LOAD(xA, wA, dA, s + 12); asm volatile("" ::: "memory"); RT_MMA(xB, wB, dB, s + 4);
            RT_LOAD(xB, wB, dB, s + 16); asm volatile("" ::: "memory"); RT_MMA(xC, wC, dC, s + 8);
        }
#undef RT_LOAD
#undef RT_MMA
        ss += shx(ss, 32, lane);
        LAS float* t = tL + (gi * 2 + kh) * (32 * 33);
#pragma unroll
        for (int i = 0; i < 16; ++i) t[((i & 3) + 8 * (i >> 2) + 4 * kk) * 33 + ti] = acc[i];
        if (lane < 32) tS[(gi * 2 + kh) * 32 + ti] = ss;
    }
    __syncthreads();
    if (gi < ngrp && kh == 0) {
        const int m0 = route_group_row0((int)blockIdx.x + gi * G, last), b = m0 / LT, pp0 = m0 - b * LT, mr = pp0 < LC ? 4 : b;
        const float rstd = rsqrtf((tS[(gi * 2) * 32 + ti] + tS[(gi * 2 + 1) * 32 + ti]) * (1.0f / D) + 1e-6f);
        const LAS float* t0 = tL + (gi * 2) * (32 * 33) + ti * 33; const LAS float* t1 = t0 + 32 * 33;
        int e4[4] = {0, 0, 0, 0}; float w4[4] = {0.f, 0.f, 0.f, 0.f}; int pos4[4] = {0, 0, 0, 0};
        float lg[32];
#pragma unroll
        for (int e = 0; e < 32; ++e) lg[e] = (t0[e] + t1[e]) * rstd + p.RC[(l * 5 + mr) * 32 + e];
        float val[4];
#pragma unroll
        for (int k = 0; k < 4; ++k) { float best = -3.0e38f; int bi = 0;
#pragma unroll
            for (int e = 0; e < 32; ++e) { const bool better = lg[e] > best; best = better ? lg[e] : best; bi = better ? e : bi; }
            e4[k] = bi; val[k] = best;
#pragma unroll
            for (int e = 0; e < 32; ++e) lg[e] = (e == bi) ? -3.0e38f : lg[e]; }
        const float x1 = __expf(val[1] - val[0]), x2 = __expf(val[2] - val[0]), x3 = __expf(val[3] - val[0]); const float inv = 1.0f / (1.0f + x1 + x2 + x3);
        w4[0] = inv; w4[1] = x1 * inv; w4[2] = x2 * inv; w4[3] = x3 * inv;
        int rank4[4] = {0, 0, 0, 0}; int mycnt = 0;
#pragma unroll 4
        for (int e = 0; e < 32; ++e) { const bool hit = lane < 32 && (e4[0] == e || e4[1] == e || e4[2] == e || e4[3] == e);
            const unsigned long long mask = __ballot(hit); const int rk = __popcll(mask & ((1ull << lane) - 1ull));
#pragma unroll
            for (int k = 0; k < 4; ++k) rank4[k] = (e4[k] == e) ? rk : rank4[k];
            mycnt = (lane == e) ? __popcll(mask) : mycnt; }
        int base = 0;
        if (lane < 32 && mycnt > 0) base = (int)__hip_atomic_fetch_add(&p.ctrl[l * 64 + lane], (unsigned)mycnt, __ATOMIC_RELAXED, __HIP_MEMORY_SCOPE_AGENT);
#pragma unroll
        for (int k = 0; k < 4; ++k) pos4[k] = __builtin_amdgcn_ds_bpermute(e4[k] << 2, base) + rank4[k];
        if (lane < 32) { LAS int* rr = rec + (gi * 32 + ti) * 12;
#pragma unroll
            for (int k = 0; k < 4; ++k) { p.tok_e[(m0 + ti) * 4 + k] = e4[k]; p.tok_pos[(m0 + ti) * 4 + k] = pos4[k]; p.tok_w[(m0 + ti) * 4 + k] = w4[k]; rr[k] = e4[k]; rr[4 + k] = pos4[k]; }
            rr[8] = __float_as_int(rstd); }
    }
    __syncthreads();
    u32x4 xn[2];
    if (wave < ngrp * 32) { const int m = route_group_row0((int)blockIdx.x + (wave >> 5) * G, last) + (wave & 31);
#pragma unroll
        for (int j = 0; j < 2; ++j) { const int col = j * 512 + lane * 8; xn[j] = *(const u32x4*)(p.X + (size_t)m * D + col); } }
    for (int rw_ = wave; rw_ < ngrp * 32; rw_ += 8) {
        const int g2 = rw_ >> 5, tk = rw_ & 31; const int m = route_group_row0((int)blockIdx.x + g2 * G, last) + tk, b = m / LT, pp = m - b * LT, mr = pp < LC ? 4 : b;
        const LAS int* rr = rec + (g2 * 32 + tk) * 12; const float rs = __int_as_float(rr[8]);
        size_t rowoff[4];
#pragma unroll
        for (int k = 0; k < 4; ++k) rowoff[k] = ((size_t)rr[k] * (CAPT * 256) + rr[4 + k]) * D;
        const float* mv = p.mod + (size_t)(l * 5 + mr) * 6144;
        u32x4 xv[2]; float4 gv[2][2], scv[2][2], shv[2][2];
#pragma unroll
        for (int j = 0; j < 2; ++j) { const int col = j * 512 + lane * 8; xv[j] = xn[j];
#pragma unroll
            for (int q = 0; q < 2; ++q) { gv[j][q] = *(const float4*)(p.norm2_g + l * D + col + 4 * q); scv[j][q] = *(const float4*)(mv + 4 * 1024 + col + 4 * q); shv[j][q] = *(const float4*)(mv + 3 * 1024 + col + 4 * q); } }
        if (rw_ + 8 < ngrp * 32) { const int mn = route_group_row0((int)blockIdx.x + ((rw_ + 8) >> 5) * G, last) + ((rw_ + 8) & 31);
#pragma unroll
            for (int j = 0; j < 2; ++j) { const int col = j * 512 + lane * 8; xn[j] = *(const u32x4*)(p.X + (size_t)mn * D + col); } }
#pragma unroll
        for (int j = 0; j < 2; ++j) { const int col = j * 512 + lane * 8; u32x2 w4;
#pragma unroll
            for (int q = 0; q < 2; ++q) {
                const unsigned x0 = xv[j][2 * q], x1 = xv[j][2 * q + 1]; const float4 x = make_float4(bflo(x0), bfhi(x0), bflo(x1), bfhi(x1));
                w4[q] = pk_fp8x4(x.x * rs * gv[j][q].x * (1.f + scv[j][q].x) + shv[j][q].x, x.y * rs * gv[j][q].y * (1.f + scv[j][q].y) + shv[j][q].y,
                                 x.z * rs * gv[j][q].z * (1.f + scv[j][q].z) + shv[j][q].z, x.w * rs * gv[j][q].w * (1.f + scv[j][q].w) + shv[j][q].w); }
#pragma unroll
            for (int k = 0; k < 4; ++k) *(u32x2*)(p.Xg + rowoff[k] + col) = w4; }
    }
}

struct EpiBranch {
    static constexpr bool PERM = true, AFTER_DRAIN = false;
    bf16_t* R;
    __device__ __forceinline__ void operator()(const f32x4 (&acc)[2][2][4][2], const Unit& u, int wr, int wc, int fr, int fq) const {
        const int br = u.pn >> 2, pnl = u.pn & 3, pmr = u.pm - br * 68;
        bf16_t* base = R + (size_t)br * MT * D + (size_t)(pmr * 256 + wr * 64 + fr) * D + pnl * 256 + wc * 32 + 8 * fq;
#pragma unroll
        for (int ai = 0; ai < 2; ++ai)
#pragma unroll
            for (int m = 0; m < 4; ++m) { bf16_t* rowp = base + (size_t)(ai * 128 + m * 16) * D;
#pragma unroll
                for (int bj = 0; bj < 2; ++bj) { const f32x4 v0 = acc[ai][bj][m][0], v1 = acc[ai][bj][m][1];
                    u32x4 w; w.x = pg8::cvt_pk_bf16(v0[0], v0[1]); w.y = pg8::cvt_pk_bf16(v0[2], v0[3]); w.z = pg8::cvt_pk_bf16(v1[0], v1[1]); w.w = pg8::cvt_pk_bf16(v1[2], v1[3]);
                    *(u32x4*)(rowp + bj * 128) = w; } }
    }
};
__device__ __forceinline__ int latent_row_tile(int k) { return (k >> 4) * 17 + 1 + (k & 15); }
struct SchedMerge { int G, c, last;
    __device__ bool next(int i, Unit& u) const { const int nt = last ? 256 : 272; const int L = i * G + c; if (L >= 3 * nt) return false; const int br = L / nt, tile = L - br * nt;
        u.pm = br * 68 + (last ? latent_row_tile(tile >> 2) : (tile >> 2)); u.pn = br * 4 + (tile & 3); u.po = 0; return true; }
    __device__ __forceinline__ void a_ready(const Unit&) const {}
    __device__ __forceinline__ void done(const Unit&) const {}
};
__device__ __forceinline__ void merge_combine_phase(const Params& p, int last) {
    const int tid = TIDX, lane = tid & 63; const int gw = blockIdx.x * (NTHREADS / 64) + __builtin_amdgcn_readfirstlane(tid >> 6), nw = gridDim.x * (NTHREADS / 64);
    for (int m = gw; m < MT; m += nw) {
        if (last && (m % LT) < LC) continue;
        u32x4 rv[2][3], gv[2][3];
#pragma unroll
        for (int hf = 0; hf < 2; ++hf)
#pragma unroll
            for (int br = 0; br < 3; ++br) { const int col = hf * 512 + lane * 8; rv[hf][br] = *(const u32x4*)(p.R + ((size_t)br * MT + m) * D + col); gv[hf][br] = *(const u32x4*)(p.U + (size_t)m * INC + C_GR + br * 1024 + col); }
#pragma unroll
        for (int hf = 0; hf < 2; ++hf) { const int col = hf * 512 + lane * 8; float o[8];
#pragma unroll
            for (int i = 0; i < 8; ++i) o[i] = 0.f;
#pragma unroll
            for (int br = 0; br < 3; ++br)
#pragma unroll
                for (int i = 0; i < 4; ++i) { o[2 * i] += sigmoidf_(bflo(gv[hf][br][i])) * bflo(rv[hf][br][i]); o[2 * i + 1] += sigmoidf_(bfhi(gv[hf][br][i])) * bfhi(rv[hf][br][i]); }
            u32x4 w; w.x = pg8::cvt_pk_bf16(o[0], o[1]); w.y = pg8::cvt_pk_bf16(o[2], o[3]); w.z = pg8::cvt_pk_bf16(o[4], o[5]); w.w = pg8::cvt_pk_bf16(o[6], o[7]);
            *(u32x4*)(p.Mg + (size_t)m * D + col) = w; }
    }
}
struct SchedOut { int nN, nwg, G, c, last;
    __device__ void init(int M, int N, int G_, int c_, int last_) { nN = N / 256; nwg = (M / 256) * nN; G = G_; c = c_; last = last_; }
    __device__ bool next(int i, Unit& u) const {
        const int L = i * G + c; if (L >= (last ? 256 : nwg)) return false;
        const int nM = nwg / nN; int wgid = L; { const int q = nwg / 8, r = nwg % 8, xcd = wgid % 8, off = wgid / 8; wgid = (xcd < r ? xcd * (q + 1) : r * (q + 1) + (xcd - r) * q) + off; }
        const int nig = 8 * nN, gid = wgid / nig, fm = gid * 8, gsz = (nM - fm) < 8 ? (nM - fm) : 8;
        const int pm0 = fm + ((wgid % nig) % gsz), pn0 = (wgid % nig) / gsz;
        u.pm = last ? latent_row_tile(L >> 2) : pm0; u.pn = last ? (L & 3) : pn0; u.po = 0; return true; }
    __device__ __forceinline__ void a_ready(const Unit&) const {}
    __device__ __forceinline__ void done(const Unit&) const {}
};
struct EpiOut {
    static constexpr bool PERM = true, AFTER_DRAIN = false;
    bf16_t* X; const float* mod_l;
    __device__ __forceinline__ void operator()(const f32x4 (&acc)[2][2][4][2], const Unit& u, int wr, int wc, int fr, int fq) const {
        const int mr = (u.pm % 17 == 0) ? 4 : u.pm / 17; const float* g1 = mod_l + mr * 6144 + 2 * 1024;
        const int row0 = u.pm * 256 + wr * 64 + fr, col0 = u.pn * 256 + wc * 32 + 8 * fq;
        bf16_t* base = X + (size_t)row0 * D + col0;
        u32x4 xo[2][4][2];
#pragma unroll
        for (int ai = 0; ai < 2; ++ai)
#pragma unroll
            for (int m = 0; m < 4; ++m)
#pragma unroll
                for (int bj = 0; bj < 2; ++bj) xo[ai][m][bj] = *(const u32x4*)(base + (size_t)(ai * 128 + m * 16) * D + bj * 128);
        f32x4 gv[2][2];
#pragma unroll
        for (int bj = 0; bj < 2; ++bj)
#pragma unroll
            for (int n = 0; n < 2; ++n) gv[bj][n] = *(const f32x4*)(g1 + col0 + bj * 128 + 4 * n);
#pragma unroll
        for (int ai = 0; ai < 2; ++ai)
#pragma unroll
            for (int m = 0; m < 4; ++m) { bf16_t* rowp = base + (size_t)(ai * 128 + m * 16) * D;
#pragma unroll
                for (int bj = 0; bj < 2; ++bj) { const f32x4 v0 = acc[ai][bj][m][0] * gv[bj][0], v1 = acc[ai][bj][m][1] * gv[bj][1]; const u32x4 o = xo[ai][m][bj];
                    u32x4 w; w.x = pg8::cvt_pk_bf16(bflo(o[0]) + v0[0], bfhi(o[0]) + v0[1]); w.y = pg8::cvt_pk_bf16(bflo(o[1]) + v0[2], bfhi(o[1]) + v0[3]);
                    w.z = pg8::cvt_pk_bf16(bflo(o[2]) + v1[0], bfhi(o[2]) + v1[1]); w.w = pg8::cvt_pk_bf16(bflo(o[3]) + v1[2], bfhi(o[3]) + v1[3]);
                    *(u32x4*)(rowp + bj * 128) = w; } }
    }
};
struct SchedMoE { int nN, G, c, sparseA;
    __device__ bool next(int i, Unit& u) const { const LAS int* te = (const LAS int*)((const LAS char*)dyn_lds_base() + TB_OFF); const LAS int* tb = te + MAXTILES;
        if ((G & 63) == 0 && nN == 8) { const int x = c & 7, r = c >> 3, tile = i * (G >> 3) + 8 * (r >> 3) + x, j = r & 7; if (tile >= tb[NE]) return false; const int e = te[tile];
            u.po = tile; u.pm = sparseA ? e * CAPT + (tile - tb[e]) : tile; u.pn = e * nN + j; return true; }
        const int L = i * G + c; if (L >= tb[NE] * nN) return false; const int tile = L / nN, j = L - tile * nN, e = te[tile];
        u.po = tile; u.pm = sparseA ? e * CAPT + (tile - tb[e]) : tile; u.pn = e * nN + j; return true; }
    __device__ __forceinline__ void a_ready(const Unit&) const {}
    __device__ __forceinline__ void done(const Unit&) const {}
};
struct EpiGU {
    static constexpr bool PERM = true, AFTER_DRAIN = false;
    unsigned char* Act; const float* bgu;
    __device__ __forceinline__ void operator()(const f32x4 (&acc)[2][2][4][2], const Unit& u, int wr, int wc, int fr, int fq) const {
        const int e = u.pn >> 3, pnl = u.pn & 7; const int row0 = u.po * 256 + wr * 64 + fr, c8 = pnl * 128 + wc * 32 + 8 * fq;
        const float* bg = bgu + e * 2048 + c8; const f32x4 bg0 = *(const f32x4*)bg, bg1 = *(const f32x4*)(bg + 4), bu0 = *(const f32x4*)(bg + 1024), bu1 = *(const f32x4*)(bg + 1028);
#pragma unroll
        for (int ai = 0; ai < 2; ++ai)
#pragma unroll
            for (int m = 0; m < 4; ++m) { const float is_ = 1.0f / W8_SCALE; const f32x4 g0 = acc[ai][0][m][0] * is_ + bg0, g1 = acc[ai][0][m][1] * is_ + bg1, u0 = acc[ai][1][m][0] * is_ + bu0, u1 = acc[ai][1][m][1] * is_ + bu1; float r[8];
#pragma unroll
                for (int j = 0; j < 4; ++j) { const float ga = fminf(g0[j], 7.0f), ua = fminf(fmaxf(u0[j], -7.0f), 7.0f); r[j] = (ua + 1.0f) * (ga * sigmoidf_(1.702f * ga));
                    const float gb = fminf(g1[j], 7.0f), ub = fminf(fmaxf(u1[j], -7.0f), 7.0f); r[4 + j] = (ub + 1.0f) * (gb * sigmoidf_(1.702f * gb)); }
                u32x2 w; w.x = pk_fp8x4(r[0], r[1], r[2], r[3]); w.y = pk_fp8x4(r[4], r[5], r[6], r[7]);
                *(u32x2*)(Act + (size_t)(row0 + ai * 128 + m * 16) * D + c8) = w; }
    }
};
struct EpiDown {
    static constexpr bool PERM = true, AFTER_DRAIN = false;
    unsigned char* Y; const float* bd;
    __device__ __forceinline__ void operator()(const f32x4 (&acc)[2][2][4][2], const Unit& u, int wr, int wc, int fr, int fq) const {
        const int e = u.pn >> 2, pnl = u.pn & 3; const int row0 = u.po * 256 + wr * 64 + fr, col0 = pnl * 256 + wc * 32 + 8 * fq;
        f32x4 bv[2][2];
#pragma unroll
        for (int bj = 0; bj < 2; ++bj)
#pragma unroll
            for (int n = 0; n < 2; ++n) bv[bj][n] = *(const f32x4*)(bd + e * 1024 + col0 + bj * 128 + 4 * n);
#pragma unroll
        for (int ai = 0; ai < 2; ++ai)
#pragma unroll
            for (int m = 0; m < 4; ++m) { unsigned char* rowp = Y + (size_t)(row0 + ai * 128 + m * 16) * D + col0;
#pragma unroll
                for (int bj = 0; bj < 2; ++bj) { const float is_ = 1.0f / W8_SCALE; f32x4 v0 = acc[ai][bj][m][0] * is_ + bv[bj][0], v1 = acc[ai][bj][m][1] * is_ + bv[bj][1];
#pragma unroll
                    for (int j = 0; j < 4; ++j) { v0[j] = fminf(fmaxf(v0[j], -448.f), 448.f); v1[j] = fminf(fmaxf(v1[j], -448.f), 448.f); }
                    u32x2 w; int t0 = __builtin_amdgcn_cvt_pk_fp8_f32(v0[0], v0[1], 0, false); t0 = __builtin_amdgcn_cvt_pk_fp8_f32(v0[2], v0[3], t0, true);
                    int t1 = __builtin_amdgcn_cvt_pk_fp8_f32(v1[0], v1[1], 0, false); t1 = __builtin_amdgcn_cvt_pk_fp8_f32(v1[2], v1[3], t1, true);
                    w.x = (unsigned)t0; w.y = (unsigned)t1; *(u32x2*)(rowp + bj * 128) = w; } }
    }
};

constexpr int NSEG = 9;
__device__ __forceinline__ int seg_first(int dir, int s) { return dir == 0 ? (s == 0 ? 0 : 8 + 16 * (s - 1)) : (s == 0 ? 7 : 135 - 16 * (s - 1)); }
__device__ __forceinline__ int seg_count(int s) { return s == 0 ? 8 : 16; }

template <int DKT, int NVT, bool VEC, bool FULL>
__device__ __forceinline__ void wave_seg(const bf16_t* __restrict__ Qg, const bf16_t* __restrict__ Kg, const bf16_t* __restrict__ Vg, int vs, bf16_t* __restrict__ Og,
                                         const float* __restrict__ alpha, float gsc, int b, int cs0, int dcs, int nst, int dir, int strict,
                                         f32x16_t (&S)[DKT][NVT], LAS char* lds, int lane) {
    constexpr int KP = DKT * 64 + 16, VP = NVT * 64 + 16, KC = DKT * 4, VC = NVT * 4;
    constexpr int KRI = 64 / KC, VRI = 64 / VC;
    const int r = lane & 31, h = lane >> 5;
    LAS char* tK = lds; LAS char* tV = lds + 32 * KP; LAS char* tA = tV + 32 * VP; LAS char* tG = tA + DKT * 128;
    u32x4 nK[2 * DKT], nV[2 * NVT]; u32x4 nQ[2 * DKT]; f32x4 nA = {1.f, 1.f, 1.f, 1.f};
    const unsigned koff = (unsigned)((lane / KC) * 1024 + (lane % KC) * 16), voff = (unsigned)((lane / VC) * (vs * 2) + (lane % VC) * 16), qoff = (unsigned)(r * 1024 + h * 16);
    const unsigned ooff = (unsigned)(h * 4 * 1024 + r * 2), ldk = (unsigned)((lane / KC) * KP + (lane % KC) * 16), ldv = (unsigned)((lane / VC) * VP + (lane % VC) * 16);
    {   const size_t m0 = (size_t)b * LT + cs0 * 32;
        const GAS char* kb = uni_ptr(Kg + m0 * 512); const GAS char* vb = uni_ptr(Vg + m0 * vs);
#pragma unroll
        for (int i = 0; i < 2 * DKT; ++i) nK[i] = *(const GAS u32x4*)(kb + koff + i * (KRI * 1024));
#pragma unroll
        for (int i = 0; i < 2 * NVT; ++i) nV[i] = *(const GAS u32x4*)(vb + voff + (size_t)i * VRI * (vs * 2));
        if (FULL) { const GAS char* qb = uni_ptr(Qg + m0 * 512);
#pragma unroll
            for (int x = 0; x < 2 * DKT; ++x) nQ[x] = *(const GAS u32x4*)(qb + qoff + 32 * x); }
        if (VEC) nA = *(const GAS f32x4*)(uni_ptr(alpha + (size_t)cs0 * 512) + (unsigned)((lane & (DKT * 8 - 1)) * 16)); }
    f32x16_t Oprev[NVT]; GAS char* ob_prev = nullptr;
    for (int si = 0; si < nst; ++si) {
        const int cs = cs0 + si * dcs; const size_t m0 = (size_t)b * LT + cs * 32;
#pragma unroll
        for (int i = 0; i < 2 * DKT; ++i) *(LAS u32x4*)(tK + ldk + i * (KRI * KP)) = nK[i];
#pragma unroll
        for (int i = 0; i < 2 * NVT; ++i) *(LAS u32x4*)(tV + ldv + i * (VRI * VP)) = nV[i];
        if (VEC) { *(LAS f32x4*)(tA + (lane & (DKT * 8 - 1)) * 16) = nA;
            if (!FULL) { LAS f32x4* gp = (LAS f32x4*)(tG + (lane & (DKT * 8 - 1)) * 16); const f32x4 gprev = si == 0 ? (f32x4){1.f, 1.f, 1.f, 1.f} : *gp; asm volatile("s_waitcnt lgkmcnt(0)" ::: "memory"); *gp = gprev * nA; } }
        if (FULL && si > 0) {
#pragma unroll
            for (int n = 0; n < NVT; ++n)
#pragma unroll
                for (int i = 0; i < 16; ++i) *(GAS bf16_t*)(ob_prev + ooff + ((i & 3) + 8 * (i >> 2)) * 1024 + 64 * n) = (bf16_t)(pk_bf16(Oprev[n][i], 0.f) & 0xffffu); }
        bf16x8_t Qf[2 * DKT];
        if (FULL) {
#pragma unroll
            for (int x = 0; x < 2 * DKT; ++x) { const u32x4 q = nQ[x];
                const u32x2 s0 = __builtin_amdgcn_permlane32_swap(q[0], q[2], false, false), s1 = __builtin_amdgcn_permlane32_swap(q[1], q[3], false, false);
                u32x4 w; w[0] = s0[0]; w[1] = s1[0]; w[2] = s0[1]; w[3] = s1[1]; Qf[x] = __builtin_bit_cast(bf16x8_t, w); } }
        const size_t m1 = (size_t)b * LT + (cs + dcs) * 32;
        if (si + 1 < nst) { const GAS char* kb = uni_ptr(Kg + m1 * 512); const GAS char* vb = uni_ptr(Vg + m1 * vs);
#pragma unroll
            for (int i = 0; i < 2 * DKT; ++i) nK[i] = *(const GAS u32x4*)(kb + koff + i * (KRI * 1024));
#pragma unroll
            for (int i = 0; i < 2 * NVT; ++i) nV[i] = *(const GAS u32x4*)(vb + voff + (size_t)i * VRI * (vs * 2));
            if (VEC) nA = *(const GAS f32x4*)(uni_ptr(alpha + (size_t)(cs + dcs) * 512) + (unsigned)((lane & (DKT * 8 - 1)) * 16));
        }
        asm volatile("s_waitcnt lgkmcnt(0)" ::: "memory");
        if (FULL) {
            f32x16_t X, X2; bf16x8_t Kf[2 * DKT];
#pragma unroll
            for (int x = 0; x < 2 * DKT; ++x) Kf[x] = frag_row(tK, KP, r, 16 * x + 4 * h);
#pragma unroll
            for (int i = 0; i < 16; ++i) { X[i] = 0.f; X2[i] = 0.f; }
#pragma unroll
            for (int x = 0; x < 2 * DKT; x += 2) { X = MFMA32(Kf[x], Qf[x], X); X2 = MFMA32(Kf[x + 1], Qf[x + 1], X2); }
#pragma unroll
            for (int i = 0; i < 16; ++i) X[i] += X2[i];
#pragma unroll
            for (int i = 0; i < 16; ++i) { const int j = (i & 3) + 8 * (i >> 2) + 4 * h; const bool keep = dir == 0 ? (j <= r) : (j >= r + strict); X[i] = keep ? X[i] : 0.f; }
            const bf16x8_t Xa0 = pack8<0>(X), Xa1 = pack8<1>(X);
            ob_prev = (GAS char*)uni_ptr(Og + m0 * 512);
#pragma unroll
            for (int n = 0; n < NVT; ++n) {
                f32x16_t O;
#pragma unroll
                for (int i = 0; i < 16; ++i) O[i] = 0.f;
                O = MFMA32(Xa0, frag_tr(tV, VP, 4 * h, n, lane), O);
                O = MFMA32(Xa1, frag_tr(tV, VP, 16 + 4 * h, n, lane), O);
#pragma unroll
                for (int a = 0; a < DKT; ++a) { O = MFMA32(Qf[2 * a], pack8<0>(S[a][n]), O); O = MFMA32(Qf[2 * a + 1], pack8<1>(S[a][n]), O); }
                Oprev[n] = O;
                    }
            asm volatile("" ::: "memory");
            if (si + 1 < nst) { const GAS char* qb = uni_ptr(Qg + m1 * 512);
#pragma unroll
                for (int x = 0; x < 2 * DKT; ++x) nQ[x] = *(const GAS u32x4*)(qb + qoff + 32 * x); }
        }
#pragma unroll
        for (int a = 0; a < DKT; ++a) {
            f32x4 al[4];
            if (VEC) {
#pragma unroll
                for (int g = 0; g < 4; ++g) al[g] = *(const LAS f32x4*)(tA + (32 * a + 8 * g + 4 * h) * 4); }
            const bf16x8_t k0 = frag_tr(tK, KP, 4 * h, a, lane), k1 = frag_tr(tK, KP, 16 + 4 * h, a, lane);
#pragma unroll
            for (int n = 0; n < NVT; ++n) {
                S[a][n] = MFMA32(k0, frag_tr(tV, VP, 4 * h, n, lane), S[a][n]);
                S[a][n] = MFMA32(k1, frag_tr(tV, VP, 16 + 4 * h, n, lane), S[a][n]);
#pragma unroll
                for (int i = 0; i < 16; ++i) S[a][n][i] *= VEC ? al[i >> 2][i & 3] : gsc;
            }
        }
    }
    if (FULL && nst > 0) {
#pragma unroll
        for (int n = 0; n < NVT; ++n)
#pragma unroll
            for (int i = 0; i < 16; ++i) *(GAS bf16_t*)(ob_prev + ooff + ((i & 3) + 8 * (i >> 2)) * 1024 + 64 * n) = (bf16_t)(pk_bf16(Oprev[n][i], 0.f) & 0xffffu); }
}

template <int DKT, int NVT, bool VEC, bool FULL>
__device__ __forceinline__ void chain_task(const Params& p, int l, int chain, int seg, LAS char* lds, int lane) {
    int b, dir, strict; const bf16_t *Qg, *Kg, *Vg; bf16_t* Og; const float* alpha = nullptr; float gsc = 0.f; size_t tbase;
    if (!VEC) { const int h = chain & 7; b = chain >> 4; dir = (chain >> 3) & 1; strict = 1; const float gam = 1.0f / (1.0f + expf(-p.ret_decay[l * 16 + dir * 8 + h])); gsc = exp2f(32.0f * log2f(gam));
        Qg = p.RQ + (size_t)dir * MT * 512 + h * 64; Kg = p.RK + (size_t)dir * MT * 512 + h * 64; Vg = p.U + C_RV + h * 64; Og = p.Oret + (size_t)dir * MT * 512 + h * 64; tbase = (size_t)chain * NSEG;
    } else { const int h = (chain >> 2) & 3, dq = chain & 3; b = chain >> 5; dir = (chain >> 4) & 1; strict = 0;
        Qg = p.HQ + (size_t)dir * MT * 512 + h * 128; Kg = p.HK + (size_t)dir * MT * 512 + h * 128; Vg = p.U + C_HI + h * 128 + dq * 32; Og = p.Ohg + (size_t)dir * MT * 512 + h * 128 + dq * 32;
        alpha = p.HA + ((size_t)dir * NCH + b * 136) * 512 + h * 128; tbase = (size_t)(64 + chain) * NSEG; }
    f32x16_t S[DKT][NVT];
#pragma unroll
    for (int a = 0; a < DKT; ++a)
#pragma unroll
        for (int n = 0; n < NVT; ++n)
#pragma unroll
            for (int i = 0; i < 16; ++i) S[a][n][i] = 0.f;
    constexpr int TS = DKT * NVT * 16 * 64, TG = 128;
    const int h = lane >> 5;
    if (FULL) {
        for (int s2 = 0; s2 < seg; ++s2) { const float* e = p.SE + (tbase + s2) * TS + lane; const float* gq = p.SG + (tbase + s2) * TG + 4 * h; const float gs = s2 == 0 ? 0.f : exp2f(16.0f * log2f(gsc));
#pragma unroll
            for (int a = 0; a < DKT; ++a) {
                f32x4 gv[4];
#pragma unroll
                for (int g = 0; g < 4; ++g) gv[g] = VEC ? *(const f32x4*)(gq + 32 * a + 8 * g) : (f32x4){gs, gs, gs, gs};
#pragma unroll
                for (int n = 0; n < NVT; ++n)
#pragma unroll
                    for (int i = 0; i < 16; ++i) S[a][n][i] = gv[i >> 2][i & 3] * S[a][n][i] + e[((a * NVT + n) * 16 + i) * 64]; } }
    }
    wave_seg<DKT, NVT, VEC, FULL>(Qg, Kg, Vg, INC, Og, alpha, gsc, b, seg_first(dir, seg), dir == 0 ? 1 : -1, seg_count(seg), dir, strict, S, lds, lane);
    if (!FULL) { float* e = p.SE + (tbase + seg) * TS + lane;
#pragma unroll
        for (int a = 0; a < DKT; ++a)
#pragma unroll
            for (int n = 0; n < NVT; ++n)
#pragma unroll
                for (int i = 0; i < 16; ++i) e[((a * NVT + n) * 16 + i) * 64] = S[a][n][i];
        if (VEC) { constexpr int KPc = DKT * 64 + 16, VPc = NVT * 64 + 16;
            const f32x4 gfin = *(const LAS f32x4*)(lds + 32 * KPc + 32 * VPc + DKT * 128 + (lane & (DKT * 8 - 1)) * 16);
            if (lane < DKT * 8) *(f32x4*)(p.SG + (tbase + seg) * TG + lane * 4) = gfin; }
    }
}

template <bool FULL, int VAR = 0> __device__ __forceinline__ void sweep_phase(const Params& p, int l, float* ldsf) {
    const int tid = TIDX, wave = __builtin_amdgcn_readfirstlane(tid >> 6); const int G = (int)gridDim.x;
    constexpr int NS = FULL ? NSEG : NSEG - 1;
    constexpr int N_HG = 128 * NS, N_RET = 64 * NS, N_LRU = FULL ? 0 : 64;
    LAS char* lds = (LAS char*)ldsf + wave * 12288;
    const int NW = 8 * G, w = wave * G + (int)blockIdx.x;
#ifndef NO_HG
    if (VAR != 2) for (int t = w; t < N_HG; t += NW) { const int chain = t / NS, seg = t - chain * NS; chain_task<4, 1, true, FULL>(p, l, chain, seg, lds, TIDX & 63); }
#endif
#ifndef NO_RET
    if (VAR != 1) for (int t = (w + NW - N_HG % NW) % NW; t < N_RET; t += NW) { const int chain = t / NS, seg = t - chain * NS; chain_task<2, 2, false, FULL>(p, l, chain, seg, lds, TIDX & 63); }
#endif
    for (int t = (w + NW - (N_HG + N_RET) % NW) % NW; t < N_LRU; t += NW) lru_tilescan_task(p, t, TIDX & 63);
}

__device__ __forceinline__ void mixprep_phase(const Params& p, int l) {
    const int tid = TIDX, lane = tid & 63; const int gw = blockIdx.x * (NTHREADS / 64) + __builtin_amdgcn_readfirstlane(tid >> 6), nw = gridDim.x * (NTHREADS / 64);
    float lgd[2];
#pragma unroll
    for (int dir = 0; dir < 2; ++dir) { const float gam = 1.0f / (1.0f + expf(-p.ret_decay[l * 16 + dir * 8 + (lane >> 3)])); lgd[dir] = log2f(gam); }
    for (int m = gw; m < MT; m += nw) {
        const int b = m / LT, pp = m - b * LT; const int hh = lane >> 3, d0 = (lane & 7) * 4;
        const bf16_t* u = p.U + (size_t)m * INC + hh * 64 + d0;
        const u32x2 qlo = *(const u32x2*)(u + C_RQ), qhi = *(const u32x2*)(u + C_RQ + 32), klo = *(const u32x2*)(u + C_RK), khi = *(const u32x2*)(u + C_RK + 32);
        float q1[4] = {bflo(qlo[0]), bfhi(qlo[0]), bflo(qlo[1]), bfhi(qlo[1])}, q2[4] = {bflo(qhi[0]), bfhi(qhi[0]), bflo(qhi[1]), bfhi(qhi[1])};
        float k1[4] = {bflo(klo[0]) * 0.125f, bfhi(klo[0]) * 0.125f, bflo(klo[1]) * 0.125f, bfhi(klo[1]) * 0.125f}, k2[4] = {bflo(khi[0]) * 0.125f, bfhi(khi[0]) * 0.125f, bflo(khi[1]) * 0.125f, bfhi(khi[1]) * 0.125f};
        if (pp >= LC) { const int tt = pp - LC;
            const float4 r0 = *(const float4*)(p.rot + (size_t)(tt * 32 + d0) * 2), r1 = *(const float4*)(p.rot + (size_t)(tt * 32 + d0) * 2 + 4);
            const float cc[4] = {r0.x, r0.z, r1.x, r1.z}, ss[4] = {r0.y, r0.w, r1.y, r1.w};
#pragma unroll
            for (int i = 0; i < 4; ++i) { const float a = q1[i] * cc[i] - q2[i] * ss[i], bq = q1[i] * ss[i] + q2[i] * cc[i]; q1[i] = a; q2[i] = bq;
                const float ck = k1[i] * cc[i] - k2[i] * ss[i], dk = k1[i] * ss[i] + k2[i] * cc[i]; k1[i] = ck; k2[i] = dk; } }
        const int ii = pp & 31;
#pragma unroll
        for (int dir = 0; dir < 2; ++dir) { const float lg = lgd[dir]; const float e = dir == 0 ? (float)(ii + 1) : (float)(32 - ii);
            const float sq = __builtin_amdgcn_exp2f(e * lg), sk = __builtin_amdgcn_exp2f(-e * lg);
            bf16_t* oq = p.RQ + ((size_t)dir * MT + m) * 512 + hh * 64 + d0; bf16_t* ok = p.RK + ((size_t)dir * MT + m) * 512 + hh * 64 + d0;
            u32x2 w; w[0] = pk_bf16(q1[0] * sq, q1[1] * sq); w[1] = pk_bf16(q1[2] * sq, q1[3] * sq); *(u32x2*)oq = w;
            w[0] = pk_bf16(q2[0] * sq, q2[1] * sq); w[1] = pk_bf16(q2[2] * sq, q2[3] * sq); *(u32x2*)(oq + 32) = w;
            w[0] = pk_bf16(k1[0] * sk, k1[1] * sk); w[1] = pk_bf16(k1[2] * sk, k1[3] * sk); *(u32x2*)ok = w;
            w[0] = pk_bf16(k2[0] * sk, k2[1] * sk); w[1] = pk_bf16(k2[2] * sk, k2[3] * sk); *(u32x2*)(ok + 32) = w; }
    }
    for (int unit = gw; unit < NCH * 8; unit += nw) {
        const int dir = unit & 1, ch = unit >> 3, hd = (unit >> 1) & 3, b = ch / 136, cs = ch - b * 136; const size_t m0 = (size_t)b * LT + cs * 32; const int c = hd * 128 + 2 * lane;
        unsigned zz_[32], qq[32]; const int zc = dir == 0 ? C_HFF : C_HFB;
        { const bf16_t* u = p.U + m0 * INC + c;
#pragma unroll
          for (int j = 0; j < 32; ++j) { zz_[j] = *(const unsigned*)(u + (size_t)j * INC + zc); qq[j] = *(const unsigned*)(u + (size_t)j * INC + C_HQ); } }
        const float lb0 = p.lb[l * 1024 + dir * 512 + c], lb1 = p.lb[l * 1024 + dir * 512 + c + 1];
        float G0 = 1.f, G1 = 1.f;
        if (dir == 0) {
#pragma unroll
            for (int s = 0; s < 32; ++s) { const int j = s; const unsigned zz = zz_[j];
                const float z0 = bflo(zz), z1 = bfhi(zz), qa = bflo(qq[j]), qb = bfhi(qq[j]);
                const float s0 = sigmoidf_(z0), s1 = sigmoidf_(z1); const float f0 = lb0 + (1.0f - lb0) * s0, f1 = lb1 + (1.0f - lb1) * s1;
                G0 *= f0; G1 *= f1;
                const float K0 = (1.0f - lb0) * (1.0f - s0) * __builtin_amdgcn_rcpf(fmaxf(G0, 1.0e-35f)), K1 = (1.0f - lb1) * (1.0f - s1) * __builtin_amdgcn_rcpf(fmaxf(G1, 1.0e-35f));
                *(unsigned*)(p.HQ + ((size_t)dir * MT + m0 + j) * 512 + c) = pk_bf16(qa * sigmoidf_(qa) * G0, qb * sigmoidf_(qb) * G1); *(unsigned*)(p.HK + ((size_t)dir * MT + m0 + j) * 512 + c) = pk_bf16(K0, K1); }
        } else {
#pragma unroll
            for (int s = 0; s < 32; ++s) { const int j = 31 - s; const unsigned zz = zz_[j];
                const float z0 = bflo(zz), z1 = bfhi(zz), qa = bflo(qq[j]), qb = bfhi(qq[j]);
                const float s0 = sigmoidf_(z0), s1 = sigmoidf_(z1); const float f0 = lb0 + (1.0f - lb0) * s0, f1 = lb1 + (1.0f - lb1) * s1;
                G0 *= f0; G1 *= f1;
                const float K0 = (1.0f - lb0) * (1.0f - s0) * __builtin_amdgcn_rcpf(fmaxf(G0, 1.0e-35f)), K1 = (1.0f - lb1) * (1.0f - s1) * __builtin_amdgcn_rcpf(fmaxf(G1, 1.0e-35f));
                *(unsigned*)(p.HQ + ((size_t)dir * MT + m0 + j) * 512 + c) = pk_bf16(qa * sigmoidf_(qa) * G0, qb * sigmoidf_(qb) * G1); *(unsigned*)(p.HK + ((size_t)dir * MT + m0 + j) * 512 + c) = pk_bf16(K0, K1); }
        }
        *(f32x2_t*)(p.HA + ((size_t)dir * NCH + ch) * 512 + c) = (f32x2_t){G0, G1};
    }
}

#ifndef GP_SP2
#define GP_SP2 true
#endif
#ifndef GP_ALIGN
#define GP_ALIGN true
#endif
constexpr int LDS_MAIN = 1024 * 36 * 4;
constexpr int LDS_TOTAL = LDS_MAIN + 16;

struct EpiScaledBf16 {
    static constexpr bool PERM = true, AFTER_DRAIN = false;
    bf16_t* O; int ldc; float scale;
    __device__ __forceinline__ void operator()(const f32x4 (&acc)[2][2][4][2], const Unit& u, int wr, int wc, int fr, int fq) const {
        bf16_t* base = O + (size_t)(u.pm * 256 + wr * 64 + fr) * ldc + u.pn * 256 + wc * 32 + 8 * fq;
#pragma unroll
        for (int ai = 0; ai < 2; ++ai)
#pragma unroll
            for (int m = 0; m < 4; ++m) { bf16_t* rowp = base + (size_t)(ai * 128 + m * 16) * ldc;
#pragma unroll
                for (int bj = 0; bj < 2; ++bj) { const f32x4 v0 = acc[ai][bj][m][0] * scale, v1 = acc[ai][bj][m][1] * scale;
                    u32x4 w; w.x = pg8::cvt_pk_bf16(v0[0], v0[1]); w.y = pg8::cvt_pk_bf16(v0[2], v0[3]); w.z = pg8::cvt_pk_bf16(v1[0], v1[1]); w.w = pg8::cvt_pk_bf16(v1[2], v1[3]);
                    *(u32x4*)(rowp + bj * 128) = w; } }
    }
};
__device__ __forceinline__ void gemm_in_phase(const Params& p, int l) {
    { pg8::Gemm g; g.A = p.H; g.Bt = p.wt_in + (size_t)l * INC * D; g.M = MT; g.N = C_GR; g.K = D;
      pg8::StaticOrder S; S.init(MT, C_GR, (int)gridDim.x, (int)blockIdx.x);
      pg8::EpiBf16<0> E; E.O = p.U; E.ldc = INC; E.bias = nullptr; E.split_cols = 0; E.split_stride = 0;
      pg8::gemm_phase<pg8::EpiBf16<0>, pg8::StaticOrder, GP_ALIGN, GP_SP2>((LAS unsigned char*)dyn_lds, g, S, E); }
    { pg8::Gemm g; g.A = (const bf16_t*)p.H8; g.Bt = (const bf16_t*)(p.wt_ing + (size_t)l * (INC - C_GR) * D); g.M = MT; g.N = INC - C_GR; g.K = D / 2;
      const int G = (int)gridDim.x, rot = (G - (MT / 256) * (C_GR / 256) % G) & ~7;
      pg8::StaticOrder S; S.init(MT, INC - C_GR, G, ((int)blockIdx.x + rot) % G);
      EpiScaledBf16 E; E.O = p.U + C_GR; E.ldc = INC; E.scale = 1.0f / W8_SCALE;
      pg8::gemm_phase<EpiScaledBf16, pg8::StaticOrder, GP_ALIGN, GP_SP2, true>((LAS unsigned char*)dyn_lds, g, S, E); }
}
__device__ __forceinline__ void gemm_merge_phase(const Params& p, int l) {
    pg8::Gemm g; g.A = p.Aall; g.Bt = p.wt_br + (size_t)l * 3 * 1024 * 512; g.M = 3 * MT; g.N = 3 * 1024; g.K = 512;
    SchedMerge S; S.G = (int)gridDim.x; S.c = (int)blockIdx.x; S.last = (l == DEPTH - 1);
    EpiBranch E; E.R = p.R;
    pg8::gemm_phase<EpiBranch, SchedMerge, GP_ALIGN, GP_SP2>((LAS unsigned char*)dyn_lds, g, S, E);
}
__device__ __forceinline__ void gemm_out_phase(const Params& p, int l) {
    pg8::Gemm g; g.A = p.Mg; g.Bt = p.wt_out + (size_t)l * D * D; g.M = MT; g.N = D; g.K = D;
    SchedOut S; S.init(MT, D, (int)gridDim.x, (int)blockIdx.x, l == DEPTH - 1);
    EpiOut E; E.X = p.X; E.mod_l = p.mod + (size_t)l * 5 * 6144;
    pg8::gemm_phase<EpiOut, SchedOut, GP_ALIGN, GP_SP2>((LAS unsigned char*)dyn_lds, g, S, E);
}
__device__ __forceinline__ void gemm_gu_phase(const Params& p, int l) {
    pg8::Gemm g; g.A = (const bf16_t*)p.Xg; g.Bt = (const bf16_t*)(p.wt_gu + (size_t)l * NE * 2048 * D); g.M = NE * CAPT * 256; g.N = NE * 2048; g.K = D / 2;
    build_tile_table(p, l);
    SchedMoE S; S.nN = 8; S.G = (int)gridDim.x; S.c = (int)blockIdx.x; S.sparseA = 1;
    EpiGU E; E.Act = p.Act; E.bgu = p.exp_b_gu + (size_t)l * NE * 2048;
    pg8::gemm_phase<EpiGU, SchedMoE, GP_ALIGN, GP_SP2, true>((LAS unsigned char*)dyn_lds, g, S, E);
}
__device__ __forceinline__ void gemm_down_phase(const Params& p, int l) {
    pg8::Gemm g; g.A = (const bf16_t*)p.Act; g.Bt = (const bf16_t*)(p.wt_down + (size_t)l * NE * D * D); g.M = MAXSLOTS; g.N = NE * D; g.K = D / 2;
    build_tile_table(p, l);
    SchedMoE S; S.nN = 4; S.G = (int)gridDim.x; S.c = (int)blockIdx.x; S.sparseA = 0;
    EpiDown E; E.Y = p.Y; E.bd = p.exp_b_down + (size_t)l * NE * D;
    pg8::gemm_phase<EpiDown, SchedMoE, GP_ALIGN, GP_SP2, true>((LAS unsigned char*)dyn_lds, g, S, E);
}

typedef __attribute__((address_space(4))) const Params* KParamsPtr;
__device__ __forceinline__ const Params& fresh_params() { KParamsPtr kp = (KParamsPtr)__builtin_amdgcn_kernarg_segment_ptr(); asm volatile("" : "+s"(kp)); return *(const Params*)kp; }
#define P_ fresh_params()
#ifdef BARRIER_TWICE
#define GRID_BARRIER() do { XcdBarrier _b = bar; asm volatile("" : "+s"(_b.bar), "+s"(_b.x)); xcd_barrier(_b); xcd_barrier(_b); } while (0)
#else
#define GRID_BARRIER() do { XcdBarrier _b = bar; asm volatile("" : "+s"(_b.bar), "+s"(_b.x)); xcd_barrier(_b); } while (0)
#endif
__global__ __launch_bounds__(512, 2) void k_fwd(Params p) {
    float* ldsf = (float*)dyn_lds;
#ifdef PROBE_PHASE
#ifndef PROBE_SHIFT
#define PROBE_SHIFT 0.0f
#endif
#ifndef PROBE_Q
#define PROBE_Q 50.0f
#endif
    unsigned long long pr_t0 = wall_clock64(), pr_prev = pr_t0, pr_acc = 0ull;
#define PMARK(id) do { const unsigned long long _t = wall_clock64(); if ((id) == PROBE_PHASE) pr_acc += _t - pr_prev; pr_prev = _t; } while (0)
#else
#define PMARK(id) do { } while (0)
#endif
    if (threadIdx.x == 0) *(uint4*)(dyn_lds + LDS_MAIN) = make_uint4(0u, 0u, 0u, 0u);
    __syncthreads();
    const XcdBarrier bar = xcd_barrier_post(P_.bar, (volatile LAS unsigned*)(dyn_lds + LDS_MAIN));
    convert_phase(P_, ldsf);
    mod_phase(P_, ldsf);
    small_phase(P_);
    GRID_BARRIER(); PMARK(0);
    norm_phase<0>(P_, 0);
    router_prep_phase(P_);
    GRID_BARRIER(); PMARK(1);
    for (int l = 0; l < DEPTH; ++l) {
        if (l > 0) { norm_phase<1>(P_, l); GRID_BARRIER(); PMARK(1); }
        gemm_in_phase(P_, l);
        GRID_BARRIER(); PMARK(2);
        mixprep_phase(P_, l);
#ifdef MIXPREP_TWICE
        mixprep_phase(P_, l);
#endif
#ifdef SPLIT_PREP
        GRID_BARRIER(); PMARK(16);
#endif
        lru_prep_phase(P_, l, ldsf);
#ifdef LRU_TWICE
        __syncthreads(); lru_prep_phase(P_, l, ldsf);
#endif
        GRID_BARRIER(); PMARK(3);
        sweep_phase<false>(P_, l, ldsf);
        GRID_BARRIER(); PMARK(4);
        sweep_phase<true>(P_, l, ldsf);
        GRID_BARRIER(); PMARK(13);
#ifdef SWEEP2_AGAIN
        { Params q = P_; q.Oret = q.Dummy; q.Ohg = q.Dummy; sweep_phase<true, SWEEP2_AGAIN - 1>(q, l, ldsf); }
        GRID_BARRIER();
#endif

        finish_phase(P_, l, l == DEPTH - 1);
        GRID_BARRIER(); PMARK(5);
        gemm_merge_phase(P_, l);
        GRID_BARRIER(); PMARK(6);
        merge_combine_phase(P_, l == DEPTH - 1);
        GRID_BARRIER(); PMARK(17);
        gemm_out_phase(P_, l);
        GRID_BARRIER(); PMARK(7);
        route_phase(P_, l, ldsf, l == DEPTH - 1);
        GRID_BARRIER(); PMARK(8);
        gemm_gu_phase(P_, l);
        GRID_BARRIER(); PMARK(11);
        gemm_down_phase(P_, l);
        GRID_BARRIER(); PMARK(12);
    }
#ifdef PROBE_PHASE
    if (blockIdx.x == 0 && threadIdx.x == 0) {
#ifdef PROBE_ABS
        const float fr = (float)((double)pr_acc / 100.0 / PROBE_ABS);
#else
        const float fr = (float)((double)pr_acc / (double)(pr_prev - pr_t0));
#endif
 ((float*)p.ctrl)[2048] = floorf(fr * PROBE_Q + 0.5f + PROBE_SHIFT) / PROBE_Q; }
    GRID_BARRIER();
#endif
    norm_phase<2>(P_, DEPTH);
}

static inline size_t align_up(size_t v, size_t a) { return (v + a - 1) / a * a; }

extern "C" void kernel_launch(void* const* d_in, const int* in_sizes, int n_in, void* d_out, int out_size, void* d_ws, size_t ws_size, hipStream_t stream) {
    (void)in_sizes; (void)n_in; (void)out_size; (void)ws_size;
    Params p{};
    const float** pin = (const float**)&p.x;
    for (int i = 0; i < 31; ++i) pin[i] = (const float*)d_in[i];
    p.out = (float*)d_out;
    char* w = (char*)d_ws; size_t off = 0;
    auto take = [&](size_t bytes) { char* r = w + off; off = align_up(off + bytes, 256); return r; };
    p.bar = (unsigned*)take(XCD_BAR_WORDS * 4);
    p.ctrl = (unsigned*)take(4096 * 4);
    const size_t zero_bytes = off;
    p.wt_in = (bf16_t*)take((size_t)DEPTH * INC * D * 2);
    p.wt_br = (bf16_t*)take((size_t)DEPTH * 3 * 1024 * 512 * 2);
    p.wt_out = (bf16_t*)take((size_t)DEPTH * D * D * 2);
    p.wt_gu = (unsigned char*)take((size_t)DEPTH * NE * 2048 * D);
    p.wt_down = (unsigned char*)take((size_t)DEPTH * NE * D * D);
    p.mod = (float*)take((size_t)DEPTH * 5 * 6144 * 4);
    p.lb = (float*)take(4096 * 4);
    p.rot = (float*)take((size_t)4096 * 32 * 2 * 4);
    p.X = (bf16_t*)take((size_t)MT * D * 2);
    p.H = (bf16_t*)take((size_t)MT * D * 2); p.H8 = (unsigned char*)take((size_t)MT * D); p.wt_ing = (unsigned char*)take((size_t)DEPTH * (INC - C_GR) * D);
    p.U = (bf16_t*)take((size_t)MT * INC * 2);
    p.Oret = (bf16_t*)take((size_t)2 * MT * 512 * 2);
    p.Ohg = (bf16_t*)take((size_t)2 * MT * 512 * 2);
    p.PH = (unsigned*)take((size_t)2 * MT * 512 * 4);
    p.RQ = (bf16_t*)take((size_t)2 * MT * 512 * 2); p.RK = (bf16_t*)take((size_t)2 * MT * 512 * 2); p.HQ = (bf16_t*)take((size_t)2 * MT * 512 * 2); p.HK = (bf16_t*)take((size_t)2 * MT * 512 * 2);
    p.HA = (float*)take((size_t)2 * (MT / 32) * 512 * 4);
    p.Dummy = (bf16_t*)take((size_t)2 * MT * 512 * 2);
    p.SE = (float*)take((size_t)192 * 9 * 4096 * 4); p.SG = (float*)take((size_t)192 * 9 * 128 * 4); p.LP = (float*)take((size_t)2 * 544 * 512 * 4); p.LH = (float*)take((size_t)2 * 544 * 512 * 4); p.LS = (float*)take((size_t)2 * 544 * 512 * 4);
    p.Aall = (bf16_t*)take((size_t)3 * MT * 512 * 2);
    p.R = (bf16_t*)take((size_t)3 * MT * D * 2); p.Dx = (bf16_t*)take((size_t)MT * D * 2);
    p.Mg = (bf16_t*)take((size_t)MT * D * 2);
    p.tok_e = (int*)take((size_t)MT * 4 * 4); p.tok_pos = (int*)take((size_t)MT * 4 * 4); p.tok_w = (float*)take((size_t)MT * 4 * 4);
    p.RWp = (float*)take((size_t)DEPTH * 5 * 1024 * 32 * 4); p.RC = (float*)take((size_t)DEPTH * 5 * 32 * 4);
    p.Xg = (unsigned char*)take((size_t)NE * CAPT * 256 * D); p.Act = (unsigned char*)take((size_t)MAXSLOTS * D); p.Y = (unsigned char*)take((size_t)MAXSLOTS * D);

    static int grid = 0;
    if (!grid) {
        (void)hipFuncSetAttribute((const void*)k_fwd, hipFuncAttributeMaxDynamicSharedMemorySize, LDS_TOTAL);
        int dev = 0, cus = 0, per_cu = 0;
        (void)hipGetDevice(&dev);
        (void)hipDeviceGetAttribute(&cus, hipDeviceAttributeMultiprocessorCount, dev);
        (void)hipOccupancyMaxActiveBlocksPerMultiprocessor(&per_cu, (const void*)k_fwd, 512, LDS_TOTAL);
        grid = cus * (per_cu < 1 ? per_cu : 1);
        if (grid <= 0) { fprintf(stderr, "k_fwd: occupancy query returned %d blocks per CU on %d CUs\n", per_cu, cus); grid = 0; return; }
    }
    (void)hipMemsetAsync(d_ws, 0, zero_bytes, stream);
    hipLaunchKernelGGL(k_fwd, dim3(grid), dim3(512), LDS_TOTAL, stream, p);
}
```
